# Optimizing an MI355X kernel written in HIP

```python
import jax, jax.numpy as jnp
from jax import lax
import numpy as np

D_MODEL = 1024
BATCH = 8
SEQ = 2048
DEPTH = 2

GRID_W = 64
CTX_LEN = 256
HEAD_DIM = 64
N_Q_HEADS = 8
N_KV_HEADS = 2
Q_PER_KV = N_Q_HEADS // N_KV_HEADS
ATTN_W = N_Q_HEADS * HEAD_DIM
KV_W = N_KV_HEADS * HEAD_DIM
WINDOW = 128
ATTN_BLOCK = 128
ROPE_BASE = 10000.0
POOL_WINDOWS = (2, 4, 8, 16)
POOL_GROUPS = len(POOL_WINDOWS)
POOL_W = 512
POOL_GW = POOL_W // POOL_GROUPS
RNN_W = 512
RNN_BLOCKS = 8
RNN_BW = RNN_W // RNN_BLOCKS
CONV_W = 4
LRU_C = 8.0
N_DIRS = 2
N_BRANCH = 3
D_FF = -(-8 * D_MODEL // (3 * 256)) * 256
EPS = 1e-6
NEG_INF = -1e30

Q0 = 0
K0 = Q0 + ATTN_W
V0 = K0 + KV_W
RX0 = V0 + KV_W
RY0 = RX0 + RNN_W
PU0 = RY0 + RNN_W
GL0 = PU0 + POOL_W
IN_W = GL0 + N_BRANCH * D_MODEL

kernel_name = "hybrid_gated_parallel_diffusion_block"


def rms_norm(x, g):
    xf = x.astype(jnp.float32)
    y = xf * lax.rsqrt(jnp.mean(xf * xf, axis=-1, keepdims=True) + EPS)
    return (y * g.astype(jnp.float32)).astype(x.dtype)


def modulate(h, shift, scale):
    return h * (1 + scale) + shift


def axial_rope_tables(seq_len):
    rows = seq_len // GRID_W
    row = jnp.repeat(jnp.arange(rows), GRID_W).astype(jnp.float32)
    col = jnp.tile(jnp.arange(GRID_W), rows).astype(jnp.float32)
    half = HEAD_DIM // 2
    quarter = half // 2
    inv = ROPE_BASE ** (-(jnp.arange(quarter, dtype=jnp.float32) * 2.0 / half))
    ang_r = row[:, None] * inv[None, :]
    ang_c = col[:, None] * inv[None, :]
    return jnp.cos(ang_r), jnp.sin(ang_r), jnp.cos(ang_c), jnp.sin(ang_c)


def apply_axial_rope(x, tables):
    cos_r, sin_r, cos_c, sin_c = tables
    xf = x.astype(jnp.float32)
    half = HEAD_DIM // 2
    quarter = half // 2

    def rot(u, cos, sin):
        cos = cos[None, :, None, :]
        sin = sin[None, :, None, :]
        u1, u2 = u[..., :quarter], u[..., quarter:]
        return jnp.concatenate([u1 * cos - u2 * sin, u2 * cos + u1 * sin], axis=-1)

    out = jnp.concatenate([rot(xf[..., :half], cos_r, sin_r), rot(xf[..., half:], cos_c, sin_c)], axis=-1)
    return out.astype(x.dtype)


def windowed_attention(q_lat, k_lat, v_lat, q_ctx, k_ctx, v_ctx, sink):
    B, S = q_lat.shape[0], q_lat.shape[1]
    C = k_ctx.shape[1]
    nb = S // ATTN_BLOCK
    scale = HEAD_DIM ** -0.5
    sink_hg = sink.astype(jnp.float32).reshape(N_KV_HEADS, Q_PER_KV)

    q = (q_lat * scale).reshape(B, nb, ATTN_BLOCK, N_KV_HEADS, Q_PER_KV, HEAD_DIM)
    pad = ((0, 0), (ATTN_BLOCK, ATTN_BLOCK), (0, 0), (0, 0))
    kp = jnp.pad(k_lat, pad).reshape(B, nb + 2, ATTN_BLOCK, N_KV_HEADS, HEAD_DIM)
    vp = jnp.pad(v_lat, pad).reshape(B, nb + 2, ATTN_BLOCK, N_KV_HEADS, HEAD_DIM)
    k_win = jnp.concatenate([kp[:, :nb], kp[:, 1:nb + 1], kp[:, 2:]], axis=2)
    v_win = jnp.concatenate([vp[:, :nb], vp[:, 1:nb + 1], vp[:, 2:]], axis=2)
    nk = 3 * ATTN_BLOCK

    blk = jnp.arange(nb)[:, None, None] * ATTN_BLOCK
    qpos = blk + jnp.arange(ATTN_BLOCK)[None, :, None]
    kpos = blk - ATTN_BLOCK + jnp.arange(nk)[None, None, :]
    valid = (kpos >= 0) & (kpos < S) & (jnp.abs(qpos - kpos) <= WINDOW)

    s_loc = jnp.einsum('bnqhgd,bnkhd->bnhgqk', q, k_win).astype(jnp.float32)
    s_loc = jnp.where(valid[None, :, None, None], s_loc, NEG_INF)
    s_ctx = jnp.einsum('bnqhgd,bkhd->bnhgqk', q, k_ctx).astype(jnp.float32)
    s_sink = jnp.broadcast_to(sink_hg[None, None, :, :, None, None],
                              (B, nb, N_KV_HEADS, Q_PER_KV, ATTN_BLOCK, 1))
    p = jax.nn.softmax(jnp.concatenate([s_loc, s_ctx, s_sink], axis=-1), axis=-1).astype(v_lat.dtype)
    o = (jnp.einsum('bnhgqk,bnkhd->bnqhgd', p[..., :nk], v_win)
         + jnp.einsum('bnhgqk,bkhd->bnqhgd', p[..., nk:nk + C], v_ctx))
    o_lat = o.reshape(B, S, ATTN_W)

    o_ctx = None
    if q_ctx is not None:
        qc = (q_ctx * scale).reshape(B, C, N_KV_HEADS, Q_PER_KV, HEAD_DIM)
        sc = jnp.einsum('bqhgd,bkhd->bhgqk', qc, k_ctx).astype(jnp.float32)
        sc_sink = jnp.broadcast_to(sink_hg[None, :, :, None, None], (B, N_KV_HEADS, Q_PER_KV, C, 1))
        pc = jax.nn.softmax(jnp.concatenate([sc, sc_sink], axis=-1), axis=-1).astype(v_ctx.dtype)
        o_ctx = jnp.einsum('bhgqk,bkhd->bqhgd', pc[..., :C], v_ctx).reshape(B, C, ATTN_W)
    return o_lat, o_ctx


def multiscale_pool(u, w_mix, ch_scale):
    B, L = u.shape[0], u.shape[1]
    t = jnp.arange(L)
    outs = []
    for g, w in enumerate(POOL_WINDOWS):
        ug = u[..., g * POOL_GW:(g + 1) * POOL_GW].astype(jnp.float32)
        cs = jnp.pad(jnp.cumsum(ug, axis=1), ((0, 0), (1, 0), (0, 0)))
        lo = jnp.clip(t - (w - 1) // 2, 0, L)
        hi = jnp.clip(t + w // 2 + 1, 0, L)
        mean = (cs[:, hi] - cs[:, lo]) / (hi - lo).astype(jnp.float32)[None, :, None]
        outs.append(mean - ug)
    d = jnp.concatenate(outs, axis=-1).astype(u.dtype).reshape(B, L, POOL_GROUPS, POOL_GW)
    y = jnp.einsum('blgc,gcd->blgd', d, w_mix).reshape(B, L, POOL_W)
    return y * ch_scale


def dwconv_centred(x, w, b):
    L = x.shape[1]
    xp = jnp.pad(x, ((0, 0), ((CONV_W - 1) // 2, CONV_W // 2), (0, 0)))
    y = b
    for k in range(CONV_W):
        y = y + xp[:, k:k + L] * w[k]
    return y


def lru_coeffs(x, w_a, b_a, w_x, b_x, lam):
    B, L = x.shape[0], x.shape[1]
    xb = x.reshape(B, L, RNN_BLOCKS, RNN_BW)
    r = jax.nn.sigmoid(jnp.einsum('blhi,hij->blhj', xb, w_a).reshape(B, L, RNN_W).astype(jnp.float32)
                       + b_a.astype(jnp.float32))
    i = jax.nn.sigmoid(jnp.einsum('blhi,hij->blhj', xb, w_x).reshape(B, L, RNN_W).astype(jnp.float32)
                       + b_x.astype(jnp.float32))
    log_a = LRU_C * r * jax.nn.log_sigmoid(lam.astype(jnp.float32))
    a = jnp.exp(log_a)
    mult = jnp.sqrt(-jnp.expm1(2.0 * log_a))
    return a, mult * i * x.astype(jnp.float32)


def linear_scan(a, b, h0):
    def comb(l, r):
        return (l[0] * r[0], r[0] * l[1] + r[1])
    a_cum, b_cum = lax.associative_scan(comb, (a, b), axis=1)
    return a_cum * h0[:, None, :] + b_cum


def bidir_rglru_branch(x_lat, y_lat, x_ctx, y_ctx, conv_w, conv_b, w_a, b_a, w_x, b_x, lam):
    xl = dwconv_centred(x_lat, conv_w, conv_b)
    xc = dwconv_centred(x_ctx, conv_w, conv_b)
    h0 = jnp.zeros((x_lat.shape[0], RNN_W), jnp.float32)
    h_lat = []
    h_ctx = []
    for d in range(N_DIRS):
        al, bl = lru_coeffs(xl, w_a[d], b_a[d], w_x[d], b_x[d], lam[d])
        ac, bc = lru_coeffs(xc, w_a[d], b_a[d], w_x[d], b_x[d], lam[d])
        if d == 1:
            al, bl, ac, bc = (jnp.flip(t, axis=1) for t in (al, bl, ac, bc))
        hc = linear_scan(ac, bc, h0)
        hl = linear_scan(al, bl, hc[:, -1])
        if d == 1:
            hl, hc = jnp.flip(hl, axis=1), jnp.flip(hc, axis=1)
        h_lat.append(hl)
        h_ctx.append(hc)
    out_l = ((h_lat[0] + h_lat[1]) * jax.nn.gelu(y_lat.astype(jnp.float32))).astype(x_lat.dtype)
    out_c = None
    if y_ctx is not None:
        out_c = ((h_ctx[0] + h_ctx[1]) * jax.nn.gelu(y_ctx.astype(jnp.float32))).astype(x_ctx.dtype)
    return out_l, out_c


def merge_branches(attn, pool, rnn, gate_logits, w_attn_o, w_pool_o, w_rnn_o, w_out):
    lead = gate_logits.shape[:-1]
    g = jax.nn.sigmoid(gate_logits.astype(jnp.float32)).astype(attn.dtype).reshape(*lead, N_BRANCH, D_MODEL)
    merged = (g[..., 0, :] * (attn @ w_attn_o) + g[..., 1, :] * (pool @ w_pool_o)
              + g[..., 2, :] * (rnn @ w_rnn_o))
    return merged @ w_out


def ffn_sublayer(x, shift, scale, gate, g_pre, g_post, w_gu, w_down):
    h = modulate(rms_norm(x, g_pre), shift, scale)
    gu = h @ w_gu
    f = (jax.nn.silu(gu[..., :D_FF]) * gu[..., D_FF:]) @ w_down
    return x + gate * rms_norm(f, g_post)


def setup_inputs(seed: int = 0) -> dict:
    key = jax.random.key(seed)
    ks = jax.random.split(key, 32)
    f32 = jnp.float32

    def nrm(k, shape, scale):
        return jax.random.normal(k, shape, f32) * scale

    L = DEPTH
    u = jax.random.uniform(ks[22], (L, N_DIRS, RNN_W), f32, 0.9, 0.999)
    return {
        "x": nrm(ks[0], (BATCH, SEQ, D_MODEL), 1.0),
        "c": nrm(ks[1], (BATCH, D_MODEL), 1.0),
        "ctx": nrm(ks[2], (BATCH, CTX_LEN, D_MODEL), 1.0),
        "c_ctx": nrm(ks[3], (D_MODEL,), 1.0),
        "w_ada": nrm(ks[4], (L, D_MODEL, 6 * D_MODEL), 0.5 * D_MODEL ** -0.5),
        "b_ada": nrm(ks[5], (L, 6 * D_MODEL), 0.02),
        "g_pre_mix": 1.0 + nrm(ks[6], (L, D_MODEL), 0.05),
        "g_post_mix": 1.0 + nrm(ks[7], (L, D_MODEL), 0.05),
        "g_pre_ffn": 1.0 + nrm(ks[8], (L, D_MODEL), 0.05),
        "g_post_ffn": 1.0 + nrm(ks[9], (L, D_MODEL), 0.05),
        "w_in": nrm(ks[10], (L, D_MODEL, IN_W), D_MODEL ** -0.5),
        "attn_sink": nrm(ks[11], (L, N_Q_HEADS), 0.5),
        "w_attn_o": nrm(ks[12], (L, ATTN_W, D_MODEL), ATTN_W ** -0.5),
        "pool_mix": nrm(ks[13], (L, POOL_GROUPS, POOL_GW, POOL_GW), POOL_GW ** -0.5),
        "pool_scale": 1.0 + nrm(ks[14], (L, POOL_W), 0.1),
        "w_pool_o": nrm(ks[15], (L, POOL_W, D_MODEL), POOL_W ** -0.5),
        "conv_w": nrm(ks[16], (L, CONV_W, RNN_W), CONV_W ** -0.5),
        "conv_b": nrm(ks[17], (L, RNN_W), 0.02),
        "lru_w_a": nrm(ks[18], (L, N_DIRS, RNN_BLOCKS, RNN_BW, RNN_BW), RNN_BW ** -0.5),
        "lru_b_a": nrm(ks[19], (L, N_DIRS, RNN_W), 0.02),
        "lru_w_x": nrm(ks[20], (L, N_DIRS, RNN_BLOCKS, RNN_BW, RNN_BW), RNN_BW ** -0.5),
        "lru_b_x": nrm(ks[21], (L, N_DIRS, RNN_W), 0.02),
        "lru_lambda": jnp.log(u) - jnp.log1p(-u),
        "w_rnn_o": nrm(ks[23], (L, RNN_W, D_MODEL), RNN_W ** -0.5),
        "w_out": nrm(ks[24], (L, D_MODEL, D_MODEL), D_MODEL ** -0.5),
        "w_gu": nrm(ks[25], (L, D_MODEL, 2 * D_FF), D_MODEL ** -0.5),
        "w_down": nrm(ks[26], (L, D_FF, D_MODEL), D_FF ** -0.5),
    }


def reference(x, c, ctx, c_ctx, w_ada, b_ada, g_pre_mix, g_post_mix, g_pre_ffn, g_post_ffn,
              w_in, attn_sink, w_attn_o, pool_mix, pool_scale, w_pool_o, conv_w, conv_b,
              lru_w_a, lru_b_a, lru_w_x, lru_b_x, lru_lambda, w_rnn_o, w_out, w_gu, w_down):
    B, S, D = x.shape
    C = ctx.shape[1]
    rope = axial_rope_tables(S)
    silu_c = jax.nn.silu(c)
    silu_cc = jax.nn.silu(c_ctx)[None]
    for l in range(DEPTH):
        need_ctx = l < DEPTH - 1
        mod_x = (silu_c @ w_ada[l] + b_ada[l]).reshape(B, 1, 6, D)
        mod_c = (silu_cc @ w_ada[l] + b_ada[l]).reshape(1, 1, 6, D)
        wl = w_in[l]

        h = modulate(rms_norm(x, g_pre_mix[l]), mod_x[:, :, 0], mod_x[:, :, 1])
        hc = modulate(rms_norm(ctx, g_pre_mix[l]), mod_c[:, :, 0], mod_c[:, :, 1])
        p = h @ wl
        q = apply_axial_rope(p[..., Q0:K0].reshape(B, S, N_Q_HEADS, HEAD_DIM), rope)
        k = apply_axial_rope(p[..., K0:V0].reshape(B, S, N_KV_HEADS, HEAD_DIM), rope)
        v = p[..., V0:RX0].reshape(B, S, N_KV_HEADS, HEAD_DIM)
        rx, ry, pu, gl = p[..., RX0:RY0], p[..., RY0:PU0], p[..., PU0:GL0], p[..., GL0:]

        pc_kvx = hc @ wl[:, K0:RY0]
        kc = pc_kvx[..., :KV_W].reshape(B, C, N_KV_HEADS, HEAD_DIM)
        vc = pc_kvx[..., KV_W:2 * KV_W].reshape(B, C, N_KV_HEADS, HEAD_DIM)
        rxc = pc_kvx[..., 2 * KV_W:]
        if need_ctx:
            qc = (hc @ wl[:, Q0:K0]).reshape(B, C, N_Q_HEADS, HEAD_DIM)
            pc_rest = hc @ wl[:, RY0:]
            ryc, puc, glc = pc_rest[..., :RNN_W], pc_rest[..., RNN_W:RNN_W + POOL_W], pc_rest[..., RNN_W + POOL_W:]
        else:
            qc, ryc = None, None

        attn_l, attn_c = windowed_attention(q, k, v, qc, kc, vc, attn_sink[l])
        rnn_l, rnn_c = bidir_rglru_branch(rx, ry, rxc, ryc, conv_w[l], conv_b[l], lru_w_a[l], lru_b_a[l],
                                          lru_w_x[l], lru_b_x[l], lru_lambda[l])
        pool_l = multiscale_pool(pu, pool_mix[l], pool_scale[l])
        mix_l = merge_branches(attn_l, pool_l, rnn_l, gl, w_attn_o[l], w_pool_o[l], w_rnn_o[l], w_out[l])
        x = x + mod_x[:, :, 2] * rms_norm(mix_l, g_post_mix[l])

        x = ffn_sublayer(x, mod_x[:, :, 3], mod_x[:, :, 4], mod_x[:, :, 5], g_pre_ffn[l], g_post_ffn[l], w_gu[l], w_down[l])

        if need_ctx:
            pool_c = multiscale_pool(puc, pool_mix[l], pool_scale[l])
            mix_c = merge_branches(attn_c, pool_c, rnn_c, glc, w_attn_o[l], w_pool_o[l], w_rnn_o[l], w_out[l])
            ctx = ctx + mod_c[:, :, 2] * rms_norm(mix_c, g_post_mix[l])
            ctx = ffn_sublayer(ctx, mod_c[:, :, 3], mod_c[:, :, 4], mod_c[:, :, 5], g_pre_ffn[l], g_post_ffn[l], w_gu[l], w_down[l])
    return x
```

```cpp
#include <hip/hip_runtime.h>
#include <hip/hip_cooperative_groups.h>
#include <cstdio>
#include <cstdint>
namespace cg = cooperative_groups;

#ifndef PER_PHASE_LAUNCH
#define PER_PHASE_LAUNCH 0
#endif

typedef unsigned short bf16_t;
typedef short bf16x8 __attribute__((ext_vector_type(8)));
typedef short s16x4 __attribute__((ext_vector_type(4)));
typedef float f32x4 __attribute__((ext_vector_type(4)));
typedef float f32x16 __attribute__((ext_vector_type(16)));
typedef unsigned u32x4 __attribute__((ext_vector_type(4)));
typedef unsigned u32x2 __attribute__((ext_vector_type(2)));

constexpr int DM = 1024, NBATCH = 8, SEQ = 2048, CTX = 256;
constexpr int ML = NBATCH * SEQ;
constexpr int MC = NBATCH * CTX;
constexpr int MA = ML + MC;
constexpr int INW = 5376, DFF = 2816, NGU = 5632;
constexpr float EPS = 1e-6f;
constexpr float LOG2E = 1.4426950408889634f;
constexpr float QSCALE = 0.125f * LOG2E;
constexpr int NTHREADS = 512, NWAVES = 8;
constexpr int LDS_BYTES = 147456;
constexpr int NPHASES = 18;

constexpr size_t MiB = 1u << 20;
constexpr size_t OFF_CTL = 0;
constexpr size_t OFF_TAB = 1 * MiB;
constexpr size_t OFF_MOD = 1 * MiB + 65536;
constexpr size_t OFF_WA = 2 * MiB;
constexpr size_t WA_IN = 0, WA_AO = 11010048, WA_PO = WA_AO + 1048576, WA_RO = WA_PO + 1048576, WA_OUT = WA_RO + 1048576,
                 WA_PM = WA_OUT + 2097152, WA_LA = WA_PM + 131072, WA_LX = WA_LA + 131072;
constexpr size_t OFF_A = 18 * MiB;
constexpr size_t OFF_Q = 54 * MiB;
constexpr size_t OFF_KV = 72 * MiB;
constexpr size_t OFF_RX = 81 * MiB;
constexpr size_t OFF_PU = 99 * MiB;
constexpr size_t OFF_RY = 117 * MiB;
constexpr size_t OFF_MERGED = OFF_RX;
constexpr size_t OFF_F = OFF_Q;
constexpr size_t OFF_WB = 94 * MiB;
constexpr size_t WB_GU = 0, WB_DOWN = 11534336;
constexpr size_t OFF_G = 135 * MiB;
constexpr size_t OFF_XC = 243 * MiB;
constexpr size_t WS_NEED = 251 * MiB;

struct P {
    const float* in[27];
    float* out;
    unsigned char* ws;
    int ph_lo, ph_hi;
};
enum { I_X = 0, I_C, I_CTX, I_CCTX, I_WADA, I_BADA, I_GPREMIX, I_GPOSTMIX, I_GPREFFN, I_GPOSTFFN, I_WIN, I_SINK, I_WAO, I_PMIX, I_PSCALE, I_WPO,
       I_CONVW, I_CONVB, I_LWA, I_LBA, I_LWX, I_LBX, I_LAM, I_WRO, I_WOUT, I_WGU, I_WDOWN };

__device__ __forceinline__ float bf2f(unsigned v) { return __uint_as_float(v << 16); }
__device__ __forceinline__ unsigned f2bf(float f) { unsigned u = __float_as_uint(f); return (u + 0x7fffu + ((u >> 16) & 1u)) >> 16; }
__device__ __forceinline__ unsigned pk2(float lo, float hi) { return f2bf(lo) | (f2bf(hi) << 16); }
__device__ __forceinline__ float wave_sum(float v) {
#pragma unroll
    for (int o = 1; o < 64; o <<= 1) v += __shfl_xor(v, o);
    return v;
}
__device__ __forceinline__ float sigm(float x) { return 1.f / (1.f + __expf(-x)); }
__device__ __forceinline__ float gelu_tanh(float y) {
    const float z = 0.7978845608028654f * (y + 0.044715f * y * y * y);
    const float t = 1.f - 2.f / (1.f + __expf(2.f * z));
    return 0.5f * y * (1.f + t);
}
__device__ __forceinline__ int crow(int r, int hi) { return (r & 3) + 8 * (r >> 2) + 4 * hi; }
__device__ __forceinline__ int perm32(int rho) { const int n = rho >> 4, i = rho & 15; return 8 * (i >> 2) + 4 * n + (i & 3); }
#define LDS_WAIT() asm volatile("s_waitcnt lgkmcnt(0)" ::: "memory")
__device__ __forceinline__ int opaque_tid() { int t = threadIdx.x; asm volatile("" : "+v"(t)); return t; }
__device__ __forceinline__ f32x4 unpack4(u32x2 w) { return (f32x4){bf2f(w.x & 0xffffu), bf2f(w.x >> 16), bf2f(w.y & 0xffffu), bf2f(w.y >> 16)}; }
__device__ __forceinline__ void unpack8(u32x4 w, f32x4& a, f32x4& b) {
    a = (f32x4){bf2f(w.x & 0xffffu), bf2f(w.x >> 16), bf2f(w.y & 0xffffu), bf2f(w.y >> 16)};
    b = (f32x4){bf2f(w.z & 0xffffu), bf2f(w.z >> 16), bf2f(w.w & 0xffffu), bf2f(w.w >> 16)};
}
__device__ __forceinline__ u32x4 pack8(f32x4 a, f32x4 b) { u32x4 w; w.x = pk2(a[0], a[1]); w.y = pk2(a[2], a[3]); w.z = pk2(b[0], b[1]); w.w = pk2(b[2], b[3]); return w; }

__constant__ float ROPE_INV[16] = {1.0f, 0.5623413251903491f, 0.31622776601683794f, 0.1778279410038923f, 0.1f, 0.05623413251903491f, 0.03162277660168379f,
                                   0.01778279410038923f, 0.01f, 0.005623413251903491f, 0.003162277660168379f, 0.001778279410038923f, 0.001f,
                                   0.0005623413251903491f, 0.0003162277660168379f, 0.0001778279410038923f};

__device__ __forceinline__ int src_col(int mode, int n) {
    if (mode == 1) {
        if (n >= 640) return n;
        const int p = n & 63, hb = n - p, G = p >> 3, j = p & 7, half = G >> 2, g = G & 3;
        const int dim = half * 32 + ((j < 4) ? (4 * g + j) : (16 + 4 * g + (j - 4)));
        return hb + dim;
    }
    if (mode == 2) {
        const int q = n >> 3, t = n & 7;
        return (t < 4) ? (4 * q + t) : (DFF + 4 * q + (t - 4));
    }
    return n;
}
__device__ __forceinline__ void tr_item(const float* W, int K, int N, int Nout, bf16_t* WT, float* scr, int item, int lane, int mode) {
    const int nblk = Nout / 32, kb = item / nblk, nb = item % nblk, k0 = 64 * kb, n0 = 32 * nb;
    const int sc = src_col(mode, n0 + (lane & 31));
#pragma unroll 8
    for (int i = 0; i < 32; ++i) { const int kk = 2 * i + (lane >> 5); scr[kk * 33 + (lane & 31)] = W[(size_t)(k0 + kk) * N + sc]; }
    LDS_WAIT(); asm volatile("" ::: "memory");
    const int c = lane & 7;
#pragma unroll
    for (int j = 0; j < 4; ++j) {
        const int n = (lane >> 3) + 8 * j; const float* s = scr + (8 * c) * 33 + n;
        u32x4 o; o.x = pk2(s[0 * 33], s[1 * 33]); o.y = pk2(s[2 * 33], s[3 * 33]); o.z = pk2(s[4 * 33], s[5 * 33]); o.w = pk2(s[6 * 33], s[7 * 33]);
        *(u32x4*)(WT + (size_t)(n0 + n) * K + k0 + 8 * c) = o;
    }
    LDS_WAIT(); asm volatile("" ::: "memory");
}
constexpr int WA_ITEMS = 2688 + 3 * 256 + 512 + 32 + 32 + 32;
constexpr int WB_ITEMS = 2816 + 1408;
__device__ __forceinline__ void convert_WA(const P& p, int l, float* scr, int gw, int NGW, int lane) {
    unsigned char* wa = p.ws + OFF_WA;
    for (int it = gw; it < WA_ITEMS; it += NGW) {
        int r = it;
        if (r < 2688) { tr_item(p.in[I_WIN] + (size_t)l * DM * INW, DM, INW, INW, (bf16_t*)(wa + WA_IN), scr, r, lane, 1); continue; } r -= 2688;
        if (r < 256) { tr_item(p.in[I_WAO] + (size_t)l * 512 * DM, 512, DM, DM, (bf16_t*)(wa + WA_AO), scr, r, lane, 0); continue; } r -= 256;
        if (r < 256) { tr_item(p.in[I_WPO] + (size_t)l * 512 * DM, 512, DM, DM, (bf16_t*)(wa + WA_PO), scr, r, lane, 0); continue; } r -= 256;
        if (r < 256) { tr_item(p.in[I_WRO] + (size_t)l * 512 * DM, 512, DM, DM, (bf16_t*)(wa + WA_RO), scr, r, lane, 0); continue; } r -= 256;
        if (r < 512) { tr_item(p.in[I_WOUT] + (size_t)l * DM * DM, DM, DM, DM, (bf16_t*)(wa + WA_OUT), scr, r, lane, 0); continue; } r -= 512;
        if (r < 32) { const int g = r >> 3; tr_item(p.in[I_PMIX] + (size_t)(l * 4 + g) * 16384, 128, 128, 128, (bf16_t*)(wa + WA_PM) + g * 16384, scr, r & 7, lane, 0); continue; } r -= 32;
        if (r < 32) { const int m = r >> 1; tr_item(p.in[I_LWA] + (size_t)(l * 16 + m) * 4096, 64, 64, 64, (bf16_t*)(wa + WA_LA) + m * 4096, scr, r & 1, lane, 0); continue; } r -= 32;
        { const int m = r >> 1; tr_item(p.in[I_LWX] + (size_t)(l * 16 + m) * 4096, 64, 64, 64, (bf16_t*)(wa + WA_LX) + m * 4096, scr, r & 1, lane, 0); }
    }
}
__device__ __forceinline__ void convert_WB(const P& p, int l, float* scr, int gw, int NGW, int lane) {
    unsigned char* wb = p.ws + OFF_WB;
    for (int it = gw; it < WB_ITEMS; it += NGW) {
        int r = it;
        if (r < 2816) { tr_item(p.in[I_WGU] + (size_t)l * DM * NGU, DM, NGU, NGU, (bf16_t*)(wb + WB_GU), scr, r, lane, 2); continue; } r -= 2816;
        tr_item(p.in[I_WDOWN] + (size_t)l * DFF * DM, DFF, DM, DM, (bf16_t*)(wb + WB_DOWN), scr, r, lane, 0);
    }
}

__device__ __forceinline__ void mod_item(const P& p, unsigned char* lds, int item) {
    const int tid = opaque_tid(), lane = tid & 63, wave = tid >> 6;
    const int l = item / 96, cgp = item % 96;
    float* sc = (float*)lds;
    float* red = (float*)(lds + 36864);
    for (int idx = tid; idx < 9 * 1024; idx += NTHREADS) {
        const int r = idx >> 10, k = idx & 1023;
        const float v = (r < 8) ? p.in[I_C][r * 1024 + k] : p.in[I_CCTX][k];
        sc[idx] = v / (1.f + __expf(-v));
    }
    __syncthreads();
    float acc[9];
#pragma unroll
    for (int r = 0; r < 9; ++r) acc[r] = 0.f;
    const float* wp = p.in[I_WADA] + (size_t)l * 1024 * 6144 + cgp * 64 + lane;
    const int kbeg = wave * 128;
#pragma unroll 4
    for (int k = kbeg; k < kbeg + 128; ++k) {
        const float w = wp[(size_t)k * 6144];
#pragma unroll
        for (int r = 0; r < 9; ++r) acc[r] += sc[r * 1024 + k] * w;
    }
#pragma unroll
    for (int r = 0; r < 9; ++r) red[(wave * 9 + r) * 64 + lane] = acc[r];
    __syncthreads();
    float* mod = (float*)(p.ws + OFF_MOD);
    for (int idx = tid; idx < 9 * 64; idx += NTHREADS) {
        const int r = idx >> 6, ln = idx & 63;
        float s = 0.f;
#pragma unroll
        for (int w = 0; w < 8; ++w) s += red[(w * 9 + r) * 64 + ln];
        const int j = cgp * 64 + ln;
        mod[(size_t)(l * 9 + r) * 6144 + j] = s + p.in[I_BADA][l * 6144 + j];
    }
    __syncthreads();
}
__device__ __forceinline__ void table_item(const P& p) {
    float* tc = (float*)(p.ws + OFF_TAB); float* ts = tc + 1024;
    for (int idx = threadIdx.x; idx < 1024; idx += NTHREADS) {
        const int pos = idx >> 4, i = idx & 15;
        const float ang = (float)pos * ROPE_INV[i];
        const double x = (double)ang;
        const double n = rint(x * 0.6366197723675814);
        const double r = x - n * 1.5707963267948966;
        const double r2 = r * r;
        const double sr = r * (1.0 - r2 / 6.0 * (1.0 - r2 / 20.0 * (1.0 - r2 / 42.0 * (1.0 - r2 / 72.0 * (1.0 - r2 / 110.0 * (1.0 - r2 / 156.0))))));
        const double cr = 1.0 - r2 / 2.0 * (1.0 - r2 / 12.0 * (1.0 - r2 / 30.0 * (1.0 - r2 / 56.0 * (1.0 - r2 / 90.0 * (1.0 - r2 / 132.0 * (1.0 - r2 / 182.0))))));
        const int q = ((int)n) & 3;
        double s, c;
        if (q == 0) { s = sr; c = cr; } else if (q == 1) { s = cr; c = -sr; } else if (q == 2) { s = -sr; c = -cr; } else { s = -cr; c = sr; }
        tc[idx] = (float)c; ts[idx] = (float)s;
    }
}

struct NormArgs {
    const float* xl; const float* xc;
    float* ol; float* oc;
    const bf16_t* y;
    const float* gpost; const float* modg; int gate_idx;
    bf16_t* h; const float* gpre; const float* modh; int shift_idx;
    int nrows;
};
__device__ __forceinline__ void norm_rows(const NormArgs& a, int gw, int NGW, int lane) {
    for (int r = gw; r < a.nrows; r += NGW) {
        const bool isl = r < ML;
        const int mrow = isl ? (r >> 11) : 8;
        const float* xin = isl ? a.xl + (size_t)r * DM : a.xc + (size_t)(r - ML) * DM;
        f32x4 v[4];
#pragma unroll
        for (int j = 0; j < 4; ++j) v[j] = *(const f32x4*)(xin + 4 * lane + 256 * j);
        if (a.y) {
            f32x4 yv[4]; float ss = 0.f;
#pragma unroll
            for (int j = 0; j < 4; ++j) { yv[j] = unpack4(*(const u32x2*)(a.y + (size_t)r * DM + 4 * lane + 256 * j)); ss += (yv[j][0] * yv[j][0] + yv[j][1] * yv[j][1]) + (yv[j][2] * yv[j][2] + yv[j][3] * yv[j][3]); }
            const float rstd = rsqrtf(wave_sum(ss) * (1.f / DM) + EPS);
#pragma unroll
            for (int j = 0; j < 4; ++j) {
                const int col = 4 * lane + 256 * j;
                const f32x4 gt = *(const f32x4*)(a.modg + (size_t)mrow * 6144 + a.gate_idx * 1024 + col);
                const f32x4 gp = *(const f32x4*)(a.gpost + col);
                v[j] = v[j] + gt * ((yv[j] * rstd) * gp);
            }
            float* xo = isl ? (a.ol ? a.ol + (size_t)r * DM : nullptr) : (a.oc ? a.oc + (size_t)(r - ML) * DM : nullptr);
            if (xo) {
#pragma unroll
                for (int j = 0; j < 4; ++j) *(f32x4*)(xo + 4 * lane + 256 * j) = v[j];
            }
        }
        if (a.h) {
            float ss = 0.f;
#pragma unroll
            for (int j = 0; j < 4; ++j) ss += (v[j][0] * v[j][0] + v[j][1] * v[j][1]) + (v[j][2] * v[j][2] + v[j][3] * v[j][3]);
            const float rstd = rsqrtf(wave_sum(ss) * (1.f / DM) + EPS);
#pragma unroll
            for (int j = 0; j < 4; ++j) {
                const int col = 4 * lane + 256 * j;
                const f32x4 gp = *(const f32x4*)(a.gpre + col);
                const f32x4 sh = *(const f32x4*)(a.modh + (size_t)mrow * 6144 + a.shift_idx * 1024 + col);
                const f32x4 scl = *(const f32x4*)(a.modh + (size_t)mrow * 6144 + (a.shift_idx + 1) * 1024 + col);
                const f32x4 hv = ((v[j] * rstd) * gp) * (1.f + scl) + sh;
                u32x2 w; w.x = pk2(hv[0], hv[1]); w.y = pk2(hv[2], hv[3]);
                *(u32x2*)(a.h + (size_t)r * DM + col) = w;
            }
        }
    }
}

struct EpiIn {
    bf16_t *Q, *KV, *RX, *PU, *RY, *G; const float* tcos; const float* tsin;
    __device__ __forceinline__ void operator()(int row, int c8, f32x4 v0, f32x4 v1) const {
        if (c8 < 640) {
            if (row < ML) {
                const int s = row & 2047, pp = c8 & 63, Gq = pp >> 3;
                const int pos = (Gq & 4) ? (s & 63) : (s >> 6);
                const int i0 = (Gq & 3) * 4;
                const f32x4 cs = *(const f32x4*)(tcos + pos * 16 + i0), sn = *(const f32x4*)(tsin + pos * 16 + i0);
                const f32x4 a = v0 * cs - v1 * sn, b = v1 * cs + v0 * sn; v0 = a; v1 = b;
            }
            if (c8 < 512) { v0 = v0 * QSCALE; v1 = v1 * QSCALE; *(u32x4*)(Q + (size_t)row * 512 + c8) = pack8(v0, v1); }
            else *(u32x4*)(KV + (size_t)row * 256 + (c8 - 512)) = pack8(v0, v1);
        } else if (c8 < 768) *(u32x4*)(KV + (size_t)row * 256 + 128 + (c8 - 640)) = pack8(v0, v1);
        else if (c8 < 1280) *(u32x4*)(RX + (size_t)row * 512 + (c8 - 768)) = pack8(v0, v1);
        else if (c8 < 1792) *(u32x4*)(RY + (size_t)row * 512 + (c8 - 1280)) = pack8(v0, v1);
        else if (c8 < 2304) *(u32x4*)(PU + (size_t)row * 512 + (c8 - 1792)) = pack8(v0, v1);
        else {
#pragma unroll
            for (int j = 0; j < 4; ++j) { v0[j] = sigm(v0[j]); v1[j] = sigm(v1[j]); }
            *(u32x4*)(G + (size_t)row * 3072 + (c8 - 2304)) = pack8(v0, v1);
        }
    }
};
struct EpiStore {
    bf16_t* O; int ldc;
    __device__ __forceinline__ void operator()(int row, int c8, f32x4 v0, f32x4 v1) const { *(u32x4*)(O + (size_t)row * ldc + c8) = pack8(v0, v1); }
};
struct EpiSwiglu {
    bf16_t* O;
    __device__ __forceinline__ void operator()(int row, int c8, f32x4 v0, f32x4 v1) const {
        f32x4 o;
#pragma unroll
        for (int j = 0; j < 4; ++j) o[j] = v0[j] * sigm(v0[j]) * v1[j];
        u32x2 w; w.x = pk2(o[0], o[1]); w.y = pk2(o[2], o[3]);
        *(u32x2*)(O + (size_t)row * DFF + (c8 >> 1)) = w;
    }
};

__device__ __forceinline__ void gemm_wave_acc(const bf16_t* A, const bf16_t* Bt, int K, int rw, int cw, int fr, int fq, f32x4 (&acc)[4][4]) {
    const bf16_t* ap[4]; const bf16_t* bp[4];
#pragma unroll
    for (int i = 0; i < 4; ++i) ap[i] = A + (size_t)(rw + 16 * i + fr) * K + 8 * fq;
#pragma unroll
    for (int q = 0; q < 4; ++q) bp[q] = Bt + (size_t)(cw + 32 * (q >> 1) + perm32(16 * (q & 1) + fr)) * K + 8 * fq;
#pragma unroll 2
    for (int k = 0; k < K; k += 32) {
        bf16x8 af[4], bfr[4];
#pragma unroll
        for (int i = 0; i < 4; ++i) af[i] = *(const bf16x8*)(ap[i] + k);
#pragma unroll
        for (int q = 0; q < 4; ++q) bfr[q] = *(const bf16x8*)(bp[q] + k);
#pragma unroll
        for (int i = 0; i < 4; ++i)
#pragma unroll
            for (int q = 0; q < 4; ++q) acc[i][q] = __builtin_amdgcn_mfma_f32_16x16x32_bf16(bfr[q], af[i], acc[i][q], 0, 0, 0);
    }
}
template <class Epi>
__device__ __forceinline__ void gemm_simple(const bf16_t* A, const bf16_t* Bt, int K, int row_off, int M, int col_off, int N, const Epi& epi, int bid, int G) {
    const int tid = opaque_tid(), lane = tid & 63, wave = tid >> 6, wr = wave >> 2, wc = wave & 3, fr = lane & 15, fq = lane >> 4;
    const int nM = M / 128, nN = N / 256;
    for (int u = bid; u < nM * nN; u += G) {
        const int pm = u % nM, pn = u / nM;
        const int rw = row_off + pm * 128 + wr * 64, cw = col_off + pn * 256 + wc * 64;
        f32x4 acc[4][4];
#pragma unroll
        for (int i = 0; i < 4; ++i)
#pragma unroll
            for (int q = 0; q < 4; ++q) acc[i][q] = (f32x4){0.f, 0.f, 0.f, 0.f};
        gemm_wave_acc(A, Bt, K, rw, cw, fr, fq, acc);
#pragma unroll
        for (int i = 0; i < 4; ++i)
#pragma unroll
            for (int g = 0; g < 2; ++g) epi(rw + 16 * i + fr, cw + 32 * g + 8 * fq, acc[i][2 * g], acc[i][2 * g + 1]);
    }
}
__device__ __forceinline__ void gemm_merge(const P& p, int M, int bid, int G) {
    const int tid = opaque_tid(), lane = tid & 63, wave = tid >> 6, wr = wave >> 2, wc = wave & 3, fr = lane & 15, fq = lane >> 4;
    const bf16_t* Gt = (const bf16_t*)(p.ws + OFF_G);
    bf16_t* O = (bf16_t*)(p.ws + OFF_MERGED);
    const int nM = M / 128, nN = 8;
    for (int u = bid; u < nM * nN; u += G) {
        const int pm = u % nM, pn = u / nM;
        const int rw = pm * 128 + wr * 64, cw = pn * 128 + wc * 32;
        f32x4 tot[4][2];
#pragma unroll
        for (int i = 0; i < 4; ++i) { tot[i][0] = (f32x4){0.f, 0.f, 0.f, 0.f}; tot[i][1] = (f32x4){0.f, 0.f, 0.f, 0.f}; }
#pragma unroll 1
        for (int s = 0; s < 3; ++s) {
            const bf16_t* A = (const bf16_t*)(p.ws + (s == 0 ? OFF_Q : (s == 1 ? OFF_A : OFF_RY)));
            const bf16_t* Bt = (const bf16_t*)(p.ws + OFF_WA + (s == 0 ? WA_AO : (s == 1 ? WA_PO : WA_RO)));
            f32x4 acc[4][2];
#pragma unroll
            for (int i = 0; i < 4; ++i) { acc[i][0] = (f32x4){0.f, 0.f, 0.f, 0.f}; acc[i][1] = (f32x4){0.f, 0.f, 0.f, 0.f}; }
            const bf16_t* ap = A + (size_t)(rw + fr) * 512 + 8 * fq;
            const bf16_t* bp0 = Bt + (size_t)(cw + perm32(fr)) * 512 + 8 * fq;
            const bf16_t* bp1 = Bt + (size_t)(cw + perm32(16 + fr)) * 512 + 8 * fq;
#pragma unroll 2
            for (int k = 0; k < 512; k += 32) {
                const bf16x8 b0 = *(const bf16x8*)(bp0 + k), b1 = *(const bf16x8*)(bp1 + k);
#pragma unroll
                for (int i = 0; i < 4; ++i) {
                    const bf16x8 af = *(const bf16x8*)(ap + (size_t)(16 * i) * 512 + k);
                    acc[i][0] = __builtin_amdgcn_mfma_f32_16x16x32_bf16(b0, af, acc[i][0], 0, 0, 0);
                    acc[i][1] = __builtin_amdgcn_mfma_f32_16x16x32_bf16(b1, af, acc[i][1], 0, 0, 0);
                }
            }
#pragma unroll
            for (int i = 0; i < 4; ++i) {
                f32x4 g0, g1; unpack8(*(const u32x4*)(Gt + (size_t)(rw + 16 * i + fr) * 3072 + s * 1024 + cw + 8 * fq), g0, g1);
                tot[i][0] += g0 * acc[i][0]; tot[i][1] += g1 * acc[i][1];
            }
        }
#pragma unroll
        for (int i = 0; i < 4; ++i) *(u32x4*)(O + (size_t)(rw + 16 * i + fr) * DM + cw + 8 * fq) = pack8(tot[i][0], tot[i][1]);
    }
}

__device__ __forceinline__ void attn_item(unsigned char* lds, bf16_t* Qb, const bf16_t* KVb, const float* sink, int qrow0, int kvh, int npos0, int b) {
    const int tid = opaque_tid(), lane = tid & 63, wave = tid >> 6, r32 = lane & 31, hi = lane >> 5;
    bf16_t* Ks = (bf16_t*)lds;
    bf16_t* Vt = (bf16_t*)(lds + 9216);
    const int hq = kvh * 4 + (wave >> 1);
    const int qoff = (wave & 1) * 32;
    bf16x8 qf[4];
#pragma unroll
    for (int ks = 0; ks < 4; ++ks) qf[ks] = *(const bf16x8*)(Qb + (size_t)(qrow0 + qoff + r32) * 512 + hq * 64 + 16 * ks + 8 * hi);
    f32x16 o[2];
#pragma unroll
    for (int dt = 0; dt < 2; ++dt)
#pragma unroll
        for (int r = 0; r < 16; ++r) o[dt][r] = 0.f;
    float m = sink[hq] * LOG2E, l = (hi == 0) ? 1.f : 0.f;
    const int ntl = (npos0 >= 0) ? 5 : 0;
    const int qp0 = npos0 + qoff;
#pragma unroll 1
    for (int ti = 0; ti < ntl + 4; ++ti) {
        int krow0, kp0 = 0; bool masked;
        if (ti < ntl) { kp0 = npos0 - 128 + 64 * ti; if (kp0 < 0 || kp0 >= SEQ) continue; krow0 = b * SEQ + kp0; masked = true; }
        else { krow0 = ML + b * CTX + 64 * (ti - ntl); masked = false; }
        __syncthreads();
        {
            const int key = tid >> 3, ch = tid & 7;
            const bf16_t* src = KVb + (size_t)(krow0 + key) * 256 + kvh * 64 + ch * 8;
            const u32x4 kv = *(const u32x4*)src; const u32x4 vv = *(const u32x4*)(src + 128);
            *(u32x4*)(Ks + key * 72 + ch * 8) = kv;
            const unsigned w[4] = {vv.x, vv.y, vv.z, vv.w};
#pragma unroll
            for (int e = 0; e < 8; ++e) Vt[(ch * 8 + e) * 72 + key] = (bf16_t)((w[e >> 1] >> (16 * (e & 1))) & 0xffffu);
        }
        __syncthreads();
        if (masked && (kp0 - (qp0 + 31) > 128 || qp0 - (kp0 + 63) > 128)) continue;
        f32x16 p0, p1;
#pragma unroll
        for (int r = 0; r < 16; ++r) { p0[r] = 0.f; p1[r] = 0.f; }
#pragma unroll
        for (int ks = 0; ks < 4; ++ks) {
            const bf16x8 k0 = *(const bf16x8*)(Ks + r32 * 72 + 16 * ks + 8 * hi);
            const bf16x8 k1 = *(const bf16x8*)(Ks + (32 + r32) * 72 + 16 * ks + 8 * hi);
            p0 = __builtin_amdgcn_mfma_f32_32x32x16_bf16(k0, qf[ks], p0, 0, 0, 0);
            p1 = __builtin_amdgcn_mfma_f32_32x32x16_bf16(k1, qf[ks], p1, 0, 0, 0);
        }
        if (masked) {
            const int qp = qp0 + r32;
#pragma unroll
            for (int r = 0; r < 16; ++r) {
                const int d0 = qp - (kp0 + crow(r, hi)), d1 = d0 - 32;
                if (d0 > 128 || d0 < -128) p0[r] = -1e30f;
                if (d1 > 128 || d1 < -128) p1[r] = -1e30f;
            }
        }
        float mx = fmaxf(p0[0], p1[0]);
#pragma unroll
        for (int r = 1; r < 16; ++r) mx = fmaxf(mx, fmaxf(p0[r], p1[r]));
        mx = fmaxf(mx, __shfl_xor(mx, 32));
        const float mn = fmaxf(m, mx);
        const float alpha = __builtin_amdgcn_exp2f(m - mn);
        m = mn;
        float rs = 0.f;
#pragma unroll
        for (int r = 0; r < 16; ++r) { p0[r] = __builtin_amdgcn_exp2f(p0[r] - mn); p1[r] = __builtin_amdgcn_exp2f(p1[r] - mn); rs += p0[r] + p1[r]; }
        l = l * alpha + rs;
#pragma unroll
        for (int dt = 0; dt < 2; ++dt)
#pragma unroll
            for (int r = 0; r < 16; ++r) o[dt][r] *= alpha;
#pragma unroll
        for (int s4 = 0; s4 < 4; ++s4) {
            u32x4 pw;
            if (s4 < 2) { const int o8 = 8 * s4; pw.x = pk2(p0[o8], p0[o8 + 1]); pw.y = pk2(p0[o8 + 2], p0[o8 + 3]); pw.z = pk2(p0[o8 + 4], p0[o8 + 5]); pw.w = pk2(p0[o8 + 6], p0[o8 + 7]); }
            else { const int o8 = 8 * (s4 - 2); pw.x = pk2(p1[o8], p1[o8 + 1]); pw.y = pk2(p1[o8 + 2], p1[o8 + 3]); pw.z = pk2(p1[o8 + 4], p1[o8 + 5]); pw.w = pk2(p1[o8 + 6], p1[o8 + 7]); }
            const bf16x8 pf = __builtin_bit_cast(bf16x8, pw);
            const int keybase = 32 * (s4 >> 1) + 16 * (s4 & 1) + 4 * hi;
#pragma unroll
            for (int dt = 0; dt < 2; ++dt) {
                const int d = 32 * dt + r32;
                const s16x4 lo = *(const s16x4*)(Vt + d * 72 + keybase);
                const s16x4 hh = *(const s16x4*)(Vt + d * 72 + keybase + 8);
                const bf16x8 vf = (bf16x8){lo[0], lo[1], lo[2], lo[3], hh[0], hh[1], hh[2], hh[3]};
                o[dt] = __builtin_amdgcn_mfma_f32_32x32x16_bf16(vf, pf, o[dt], 0, 0, 0);
            }
        }
    }
    {
        const float lt = l + __shfl_xor(l, 32);
        const float inv = 1.f / lt;
        bf16_t* orow = Qb + (size_t)(qrow0 + qoff + r32) * 512 + hq * 64;
#pragma unroll
        for (int dt = 0; dt < 2; ++dt)
#pragma unroll
            for (int rg = 0; rg < 4; ++rg) {
                u32x2 w; w.x = pk2(o[dt][4 * rg] * inv, o[dt][4 * rg + 1] * inv); w.y = pk2(o[dt][4 * rg + 2] * inv, o[dt][4 * rg + 3] * inv);
                *(u32x2*)(orow + 32 * dt + 8 * rg + 4 * hi) = w;
            }
    }
    __syncthreads();
}

__device__ __forceinline__ void pool_item(const P& p, int l, unsigned char* lds, int rb, int L, int t0, int g) {
    const int tid = opaque_tid(), lane = tid & 63, wave = tid >> 6, fr = lane & 15, fq = lane >> 4;
    bf16_t* U = (bf16_t*)lds;
    bf16_t* Dt = (bf16_t*)(lds + 20480);
    const bf16_t* PUb = (const bf16_t*)(p.ws + OFF_PU);
    bf16_t* PO = (bf16_t*)(p.ws + OFF_A);
    const bf16_t* PMt = (const bf16_t*)(p.ws + OFF_WA + WA_PM);
    for (int idx = tid; idx < 80 * 16; idx += NTHREADS) {
        const int rr = idx >> 4, ch = idx & 15, t = t0 - 7 + rr;
        u32x4 v = (u32x4){0u, 0u, 0u, 0u};
        if (t >= 0 && t < L) v = *(const u32x4*)(PUb + (size_t)(rb + t) * 512 + g * 128 + ch * 8);
        *(u32x4*)(U + rr * 128 + ch * 8) = v;
    }
    __syncthreads();
    const int w = 2 << g, offL = (w - 1) / 2, offR = w / 2;
    for (int idx = tid; idx < 64 * 128; idx += NTHREADS) {
        const int tt = idx >> 7, c = idx & 127, t = t0 + tt;
        const int lo = max(t - offL, 0), hi = min(t + offR + 1, L);
        float s = 0.f;
        for (int u = lo; u < hi; ++u) s += bf2f(U[(u - t0 + 7) * 128 + c]);
        const float d = s / (float)(hi - lo) - bf2f(U[(tt + 7) * 128 + c]);
        Dt[tt * 136 + c] = (bf16_t)f2bf(d);
    }
    __syncthreads();
    const int mt = wave & 3, nh = wave >> 2;
    f32x4 acc[4];
#pragma unroll
    for (int nt = 0; nt < 4; ++nt) acc[nt] = (f32x4){0.f, 0.f, 0.f, 0.f};
#pragma unroll
    for (int ks = 0; ks < 4; ++ks) {
        const bf16x8 af = *(const bf16x8*)(Dt + (16 * mt + fr) * 136 + 32 * ks + 8 * fq);
#pragma unroll
        for (int nt = 0; nt < 4; ++nt) {
            const bf16x8 bfr = *(const bf16x8*)(PMt + (size_t)(g * 128 + nh * 64 + 16 * nt + fr) * 128 + 32 * ks + 8 * fq);
            acc[nt] = __builtin_amdgcn_mfma_f32_16x16x32_bf16(bfr, af, acc[nt], 0, 0, 0);
        }
    }
#pragma unroll
    for (int nt = 0; nt < 4; ++nt) {
        const int col = g * 128 + nh * 64 + 16 * nt + 4 * fq;
        const f32x4 sc = *(const f32x4*)(p.in[I_PSCALE] + l * 512 + col);
        const f32x4 v = acc[nt] * sc;
        u32x2 wv; wv.x = pk2(v[0], v[1]); wv.y = pk2(v[2], v[3]);
        *(u32x2*)(PO + (size_t)(rb + t0 + 16 * mt + fr) * 512 + col) = wv;
    }
    __syncthreads();
}

__device__ __forceinline__ void rnn_item(const P& p, int l, unsigned char* lds, int b, int hb, bool need_ctx) {
    const int tid = opaque_tid(), half = tid >> 8, ht = tid & 255, lane = tid & 63, hw = (tid >> 6) & 3, fr = lane & 15, fq = lane >> 4;
    const int d = half;
    unsigned char* hl = lds + half * 58368;
    float* XL = (float*)hl;
    bf16_t* XA = (bf16_t*)(hl + 16384);
    float* CA = (float*)(hl + 25600);
    float* CB = (float*)(hl + 41984);
    const bf16_t* RXb = (const bf16_t*)(p.ws + OFF_RX);
    bf16_t* RYb = (bf16_t*)(p.ws + OFF_RY);
    bf16_t* Sb = (bf16_t*)(p.ws + OFF_A + 18 * MiB);
    const bf16_t* LA = (const bf16_t*)(p.ws + OFF_WA + WA_LA) + (size_t)(d * 8 + hb) * 4096;
    const bf16_t* LX = (const bf16_t*)(p.ws + OFF_WA + WA_LX) + (size_t)(d * 8 + hb) * 4096;
    float ba[4], bx[4], ls[4];
#pragma unroll
    for (int nt = 0; nt < 4; ++nt) {
        const int c = (l * 2 + d) * 512 + hb * 64 + 16 * nt + fr;
        ba[nt] = p.in[I_LBA][c]; bx[nt] = p.in[I_LBX][c];
        const float lam = p.in[I_LAM][c];
        ls[nt] = -8.f * log1pf(__expf(-lam));
    }
    const int cc = ht & 63, tq = ht >> 6;
    float cw[4];
#pragma unroll
    for (int k = 0; k < 4; ++k) cw[k] = p.in[I_CONVW][(l * 4 + k) * 512 + hb * 64 + cc];
    const float cbias = p.in[I_CONVB][l * 512 + hb * 64 + cc];
    float hstate = 0.f;
#pragma unroll 1
    for (int st = 0; st < 36; ++st) {
        const int cj = (d == 0) ? st : (st < 4 ? 3 - st : 39 - st);
        const bool isctx = cj < 4;
        const int segpos0 = isctx ? cj * 64 : cj * 64 - 256;
        const int L = isctx ? CTX : SEQ;
        const int rowbase = isctx ? (ML + b * CTX + segpos0) : (b * SEQ + segpos0);
        {
            const bf16_t* rxp = RXb + (size_t)rowbase * 512 + hb * 64 + cc;
            const int tb = tq * 16;
            float xm1, x0, xp1;
            { const int sp = segpos0 + tb - 1; xm1 = (sp >= 0 && sp < L) ? bf2f(rxp[(ptrdiff_t)(tb - 1) * 512]) : 0.f; }
            { const int sp = segpos0 + tb;     x0  = (sp >= 0 && sp < L) ? bf2f(rxp[(ptrdiff_t)(tb) * 512]) : 0.f; }
            { const int sp = segpos0 + tb + 1; xp1 = (sp >= 0 && sp < L) ? bf2f(rxp[(ptrdiff_t)(tb + 1) * 512]) : 0.f; }
#pragma unroll 4
            for (int i = 0; i < 16; ++i) {
                const int t = tb + i, sp = segpos0 + t + 2;
                const float xp2 = (sp >= 0 && sp < L) ? bf2f(rxp[(ptrdiff_t)(t + 2) * 512]) : 0.f;
                const float v = cbias + cw[0] * xm1 + cw[1] * x0 + cw[2] * xp1 + cw[3] * xp2;
                XL[t * 64 + cc] = v; XA[t * 72 + cc] = (bf16_t)f2bf(v);
                xm1 = x0; x0 = xp1; xp1 = xp2;
            }
        }
        __syncthreads();
        {
            f32x4 ga[4], gx[4];
#pragma unroll
            for (int nt = 0; nt < 4; ++nt) { ga[nt] = (f32x4){0.f, 0.f, 0.f, 0.f}; gx[nt] = (f32x4){0.f, 0.f, 0.f, 0.f}; }
#pragma unroll
            for (int ks = 0; ks < 2; ++ks) {
                const bf16x8 af = *(const bf16x8*)(XA + (16 * hw + fr) * 72 + 32 * ks + 8 * fq);
#pragma unroll
                for (int nt = 0; nt < 4; ++nt) {
                    const bf16x8 wa = *(const bf16x8*)(LA + (16 * nt + fr) * 64 + 32 * ks + 8 * fq);
                    const bf16x8 wx = *(const bf16x8*)(LX + (16 * nt + fr) * 64 + 32 * ks + 8 * fq);
                    ga[nt] = __builtin_amdgcn_mfma_f32_16x16x32_bf16(af, wa, ga[nt], 0, 0, 0);
                    gx[nt] = __builtin_amdgcn_mfma_f32_16x16x32_bf16(af, wx, gx[nt], 0, 0, 0);
                }
            }
#pragma unroll
            for (int nt = 0; nt < 4; ++nt)
#pragma unroll
                for (int rg = 0; rg < 4; ++rg) {
                    const int tk = 16 * hw + 4 * fq + rg, c = 16 * nt + fr;
                    const float r = sigm(ga[nt][rg] + ba[nt]);
                    const float ig = sigm(gx[nt][rg] + bx[nt]);
                    const float la = ls[nt] * r;
                    const float a = __expf(la);
                    const float mult = sqrtf(fmaxf(1.f - a * a, 0.f));
                    CA[tk * 64 + c] = a;
                    CB[tk * 64 + c] = mult * ig * XL[tk * 64 + c];
                }
        }
        __syncthreads();
        if (hw == 0) {
            if (d == 0) {
#pragma unroll 8
                for (int t = 0; t < 64; ++t) { hstate = CA[t * 64 + lane] * hstate + CB[t * 64 + lane]; CB[t * 64 + lane] = hstate; }
            } else {
#pragma unroll 8
                for (int t = 63; t >= 0; --t) { hstate = CA[t * 64 + lane] * hstate + CB[t * 64 + lane]; CB[t * 64 + lane] = hstate; }
            }
        }
        __syncthreads();
        if (!isctx || need_ctx) {
            const bool first = (d == 0) ? (isctx ? (cj < 2) : (cj <= 19)) : (isctx ? (cj >= 2) : (cj >= 20));
#pragma unroll
            for (int it = 0; it < 2; ++it) {
                const int idx = ht + 256 * it, t = idx >> 3, c8 = (idx & 7) * 8;
                const f32x4 h0 = *(const f32x4*)(CB + t * 64 + c8), h1 = *(const f32x4*)(CB + t * 64 + c8 + 4);
                const size_t off = (size_t)(rowbase + t) * 512 + hb * 64 + c8;
                if (first) *(u32x4*)(Sb + off) = pack8(h0, h1);
                else {
                    f32x4 s0, s1, y0, y1; unpack8(*(const u32x4*)(Sb + off), s0, s1); unpack8(*(const u32x4*)(RYb + off), y0, y1);
                    f32x4 o0, o1;
#pragma unroll
                    for (int j = 0; j < 4; ++j) { o0[j] = (h0[j] + s0[j]) * gelu_tanh(y0[j]); o1[j] = (h1[j] + s1[j]) * gelu_tanh(y1[j]); }
                    *(u32x4*)(RYb + off) = pack8(o0, o1);
                }
            }
        }
    }
    __syncthreads();
}

__device__ __forceinline__ void run_phase(const P& p, int ph, unsigned char* lds) {
    const int tid = opaque_tid(), lane = tid & 63, wave = tid >> 6;
    const int bid = blockIdx.x, G = gridDim.x;
    const int gw = bid * NWAVES + wave, NGW = G * NWAVES;
    float* scr = (float*)(lds + wave * 16384);
    const float* mod = (const float*)(p.ws + OFF_MOD);
    bf16_t* Hb = (bf16_t*)(p.ws + OFF_A);
    float* XC = (float*)(p.ws + OFF_XC);
    if (ph == 0) {
        for (int it = bid; it < 192; it += G) mod_item(p, lds, it);
        if (bid == (192 % G)) table_item(p);
        __syncthreads();
        convert_WA(p, 0, scr, gw, NGW, lane);
        return;
    }
    if (ph == 1) {
        NormArgs a{}; a.xl = p.in[I_X]; a.xc = p.in[I_CTX]; a.y = nullptr; a.h = Hb; a.gpre = p.in[I_GPREMIX]; a.modh = mod; a.shift_idx = 0; a.nrows = MA;
        norm_rows(a, gw, NGW, lane);
        return;
    }
    const int l = (ph - 2) >> 3, sp = (ph - 2) & 7;
    const bool last = (l == 1);
    const int Mrows = last ? ML : MA;
    const float* modl = mod + (size_t)l * 9 * 6144;
    if (sp == 0) {
        EpiIn e{(bf16_t*)(p.ws + OFF_Q), (bf16_t*)(p.ws + OFF_KV), (bf16_t*)(p.ws + OFF_RX), (bf16_t*)(p.ws + OFF_PU), (bf16_t*)(p.ws + OFF_RY), (bf16_t*)(p.ws + OFF_G),
                (const float*)(p.ws + OFF_TAB), (const float*)(p.ws + OFF_TAB) + 1024};
        const bf16_t* Wt = (const bf16_t*)(p.ws + OFF_WA + WA_IN);
        if (!last) gemm_simple(Hb, Wt, DM, 0, MA, 0, INW, e, bid, G);
        else { gemm_simple(Hb, Wt, DM, 0, ML, 0, INW, e, bid, G); gemm_simple(Hb, Wt, DM, ML, MC, 512, 768, e, bid, G); }
        return;
    }
    if (sp == 1) {
        const bool need_ctx = !last;
        const bool split = (G >= 128);
        if (split && bid < 64) { rnn_item(p, l, lds, bid >> 3, bid & 7, need_ctx); return; }
        if (!split) for (int it = bid; it < 64; it += G) rnn_item(p, l, lds, it >> 3, it & 7, need_ctx);
        const int vb = split ? bid - 64 : bid, VG = split ? G - 64 : G;
        const int nAL = 512, nAC = need_ctx ? 64 : 0, nPL = 1024, nPC = need_ctx ? 128 : 0;
        bf16_t* Qb = (bf16_t*)(p.ws + OFF_Q); const bf16_t* KVb = (const bf16_t*)(p.ws + OFF_KV);
        const float* sink = p.in[I_SINK] + l * 8;
        for (int it = vb; it < nAL + nAC + nPL + nPC; it += VG) {
            int r = it;
            if (r < nAL + nAC) {
                int b, qrow0, npos0; const int kvh = r & 1;
                if (r < nAL) { b = r >> 6; const int qb = (r >> 1) & 31; qrow0 = b * SEQ + 64 * qb; npos0 = 64 * qb; }
                else { const int rc = r - nAL; b = rc >> 3; const int qb = (rc >> 1) & 3; qrow0 = ML + b * CTX + 64 * qb; npos0 = -1; }
                attn_item(lds, Qb, KVb, sink, qrow0, kvh, npos0, b);
                continue;
            }
            r -= nAL + nAC;
            int b, tile, rb, L; const int g = r & 3;
            if (r < nPL) { b = r >> 7; tile = (r >> 2) & 31; rb = b * SEQ; L = SEQ; }
            else { const int rc = r - nPL; b = rc >> 4; tile = (rc >> 2) & 3; rb = ML + b * CTX; L = CTX; }
            pool_item(p, l, lds, rb, L, tile * 64, g);
        }
        return;
    }
    if (sp == 2) { gemm_merge(p, Mrows, bid, G); return; }
    if (sp == 3) {
        EpiStore e{(bf16_t*)(p.ws + OFF_G), DM};
        gemm_simple((const bf16_t*)(p.ws + OFF_MERGED), (const bf16_t*)(p.ws + OFF_WA + WA_OUT), DM, 0, Mrows, 0, DM, e, bid, G);
        return;
    }
    if (sp == 4) {
        NormArgs a{};
        a.xl = (l == 0) ? p.in[I_X] : p.out; a.xc = (l == 0) ? p.in[I_CTX] : XC; a.ol = p.out; a.oc = XC;
        a.y = (const bf16_t*)(p.ws + OFF_G); a.gpost = p.in[I_GPOSTMIX] + l * DM; a.modg = modl; a.gate_idx = 2;
        a.h = Hb; a.gpre = p.in[I_GPREFFN] + l * DM; a.modh = modl; a.shift_idx = 3; a.nrows = Mrows;
        norm_rows(a, gw, NGW, lane);
        convert_WB(p, l, scr, gw, NGW, lane);
        return;
    }
    if (sp == 5) {
        EpiSwiglu e{(bf16_t*)(p.ws + OFF_G)};
        gemm_simple(Hb, (const bf16_t*)(p.ws + OFF_WB + WB_GU), DM, 0, Mrows, 0, NGU, e, bid, G);
        return;
    }
    if (sp == 6) {
        EpiStore e{(bf16_t*)(p.ws + OFF_F), DM};
        gemm_simple((const bf16_t*)(p.ws + OFF_G), (const bf16_t*)(p.ws + OFF_WB + WB_DOWN), DFF, 0, Mrows, 0, DM, e, bid, G);
        return;
    }
    {
        NormArgs a{};
        a.xl = p.out; a.xc = XC; a.ol = p.out; a.oc = XC;
        a.y = (const bf16_t*)(p.ws + OFF_F); a.gpost = p.in[I_GPOSTFFN] + l * DM; a.modg = modl; a.gate_idx = 5;
        if (!last) { a.h = Hb; a.gpre = p.in[I_GPREMIX] + (l + 1) * DM; a.modh = mod + (size_t)(l + 1) * 9 * 6144; a.shift_idx = 0; }
        a.nrows = Mrows;
        norm_rows(a, gw, NGW, lane);
        if (!last) convert_WA(p, l + 1, scr, gw, NGW, lane);
    }
}

__global__ void __launch_bounds__(NTHREADS) mega(P p) {
    extern __shared__ __attribute__((aligned(16))) unsigned char lds[];
    for (int ph = p.ph_lo; ph < p.ph_hi; ++ph) {
        run_phase(p, ph, lds);
        if (ph + 1 < p.ph_hi) { cg::this_grid().sync(); }
    }
}

extern "C" void kernel_launch(void* const* d_in, const int* in_sizes, int n_in, void* d_out, int out_size, void* d_ws, size_t ws_size, hipStream_t stream) {
    static int grid = 0;
    if (grid == 0) {
        if (n_in != 27 || ws_size < WS_NEED) { fprintf(stderr, "kernel_launch: unexpected n_in %d or ws_size %zu\n", n_in, ws_size); grid = -1; return; }
        int dev = 0, cus = 0, per_cu = 0;
        hipGetDevice(&dev);
        hipDeviceGetAttribute(&cus, hipDeviceAttributeMultiprocessorCount, dev);
        hipFuncSetAttribute((const void*)mega, hipFuncAttributeMaxDynamicSharedMemorySize, LDS_BYTES);
        hipOccupancyMaxActiveBlocksPerMultiprocessor(&per_cu, (const void*)mega, NTHREADS, LDS_BYTES);
        if (per_cu < 1) { fprintf(stderr, "kernel_launch: occupancy query says %d blocks per CU\n", per_cu); per_cu = 1; }
        grid = cus;
    }
    if (grid < 0) return;
    hipMemsetAsync((char*)d_ws + OFF_CTL, 0, 1 * MiB, stream);
    P p{};
    for (int i = 0; i < 27; ++i) p.in[i] = (const float*)d_in[i];
    p.out = (float*)d_out; p.ws = (unsigned char*)d_ws;
#if PER_PHASE_LAUNCH
    for (int ph = 0; ph < NPHASES; ++ph) {
        p.ph_lo = ph; p.ph_hi = ph + 1;
        hipLaunchKernelGGL(mega, dim3(grid), dim3(NTHREADS), LDS_BYTES, stream, p);
    }
#else
    p.ph_lo = 0; p.ph_hi = NPHASES;
    void* args[] = {&p};
    hipError_t e = hipLaunchCooperativeKernel((const void*)mega, dim3(grid), dim3(NTHREADS), args, LDS_BYTES, stream);
    if (e != hipSuccess) fprintf(stderr, "cooperative launch failed: %s (grid %d)\n", hipGetErrorString(e), grid);
#endif
}
```

```cpp
#include <hip/hip_runtime.h>
#include <hip/hip_cooperative_groups.h>
#include <cstdio>
#include <cstdint>
namespace cg = cooperative_groups;

#ifndef PER_PHASE_LAUNCH
#define PER_PHASE_LAUNCH 0
#endif

typedef unsigned short bf16_t;
typedef short bf16x8 __attribute__((ext_vector_type(8)));
typedef short s16x4 __attribute__((ext_vector_type(4)));
typedef float f32x4 __attribute__((ext_vector_type(4)));
typedef float f32x16 __attribute__((ext_vector_type(16)));
typedef unsigned u32x4 __attribute__((ext_vector_type(4)));
typedef unsigned u32x2 __attribute__((ext_vector_type(2)));

constexpr int DM = 1024, NBATCH = 8, SEQ = 2048, CTX = 256;
constexpr int ML = NBATCH * SEQ;
constexpr int MC = NBATCH * CTX;
constexpr int MA = ML + MC;
constexpr int INW = 5376, DFF = 2816, NGU = 5632;
constexpr float EPS = 1e-6f;
constexpr float LOG2E = 1.4426950408889634f;
constexpr float QSCALE = 0.125f * LOG2E;
constexpr int NTHREADS = 512, NWAVES = 8;
constexpr int LDS_BYTES = 147456;
constexpr int NPHASES = 18;

constexpr size_t MiB = 1u << 20;
constexpr size_t OFF_CTL = 0;
constexpr size_t OFF_TAB = 1 * MiB;
constexpr size_t OFF_MOD = 1 * MiB + 65536;
constexpr size_t OFF_WA = 2 * MiB;
constexpr size_t WA_IN = 0, WA_AO = 11010048, WA_PO = WA_AO + 1048576, WA_RO = WA_PO + 1048576, WA_OUT = WA_RO + 1048576,
                 WA_PM = WA_OUT + 2097152, WA_LA = WA_PM + 131072, WA_LX = WA_LA + 131072;
constexpr size_t OFF_A = 18 * MiB;
constexpr size_t OFF_Q = 54 * MiB;
constexpr size_t OFF_KV = 72 * MiB;
constexpr size_t OFF_RX = 81 * MiB;
constexpr size_t OFF_PU = 99 * MiB;
constexpr size_t OFF_RY = 117 * MiB;
constexpr size_t OFF_MERGED = OFF_RX;
constexpr size_t OFF_F = OFF_Q;
constexpr size_t OFF_WB = 94 * MiB;
constexpr size_t WB_GU = 0, WB_DOWN = 11534336;
constexpr size_t OFF_G = 135 * MiB;
constexpr size_t OFF_XC = 243 * MiB;
constexpr size_t WS_NEED = 251 * MiB;

struct P {
    const float* in[27];
    float* out;
    unsigned char* ws;
    int ph_lo, ph_hi;
};
enum { I_X = 0, I_C, I_CTX, I_CCTX, I_WADA, I_BADA, I_GPREMIX, I_GPOSTMIX, I_GPREFFN, I_GPOSTFFN, I_WIN, I_SINK, I_WAO, I_PMIX, I_PSCALE, I_WPO,
       I_CONVW, I_CONVB, I_LWA, I_LBA, I_LWX, I_LBX, I_LAM, I_WRO, I_WOUT, I_WGU, I_WDOWN };

__device__ __forceinline__ float bf2f(unsigned v) { return __uint_as_float(v << 16); }
__device__ __forceinline__ unsigned f2bf(float f) { unsigned u = __float_as_uint(f); return (u + 0x7fffu + ((u >> 16) & 1u)) >> 16; }
__device__ __forceinline__ unsigned pk2(float lo, float hi) { return f2bf(lo) | (f2bf(hi) << 16); }
__device__ __forceinline__ float wave_sum(float v) {
#pragma unroll
    for (int o = 1; o < 64; o <<= 1) v += __shfl_xor(v, o);
    return v;
}
__device__ __forceinline__ float sigm(float x) { return 1.f / (1.f + __expf(-x)); }
__device__ __forceinline__ float gelu_tanh(float y) {
    const float z = 0.7978845608028654f * (y + 0.044715f * y * y * y);
    const float t = 1.f - 2.f / (1.f + __expf(2.f * z));
    return 0.5f * y * (1.f + t);
}
__device__ __forceinline__ int crow(int r, int hi) { return (r & 3) + 8 * (r >> 2) + 4 * hi; }
__device__ __forceinline__ int perm32(int rho) { const int n = rho >> 4, i = rho & 15; return 8 * (i >> 2) + 4 * n + (i & 3); }
#define LDS_WAIT() asm volatile("s_waitcnt lgkmcnt(0)" ::: "memory")
__device__ __forceinline__ int opaque_tid() { int t = threadIdx.x; asm volatile("" : "+v"(t)); return t; }
__device__ __forceinline__ f32x4 unpack4(u32x2 w) { return (f32x4){bf2f(w.x & 0xffffu), bf2f(w.x >> 16), bf2f(w.y & 0xffffu), bf2f(w.y >> 16)}; }
__device__ __forceinline__ void unpack8(u32x4 w, f32x4& a, f32x4& b) {
    a = (f32x4){bf2f(w.x & 0xffffu), bf2f(w.x >> 16), bf2f(w.y & 0xffffu), bf2f(w.y >> 16)};
    b = (f32x4){bf2f(w.z & 0xffffu), bf2f(w.z >> 16), bf2f(w.w & 0xffffu), bf2f(w.w >> 16)};
}
__device__ __forceinline__ u32x4 pack8(f32x4 a, f32x4 b) { u32x4 w; w.x = pk2(a[0], a[1]); w.y = pk2(a[2], a[3]); w.z = pk2(b[0], b[1]); w.w = pk2(b[2], b[3]); return w; }

__constant__ float ROPE_INV[16] = {1.0f, 0.5623413251903491f, 0.31622776601683794f, 0.1778279410038923f, 0.1f, 0.05623413251903491f, 0.03162277660168379f,
                                   0.01778279410038923f, 0.01f, 0.005623413251903491f, 0.003162277660168379f, 0.001778279410038923f, 0.001f,
                                   0.0005623413251903491f, 0.0003162277660168379f, 0.0001778279410038923f};

__device__ __forceinline__ int src_col(int mode, int n) {
    if (mode == 1) {
        if (n >= 640) return n;
        const int p = n & 63, hb = n - p, G = p >> 3, j = p & 7, half = G >> 2, g = G & 3;
        const int dim = half * 32 + ((j < 4) ? (4 * g + j) : (16 + 4 * g + (j - 4)));
        return hb + dim;
    }
    if (mode == 2) {
        const int q = n >> 3, t = n & 7;
        return (t < 4) ? (4 * q + t) : (DFF + 4 * q + (t - 4));
    }
    return n;
}
__device__ __forceinline__ void tr_item(const float* W, int K, int N, int Nout, bf16_t* WT, float* scr, int item, int lane, int mode) {
    const int nblk = Nout / 32, kb = item / nblk, nb = item % nblk, k0 = 64 * kb, n0 = 32 * nb;
    const int sc = src_col(mode, n0 + (lane & 31));
#pragma unroll 8
    for (int i = 0; i < 32; ++i) { const int kk = 2 * i + (lane >> 5); scr[kk * 33 + (lane & 31)] = W[(size_t)(k0 + kk) * N + sc]; }
    LDS_WAIT(); asm volatile("" ::: "memory");
    const int c = lane & 7;
#pragma unroll
    for (int j = 0; j < 4; ++j) {
        const int n = (lane >> 3) + 8 * j; const float* s = scr + (8 * c) * 33 + n;
        u32x4 o; o.x = pk2(s[0 * 33], s[1 * 33]); o.y = pk2(s[2 * 33], s[3 * 33]); o.z = pk2(s[4 * 33], s[5 * 33]); o.w = pk2(s[6 * 33], s[7 * 33]);
        *(u32x4*)(WT + (size_t)(n0 + n) * K + k0 + 8 * c) = o;
    }
    LDS_WAIT(); asm volatile("" ::: "memory");
}
constexpr int WA_ITEMS = 2688 + 3 * 256 + 512 + 32 + 32 + 32;
constexpr int WB_ITEMS = 2816 + 1408;
__device__ __forceinline__ void convert_WA(const P& p, int l, float* scr, int gw, int NGW, int lane) {
    unsigned char* wa = p.ws + OFF_WA;
    for (int it = gw; it < WA_ITEMS; it += NGW) {
        int r = it;
        if (r < 2688) { tr_item(p.in[I_WIN] + (size_t)l * DM * INW, DM, INW, INW, (bf16_t*)(wa + WA_IN), scr, r, lane, 1); continue; } r -= 2688;
        if (r < 256) { tr_item(p.in[I_WAO] + (size_t)l * 512 * DM, 512, DM, DM, (bf16_t*)(wa + WA_AO), scr, r, lane, 0); continue; } r -= 256;
        if (r < 256) { tr_item(p.in[I_WPO] + (size_t)l * 512 * DM, 512, DM, DM, (bf16_t*)(wa + WA_PO), scr, r, lane, 0); continue; } r -= 256;
        if (r < 256) { tr_item(p.in[I_WRO] + (size_t)l * 512 * DM, 512, DM, DM, (bf16_t*)(wa + WA_RO), scr, r, lane, 0); continue; } r -= 256;
        if (r < 512) { tr_item(p.in[I_WOUT] + (size_t)l * DM * DM, DM, DM, DM, (bf16_t*)(wa + WA_OUT), scr, r, lane, 0); continue; } r -= 512;
        if (r < 32) { const int g = r >> 3; tr_item(p.in[I_PMIX] + (size_t)(l * 4 + g) * 16384, 128, 128, 128, (bf16_t*)(wa + WA_PM) + g * 16384, scr, r & 7, lane, 0); continue; } r -= 32;
        if (r < 32) { const int m = r >> 1; tr_item(p.in[I_LWA] + (size_t)(l * 16 + m) * 4096, 64, 64, 64, (bf16_t*)(wa + WA_LA) + m * 4096, scr, r & 1, lane, 0); continue; } r -= 32;
        { const int m = r >> 1; tr_item(p.in[I_LWX] + (size_t)(l * 16 + m) * 4096, 64, 64, 64, (bf16_t*)(wa + WA_LX) + m * 4096, scr, r & 1, lane, 0); }
    }
}
__device__ __forceinline__ void convert_WB(const P& p, int l, float* scr, int gw, int NGW, int lane) {
    unsigned char* wb = p.ws + OFF_WB;
    for (int it = gw; it < WB_ITEMS; it += NGW) {
        int r = it;
        if (r < 2816) { tr_item(p.in[I_WGU] + (size_t)l * DM * NGU, DM, NGU, NGU, (bf16_t*)(wb + WB_GU), scr, r, lane, 2); continue; } r -= 2816;
        tr_item(p.in[I_WDOWN] + (size_t)l * DFF * DM, DFF, DM, DM, (bf16_t*)(wb + WB_DOWN), scr, r, lane, 0);
    }
}

__device__ __forceinline__ void mod_item(const P& p, unsigned char* lds, int item) {
    const int tid = opaque_tid(), lane = tid & 63, wave = tid >> 6;
    const int l = item / 96, cgp = item % 96;
    float* sc = (float*)lds;
    float* red = (float*)(lds + 36864);
    for (int idx = tid; idx < 9 * 1024; idx += NTHREADS) {
        const int r = idx >> 10, k = idx & 1023;
        const float v = (r < 8) ? p.in[I_C][r * 1024 + k] : p.in[I_CCTX][k];
        sc[idx] = v / (1.f + __expf(-v));
    }
    __syncthreads();
    float acc[9];
#pragma unroll
    for (int r = 0; r < 9; ++r) acc[r] = 0.f;
    const float* wp = p.in[I_WADA] + (size_t)l * 1024 * 6144 + cgp * 64 + lane;
    const int kbeg = wave * 128;
#pragma unroll 4
    for (int k = kbeg; k < kbeg + 128; ++k) {
        const float w = wp[(size_t)k * 6144];
#pragma unroll
        for (int r = 0; r < 9; ++r) acc[r] += sc[r * 1024 + k] * w;
    }
#pragma unroll
    for (int r = 0; r < 9; ++r) red[(wave * 9 + r) * 64 + lane] = acc[r];
    __syncthreads();
    float* mod = (float*)(p.ws + OFF_MOD);
    for (int idx = tid; idx < 9 * 64; idx += NTHREADS) {
        const int r = idx >> 6, ln = idx & 63;
        float s = 0.f;
#pragma unroll
        for (int w = 0; w < 8; ++w) s += red[(w * 9 + r) * 64 + ln];
        const int j = cgp * 64 + ln;
        mod[(size_t)(l * 9 + r) * 6144 + j] = s + p.in[I_BADA][l * 6144 + j];
    }
    __syncthreads();
}
__device__ __forceinline__ void table_item(const P& p) {
    float* tc = (float*)(p.ws + OFF_TAB); float* ts = tc + 1024;
    for (int idx = threadIdx.x; idx < 1024; idx += NTHREADS) {
        const int pos = idx >> 4, i = idx & 15;
        const float ang = (float)pos * ROPE_INV[i];
        const double x = (double)ang;
        const double n = rint(x * 0.6366197723675814);
        const double r = x - n * 1.5707963267948966;
        const double r2 = r * r;
        const double sr = r * (1.0 - r2 / 6.0 * (1.0 - r2 / 20.0 * (1.0 - r2 / 42.0 * (1.0 - r2 / 72.0 * (1.0 - r2 / 110.0 * (1.0 - r2 / 156.0))))));
        const double cr = 1.0 - r2 / 2.0 * (1.0 - r2 / 12.0 * (1.0 - r2 / 30.0 * (1.0 - r2 / 56.0 * (1.0 - r2 / 90.0 * (1.0 - r2 / 132.0 * (1.0 - r2 / 182.0))))));
        const int q = ((int)n) & 3;
        double s, c;
        if (q == 0) { s = sr; c = cr; } else if (q == 1) { s = cr; c = -sr; } else if (q == 2) { s = -sr; c = -cr; } else { s = -cr; c = sr; }
        tc[idx] = (float)c; ts[idx] = (float)s;
    }
}

struct NormArgs {
    const float* xl; const float* xc;
    float* ol; float* oc;
    const bf16_t* y;
    const float* gpost; const float* modg; int gate_idx;
    bf16_t* h; const float* gpre; const float* modh; int shift_idx;
    int nrows;
};
__device__ __forceinline__ void norm_rows(const NormArgs& a, int gw, int NGW, int lane) {
    for (int r = gw; r < a.nrows; r += NGW) {
        const bool isl = r < ML;
        const int mrow = isl ? (r >> 11) : 8;
        const float* xin = isl ? a.xl + (size_t)r * DM : a.xc + (size_t)(r - ML) * DM;
        f32x4 v[4];
#pragma unroll
        for (int j = 0; j < 4; ++j) v[j] = *(const f32x4*)(xin + 4 * lane + 256 * j);
        if (a.y) {
            f32x4 yv[4]; float ss = 0.f;
#pragma unroll
            for (int j = 0; j < 4; ++j) { yv[j] = unpack4(*(const u32x2*)(a.y + (size_t)r * DM + 4 * lane + 256 * j)); ss += (yv[j][0] * yv[j][0] + yv[j][1] * yv[j][1]) + (yv[j][2] * yv[j][2] + yv[j][3] * yv[j][3]); }
            const float rstd = rsqrtf(wave_sum(ss) * (1.f / DM) + EPS);
#pragma unroll
            for (int j = 0; j < 4; ++j) {
                const int col = 4 * lane + 256 * j;
                const f32x4 gt = *(const f32x4*)(a.modg + (size_t)mrow * 6144 + a.gate_idx * 1024 + col);
                const f32x4 gp = *(const f32x4*)(a.gpost + col);
                v[j] = v[j] + gt * ((yv[j] * rstd) * gp);
            }
            float* xo = isl ? (a.ol ? a.ol + (size_t)r * DM : nullptr) : (a.oc ? a.oc + (size_t)(r - ML) * DM : nullptr);
            if (xo) {
#pragma unroll
                for (int j = 0; j < 4; ++j) *(f32x4*)(xo + 4 * lane + 256 * j) = v[j];
            }
        }
        if (a.h) {
            float ss = 0.f;
#pragma unroll
            for (int j = 0; j < 4; ++j) ss += (v[j][0] * v[j][0] + v[j][1] * v[j][1]) + (v[j][2] * v[j][2] + v[j][3] * v[j][3]);
            const float rstd = rsqrtf(wave_sum(ss) * (1.f / DM) + EPS);
#pragma unroll
            for (int j = 0; j < 4; ++j) {
                const int col = 4 * lane + 256 * j;
                const f32x4 gp = *(const f32x4*)(a.gpre + col);
                const f32x4 sh = *(const f32x4*)(a.modh + (size_t)mrow * 6144 + a.shift_idx * 1024 + col);
                const f32x4 scl = *(const f32x4*)(a.modh + (size_t)mrow * 6144 + (a.shift_idx + 1) * 1024 + col);
                const f32x4 hv = ((v[j] * rstd) * gp) * (1.f + scl) + sh;
                u32x2 w; w.x = pk2(hv[0], hv[1]); w.y = pk2(hv[2], hv[3]);
                *(u32x2*)(a.h + (size_t)r * DM + col) = w;
            }
        }
    }
}

namespace pg8 {
#define PG8_LAS __attribute__((address_space(3)))
typedef unsigned short bf16_t;
typedef short bf16x8 __attribute__((ext_vector_type(8)));
typedef float f32x4 __attribute__((ext_vector_type(4)));
typedef unsigned u32x4 __attribute__((ext_vector_type(4)));
constexpr int BM = 256, BK = 64, HALF = 128, HTB = HALF * BK * 2  , STAGE_BYTES = 8 * HTB, NXCD = 8, WGM = 8;

__host__ __device__ __forceinline__ int lds_byte(int r, int c) { const int st = (r >> 4) * 2 + (c >> 5), rr = r & 15, cc = c & 31, ob = rr * 64 + cc * 2; return st * 1024 + (ob ^ (((ob >> 9) & 1) << 5)); }
__host__ __device__ __forceinline__ void stage_rc(int b, int& R, int& C) { const int st = b / 1024, sb = b % 1024, swz = sb ^ (((sb >> 9) & 1) << 5); R = (st >> 1) * 16 + swz / 64; C = (st & 1) * 32 + (swz % 64) / 2; }
__host__ __device__ __forceinline__ int perm32(int rho) { const int n = rho >> 4, i = rho & 15; return 8 * (i >> 2) + 4 * n + (i & 3); }

struct Unit { int pm, pn; };
struct Gemm { const bf16_t* A; const bf16_t* Bt; int M, N, K; };

struct StaticOrder {
    int nM, nN, nwg, G, c;
    __host__ __device__ void init(int M, int N, int G_, int c_) { nM = M / BM; nN = N / BM; nwg = nM * nN; G = G_; c = c_; }
    __host__ __device__ bool next(int i, Unit& u) const {
        const long L = (long)i * G + c; if (L >= nwg) return false;
        int wgid = (int)L; { const int q = nwg / NXCD, r = nwg % NXCD, xcd = wgid % NXCD, off = wgid / NXCD; wgid = (xcd < r ? xcd * (q + 1) : r * (q + 1) + (xcd - r) * q) + off; }
        const int nig = WGM * nN, gid = wgid / nig, fm = gid * WGM, gsz = (nM - fm) < WGM ? (nM - fm) : WGM;
        u.pm = fm + ((wgid % nig) % gsz); u.pn = (wgid % nig) / gsz; return true;
    }
    __device__ __forceinline__ void a_ready(const Unit&) const {}
    __device__ __forceinline__ void done(const Unit&) const {}
};


template <class Epi, class Sched, bool ALIGN_EPI = false, bool SP2 = false>
__device__ __forceinline__ void gemm_phase(PG8_LAS unsigned char* lds, const Gemm g, const Sched& S, const Epi& E) {
    const int tid = opaque_tid(), wid = __builtin_amdgcn_readfirstlane(tid >> 6), lane = tid & 63, wr = wid >> 2, wc = wid & 3, fr = lane & 15, fq = lane >> 4;
    const int K = g.K, nt = K / BK;
    unsigned voffA[2], voffB[2];
#pragma unroll
    for (int i = 0; i < 2; ++i) { int R, C; stage_rc(tid * 16 + i * 8192, R, C); const int Rb = Epi::PERM ? ((R & ~31) + perm32(R & 31)) : R;
        voffA[i] = (unsigned)(R * K + C) * 2u; voffB[i] = (unsigned)(Rb * K + C) * 2u; }
    const size_t kstep = (size_t)(BK * 2);
    const size_t hstep = (size_t)HALF * K * 2;
    const size_t tstep = 2 * hstep;
    const unsigned ldsw = (unsigned)wid * 1024u;
    const int aoff = lds_byte(wr * 64 + fr, fq * 8), boff = lds_byte(wc * 32 + fr, fq * 8);
#define PG8_SA(b, h) (((b) * 2 + (h)) * HTB)
#define PG8_SB(b, h) ((4 + (b) * 2 + (h)) * HTB)
#define PG8_STAGE(bufoff, gbase, voff) do { _Pragma("unroll") for (int _i = 0; _i < 2; ++_i) \
        __builtin_amdgcn_global_load_lds((const unsigned*)((const char*)(gbase) + (voff)[_i]), (PG8_LAS unsigned*)(lds + (bufoff) + ldsw + _i * 8192), 16, 0, 0); } while (0)
#define PG8_LDA(dst, b, h) do { _Pragma("unroll") for (int m = 0; m < 4; ++m) _Pragma("unroll") for (int k = 0; k < 2; ++k) dst[m][k] = *(const PG8_LAS bf16x8*)(lds + PG8_SA(b, h) + aoff + m * 2048 + k * 1024); } while (0)
#define PG8_LDB(dst, b, h) do { _Pragma("unroll") for (int n = 0; n < 2; ++n) _Pragma("unroll") for (int k = 0; k < 2; ++k) dst[n][k] = *(const PG8_LAS bf16x8*)(lds + PG8_SB(b, h) + boff + n * 2048 + k * 1024); } while (0)
#define PG8_MMA(ai, bj, At, Bt) do { __builtin_amdgcn_s_setprio(1); _Pragma("unroll") for (int m = 0; m < 4; ++m) _Pragma("unroll") for (int n = 0; n < 2; ++n) _Pragma("unroll") for (int k = 0; k < 2; ++k) \
        acc[ai][bj][m][n] = __builtin_amdgcn_mfma_f32_16x16x32_bf16(Bt[n][k], At[m][k], acc[ai][bj][m][n], 0, 0, 0); __builtin_amdgcn_s_setprio(0); } while (0)
#define PG8_WAIT_V(n) asm volatile("s_waitcnt vmcnt(" #n ")" ::: "memory")
#define PG8_WAIT_L(n) asm volatile("s_waitcnt lgkmcnt(" #n ")" ::: "memory")
#define PG8_BAR __builtin_amdgcn_s_barrier()
#define PG8_SCHED __builtin_amdgcn_sched_barrier(0)
    Unit cur, nxt; int ui = 0;
    if (!S.next(0, cur)) return;
    f32x4 acc[2][2][4][2];
#pragma unroll
    for (int a = 0; a < 2; ++a)
#pragma unroll
        for (int b = 0; b < 2; ++b)
#pragma unroll
            for (int m = 0; m < 4; ++m)
#pragma unroll
                for (int n = 0; n < 2; ++n) acc[a][b][m][n] = (f32x4){0.f, 0.f, 0.f, 0.f};
    bf16x8 At[4][2], B0[2][2], B1[2][2];
    const char* cA = (const char*)g.A + (size_t)cur.pm * tstep; const char* cB = (const char*)g.Bt + (size_t)cur.pn * tstep;
    S.a_ready(cur);
    if constexpr (SP2) {
        PG8_STAGE(PG8_SB(0, 0), cB, voffB); PG8_STAGE(PG8_SB(0, 1), cB + hstep, voffB); PG8_STAGE(PG8_SA(0, 0), cA, voffA); PG8_STAGE(PG8_SA(0, 1), cA + hstep, voffA);
        if (wr == 1) PG8_BAR;
        PG8_WAIT_V(2); PG8_BAR;
        PG8_STAGE(PG8_SB(1, 0), cB + kstep, voffB); PG8_STAGE(PG8_SA(1, 0), cA + kstep, voffA); PG8_STAGE(PG8_SB(1, 1), cB + hstep + kstep, voffB);
        PG8_WAIT_V(6); PG8_BAR;
    } else {
        PG8_STAGE(PG8_SB(0, 0), cB, voffB); PG8_STAGE(PG8_SA(0, 0), cA, voffA); PG8_STAGE(PG8_SB(0, 1), cB + hstep, voffB); PG8_STAGE(PG8_SA(0, 1), cA + hstep, voffA);
        if (wr == 1) PG8_BAR;
        PG8_WAIT_V(4); PG8_BAR;
        PG8_STAGE(PG8_SB(1, 0), cB + kstep, voffB); PG8_STAGE(PG8_SA(1, 0), cA + kstep, voffA); PG8_STAGE(PG8_SB(1, 1), cB + hstep + kstep, voffB);
        PG8_WAIT_V(6); PG8_BAR;
    }
    for (;;) {
        const bool has_next = S.next(ui + 1, nxt);
        const char* nA = has_next ? (const char*)g.A + (size_t)nxt.pm * tstep : cA; const char* nB = has_next ? (const char*)g.Bt + (size_t)nxt.pn * tstep : cB;
        for (int t = 0; t < nt; t += 2) {
            const bool last = (t == nt - 2);
            const char* a1 = cA + (size_t)(t + 1) * kstep;
            const char* a2 = last ? nA : cA + (size_t)(t + 2) * kstep; const char* b2 = last ? nB : cB + (size_t)(t + 2) * kstep;
            const char* a3 = a2 + kstep; const char* b3 = b2 + kstep;
            if (last && has_next) S.a_ready(nxt);
            if constexpr (SP2) {
            PG8_LDB(B0, 0, 0); PG8_LDB(B1, 0, 1); PG8_SCHED; PG8_LDA(At, 0, 0); PG8_STAGE(PG8_SA(1, 1), a1 + hstep, voffA);
            PG8_WAIT_V(8); PG8_WAIT_L(0); PG8_BAR; PG8_MMA(0, 0, At, B0); PG8_MMA(0, 1, At, B1); PG8_BAR; PG8_SCHED;
            PG8_LDA(At, 0, 1); PG8_STAGE(PG8_SB(0, 0), b2, voffB); PG8_STAGE(PG8_SB(0, 1), b2 + hstep, voffB); PG8_STAGE(PG8_SA(0, 0), a2, voffA);
            PG8_WAIT_V(8); PG8_WAIT_L(0); PG8_BAR; PG8_MMA(1, 0, At, B0); PG8_MMA(1, 1, At, B1); PG8_BAR; PG8_SCHED;
            PG8_LDB(B0, 1, 0); PG8_LDB(B1, 1, 1); PG8_SCHED; PG8_LDA(At, 1, 0); PG8_STAGE(PG8_SA(0, 1), a2 + hstep, voffA);
            PG8_WAIT_V(8); PG8_WAIT_L(0); PG8_BAR; PG8_MMA(0, 0, At, B0); PG8_MMA(0, 1, At, B1); PG8_BAR; PG8_SCHED;
            PG8_LDA(At, 1, 1); PG8_STAGE(PG8_SB(1, 0), b3, voffB); PG8_STAGE(PG8_SB(1, 1), b3 + hstep, voffB); PG8_STAGE(PG8_SA(1, 0), a3, voffA);
            PG8_WAIT_V(8); PG8_WAIT_L(0); PG8_BAR; PG8_MMA(1, 0, At, B0); PG8_MMA(1, 1, At, B1); PG8_BAR; PG8_SCHED;
            } else {
            PG8_LDB(B0, 0, 0); PG8_SCHED; PG8_LDA(At, 0, 0); PG8_STAGE(PG8_SA(1, 1), a1 + hstep, voffA);
            PG8_WAIT_L(8); PG8_BAR; PG8_WAIT_L(0); PG8_MMA(0, 0, At, B0); PG8_BAR; PG8_SCHED;
            PG8_LDB(B1, 0, 1); PG8_STAGE(PG8_SB(0, 0), b2, voffB);
            PG8_BAR; PG8_WAIT_L(0); PG8_MMA(0, 1, At, B1); PG8_BAR;
            PG8_LDA(At, 0, 1); PG8_STAGE(PG8_SA(0, 0), a2, voffA);
            PG8_BAR; PG8_WAIT_L(0); PG8_MMA(1, 0, At, B0); PG8_BAR; PG8_SCHED;
            PG8_STAGE(PG8_SB(0, 1), b2 + hstep, voffB);
            PG8_WAIT_V(6); PG8_BAR; PG8_MMA(1, 1, At, B1); PG8_BAR;
            PG8_LDB(B0, 1, 0); PG8_SCHED; PG8_LDA(At, 1, 0); PG8_STAGE(PG8_SA(0, 1), a2 + hstep, voffA);
            PG8_WAIT_L(8); PG8_BAR; PG8_WAIT_L(0); PG8_MMA(0, 0, At, B0); PG8_BAR; PG8_SCHED;
            PG8_LDB(B1, 1, 1); PG8_STAGE(PG8_SB(1, 0), b3, voffB);
            PG8_BAR; PG8_WAIT_L(0); PG8_MMA(0, 1, At, B1); PG8_BAR;
            PG8_LDA(At, 1, 1); PG8_STAGE(PG8_SA(1, 0), a3, voffA);
            PG8_BAR; PG8_WAIT_L(0); PG8_MMA(1, 0, At, B0); PG8_BAR; PG8_SCHED;
            PG8_STAGE(PG8_SB(1, 1), b3 + hstep, voffB);
            PG8_WAIT_V(6); PG8_BAR; PG8_MMA(1, 1, At, B1); PG8_BAR;
            }
        }
        if constexpr (ALIGN_EPI) { if (wr == 0) PG8_BAR; }
        if constexpr (!Epi::AFTER_DRAIN) { E(acc, cur, wr, wc, fr, fq); S.done(cur); }
        if (!has_next) break;
#pragma unroll
        for (int a = 0; a < 2; ++a)
#pragma unroll
            for (int b = 0; b < 2; ++b)
#pragma unroll
                for (int m = 0; m < 4; ++m)
#pragma unroll
                    for (int n = 0; n < 2; ++n) acc[a][b][m][n] = (f32x4){0.f, 0.f, 0.f, 0.f};
        cur = nxt; cA = nA; cB = nB; ++ui;
        if constexpr (ALIGN_EPI) { if (wr == 1) PG8_BAR; }
    }
    PG8_WAIT_V(0);
    if constexpr (!ALIGN_EPI) { if (wr == 0) PG8_BAR; }
    PG8_BAR;
    if constexpr (Epi::AFTER_DRAIN) { E.fused(acc, cur, wr, wc, fr, fq, lds, wid, lane); S.done(cur); }
#undef PG8_SA
#undef PG8_SB
#undef PG8_STAGE
#undef PG8_LDA
#undef PG8_LDB
#undef PG8_MMA
#undef PG8_WAIT_V
#undef PG8_WAIT_L
#undef PG8_BAR
#undef PG8_SCHED
}
}

struct EpiIn {
    bf16_t *Q, *KV, *RX, *PU, *RY, *G; const float* tcos; const float* tsin;
    __device__ __forceinline__ void operator()(int row, int c8, f32x4 v0, f32x4 v1) const {
        if (c8 < 640) {
            if (row < ML) {
                const int s = row & 2047, pp = c8 & 63, Gq = pp >> 3;
                const int pos = (Gq & 4) ? (s & 63) : (s >> 6);
                const int i0 = (Gq & 3) * 4;
                const f32x4 cs = *(const f32x4*)(tcos + pos * 16 + i0), sn = *(const f32x4*)(tsin + pos * 16 + i0);
                const f32x4 a = v0 * cs - v1 * sn, b = v1 * cs + v0 * sn; v0 = a; v1 = b;
            }
            if (c8 < 512) { v0 = v0 * QSCALE; v1 = v1 * QSCALE; *(u32x4*)(Q + (size_t)row * 512 + c8) = pack8(v0, v1); }
            else *(u32x4*)(KV + (size_t)row * 256 + (c8 - 512)) = pack8(v0, v1);
        } else if (c8 < 768) *(u32x4*)(KV + (size_t)row * 256 + 128 + (c8 - 640)) = pack8(v0, v1);
        else if (c8 < 1280) *(u32x4*)(RX + (size_t)row * 512 + (c8 - 768)) = pack8(v0, v1);
        else if (c8 < 1792) *(u32x4*)(RY + (size_t)row * 512 + (c8 - 1280)) = pack8(v0, v1);
        else if (c8 < 2304) *(u32x4*)(PU + (size_t)row * 512 + (c8 - 1792)) = pack8(v0, v1);
        else {
#pragma unroll
            for (int j = 0; j < 4; ++j) { v0[j] = sigm(v0[j]); v1[j] = sigm(v1[j]); }
            *(u32x4*)(G + (size_t)row * 3072 + (c8 - 2304)) = pack8(v0, v1);
        }
    }
};
struct EpiStore {
    bf16_t* O; int ldc;
    __device__ __forceinline__ void operator()(int row, int c8, f32x4 v0, f32x4 v1) const { *(u32x4*)(O + (size_t)row * ldc + c8) = pack8(v0, v1); }
};
struct EpiSwiglu {
    bf16_t* O;
    __device__ __forceinline__ void operator()(int row, int c8, f32x4 v0, f32x4 v1) const {
        f32x4 o;
#pragma unroll
        for (int j = 0; j < 4; ++j) o[j] = v0[j] * sigm(v0[j]) * v1[j];
        u32x2 w; w.x = pk2(o[0], o[1]); w.y = pk2(o[2], o[3]);
        *(u32x2*)(O + (size_t)row * DFF + (c8 >> 1)) = w;
    }
};

template <class F> struct EpiW {
    static constexpr bool PERM = true, AFTER_DRAIN = false;
    F f;
    __device__ __forceinline__ void operator()(const pg8::f32x4 (&acc)[2][2][4][2], const pg8::Unit& u, int wr, int wc, int fr, int fq) const {
        const int row0 = u.pm * 256 + wr * 64 + fr, col0 = u.pn * 256 + wc * 32 + 8 * fq;
#pragma unroll
        for (int ai = 0; ai < 2; ++ai)
#pragma unroll
            for (int m = 0; m < 4; ++m)
#pragma unroll
                for (int bj = 0; bj < 2; ++bj) f(row0 + ai * 128 + m * 16, col0 + bj * 128, acc[ai][bj][m][0], acc[ai][bj][m][1]);
    }
};
struct InOrder1 {
    pg8::StaticOrder so;
    __device__ void init(int G, int c) { so.init(ML, INW, G, c); }
    __device__ bool next(int i, pg8::Unit& u) const {
        const long L = (long)i * so.G + so.c;
        if (L < so.nwg) return so.next(i, u);
        const int r = (int)(L - so.nwg); if (r >= 24) return false;
        u.pm = 64 + (r & 7); u.pn = 2 + (r >> 3); return true;
    }
    __device__ __forceinline__ void a_ready(const pg8::Unit&) const {}
    __device__ __forceinline__ void done(const pg8::Unit&) const {}
};

__device__ __forceinline__ void gemm_wave_acc(const bf16_t* A, const bf16_t* Bt, int K, int rw, int cw, int fr, int fq, f32x4 (&acc)[4][4]) {
    const bf16_t* ap[4]; const bf16_t* bp[4];
#pragma unroll
    for (int i = 0; i < 4; ++i) ap[i] = A + (size_t)(rw + 16 * i + fr) * K + 8 * fq;
#pragma unroll
    for (int q = 0; q < 4; ++q) bp[q] = Bt + (size_t)(cw + 32 * (q >> 1) + perm32(16 * (q & 1) + fr)) * K + 8 * fq;
#pragma unroll 2
    for (int k = 0; k < K; k += 32) {
        bf16x8 af[4], bfr[4];
#pragma unroll
        for (int i = 0; i < 4; ++i) af[i] = *(const bf16x8*)(ap[i] + k);
#pragma unroll
        for (int q = 0; q < 4; ++q) bfr[q] = *(const bf16x8*)(bp[q] + k);
#pragma unroll
        for (int i = 0; i < 4; ++i)
#pragma unroll
            for (int q = 0; q < 4; ++q) acc[i][q] = __builtin_amdgcn_mfma_f32_16x16x32_bf16(bfr[q], af[i], acc[i][q], 0, 0, 0);
    }
}
template <class Epi>
__device__ __forceinline__ void gemm_simple(const bf16_t* A, const bf16_t* Bt, int K, int row_off, int M, int col_off, int N, const Epi& epi, int bid, int G) {
    const int tid = opaque_tid(), lane = tid & 63, wave = tid >> 6, wr = wave >> 2, wc = wave & 3, fr = lane & 15, fq = lane >> 4;
    const int nM = M / 128, nN = N / 256;
    for (int u = bid; u < nM * nN; u += G) {
        const int pm = u % nM, pn = u / nM;
        const int rw = row_off + pm * 128 + wr * 64, cw = col_off + pn * 256 + wc * 64;
        f32x4 acc[4][4];
#pragma unroll
        for (int i = 0; i < 4; ++i)
#pragma unroll
            for (int q = 0; q < 4; ++q) acc[i][q] = (f32x4){0.f, 0.f, 0.f, 0.f};
        gemm_wave_acc(A, Bt, K, rw, cw, fr, fq, acc);
#pragma unroll
        for (int i = 0; i < 4; ++i)
#pragma unroll
            for (int g = 0; g < 2; ++g) epi(rw + 16 * i + fr, cw + 32 * g + 8 * fq, acc[i][2 * g], acc[i][2 * g + 1]);
    }
}
__device__ __forceinline__ void gemm_merge(const P& p, int M, int bid, int G) {
    const int tid = opaque_tid(), lane = tid & 63, wave = tid >> 6, wr = wave >> 2, wc = wave & 3, fr = lane & 15, fq = lane >> 4;
    const bf16_t* Gt = (const bf16_t*)(p.ws + OFF_G);
    bf16_t* O = (bf16_t*)(p.ws + OFF_MERGED);
    const int nM = M / 128, nN = 8;
    for (int u = bid; u < nM * nN; u += G) {
        const int pm = u % nM, pn = u / nM;
        const int rw = pm * 128 + wr * 64, cw = pn * 128 + wc * 32;
        f32x4 tot[4][2];
#pragma unroll
        for (int i = 0; i < 4; ++i) { tot[i][0] = (f32x4){0.f, 0.f, 0.f, 0.f}; tot[i][1] = (f32x4){0.f, 0.f, 0.f, 0.f}; }
#pragma unroll 1
        for (int s = 0; s < 3; ++s) {
            const bf16_t* A = (const bf16_t*)(p.ws + (s == 0 ? OFF_Q : (s == 1 ? OFF_A : OFF_RY)));
            const bf16_t* Bt = (const bf16_t*)(p.ws + OFF_WA + (s == 0 ? WA_AO : (s == 1 ? WA_PO : WA_RO)));
            f32x4 acc[4][2];
#pragma unroll
            for (int i = 0; i < 4; ++i) { acc[i][0] = (f32x4){0.f, 0.f, 0.f, 0.f}; acc[i][1] = (f32x4){0.f, 0.f, 0.f, 0.f}; }
            const bf16_t* ap = A + (size_t)(rw + fr) * 512 + 8 * fq;
            const bf16_t* bp0 = Bt + (size_t)(cw + perm32(fr)) * 512 + 8 * fq;
            const bf16_t* bp1 = Bt + (size_t)(cw + perm32(16 + fr)) * 512 + 8 * fq;
#pragma unroll 2
            for (int k = 0; k < 512; k += 32) {
                const bf16x8 b0 = *(const bf16x8*)(bp0 + k), b1 = *(const bf16x8*)(bp1 + k);
#pragma unroll
                for (int i = 0; i < 4; ++i) {
                    const bf16x8 af = *(const bf16x8*)(ap + (size_t)(16 * i) * 512 + k);
                    acc[i][0] = __builtin_amdgcn_mfma_f32_16x16x32_bf16(b0, af, acc[i][0], 0, 0, 0);
                    acc[i][1] = __builtin_amdgcn_mfma_f32_16x16x32_bf16(b1, af, acc[i][1], 0, 0, 0);
                }
            }
#pragma unroll
            for (int i = 0; i < 4; ++i) {
                f32x4 g0, g1; unpack8(*(const u32x4*)(Gt + (size_t)(rw + 16 * i + fr) * 3072 + s * 1024 + cw + 8 * fq), g0, g1);
                tot[i][0] += g0 * acc[i][0]; tot[i][1] += g1 * acc[i][1];
            }
        }
#pragma unroll
        for (int i = 0; i < 4; ++i) *(u32x4*)(O + (size_t)(rw + 16 * i + fr) * DM + cw + 8 * fq) = pack8(tot[i][0], tot[i][1]);
    }
}

__device__ __forceinline__ void attn_item(unsigned char* lds, bf16_t* Qb, const bf16_t* KVb, const float* sink, int qrow0, int kvh, int npos0, int b) {
    const int tid = opaque_tid(), lane = tid & 63, wave = tid >> 6, r32 = lane & 31, hi = lane >> 5;
    bf16_t* Ks = (bf16_t*)lds;
    bf16_t* Vt = (bf16_t*)(lds + 9216);
    const int hq = kvh * 4 + (wave >> 1);
    const int qoff = (wave & 1) * 32;
    bf16x8 qf[4];
#pragma unroll
    for (int ks = 0; ks < 4; ++ks) qf[ks] = *(const bf16x8*)(Qb + (size_t)(qrow0 + qoff + r32) * 512 + hq * 64 + 16 * ks + 8 * hi);
    f32x16 o[2];
#pragma unroll
    for (int dt = 0; dt < 2; ++dt)
#pragma unroll
        for (int r = 0; r < 16; ++r) o[dt][r] = 0.f;
    float m = sink[hq] * LOG2E, l = (hi == 0) ? 1.f : 0.f;
    const int ntl = (npos0 >= 0) ? 5 : 0;
    const int qp0 = npos0 + qoff;
#pragma unroll 1
    for (int ti = 0; ti < ntl + 4; ++ti) {
        int krow0, kp0 = 0; bool masked;
        if (ti < ntl) { kp0 = npos0 - 128 + 64 * ti; if (kp0 < 0 || kp0 >= SEQ) continue; krow0 = b * SEQ + kp0; masked = true; }
        else { krow0 = ML + b * CTX + 64 * (ti - ntl); masked = false; }
        __syncthreads();
        {
            const int key = tid >> 3, ch = tid & 7;
            const bf16_t* src = KVb + (size_t)(krow0 + key) * 256 + kvh * 64 + ch * 8;
            const u32x4 kv = *(const u32x4*)src; const u32x4 vv = *(const u32x4*)(src + 128);
            *(u32x4*)(Ks + key * 72 + ch * 8) = kv;
            const unsigned w[4] = {vv.x, vv.y, vv.z, vv.w};
#pragma unroll
            for (int e = 0; e < 8; ++e) Vt[(ch * 8 + e) * 72 + key] = (bf16_t)((w[e >> 1] >> (16 * (e & 1))) & 0xffffu);
        }
        __syncthreads();
        if (masked && (kp0 - (qp0 + 31) > 128 || qp0 - (kp0 + 63) > 128)) continue;
        f32x16 p0, p1;
#pragma unroll
        for (int r = 0; r < 16; ++r) { p0[r] = 0.f; p1[r] = 0.f; }
#pragma unroll
        for (int ks = 0; ks < 4; ++ks) {
            const bf16x8 k0 = *(const bf16x8*)(Ks + r32 * 72 + 16 * ks + 8 * hi);
            const bf16x8 k1 = *(const bf16x8*)(Ks + (32 + r32) * 72 + 16 * ks + 8 * hi);
            p0 = __builtin_amdgcn_mfma_f32_32x32x16_bf16(k0, qf[ks], p0, 0, 0, 0);
            p1 = __builtin_amdgcn_mfma_f32_32x32x16_bf16(k1, qf[ks], p1, 0, 0, 0);
        }
        if (masked) {
            const int qp = qp0 + r32;
#pragma unroll
            for (int r = 0; r < 16; ++r) {
                const int d0 = qp - (kp0 + crow(r, hi)), d1 = d0 - 32;
                if (d0 > 128 || d0 < -128) p0[r] = -1e30f;
                if (d1 > 128 || d1 < -128) p1[r] = -1e30f;
            }
        }
        float mx = fmaxf(p0[0], p1[0]);
#pragma unroll
        for (int r = 1; r < 16; ++r) mx = fmaxf(mx, fmaxf(p0[r], p1[r]));
        mx = fmaxf(mx, __shfl_xor(mx, 32));
        const float mn = fmaxf(m, mx);
        const float alpha = __builtin_amdgcn_exp2f(m - mn);
        m = mn;
        float rs = 0.f;
#pragma unroll
        for (int r = 0; r < 16; ++r) { p0[r] = __builtin_amdgcn_exp2f(p0[r] - mn); p1[r] = __builtin_amdgcn_exp2f(p1[r] - mn); rs += p0[r] + p1[r]; }
        l = l * alpha + rs;
#pragma unroll
        for (int dt = 0; dt < 2; ++dt)
#pragma unroll
            for (int r = 0; r < 16; ++r) o[dt][r] *= alpha;
#pragma unroll
        for (int s4 = 0; s4 < 4; ++s4) {
            u32x4 pw;
            if (s4 < 2) { const int o8 = 8 * s4; pw.x = pk2(p0[o8], p0[o8 + 1]); pw.y = pk2(p0[o8 + 2], p0[o8 + 3]); pw.z = pk2(p0[o8 + 4], p0[o8 + 5]); pw.w = pk2(p0[o8 + 6], p0[o8 + 7]); }
            else { const int o8 = 8 * (s4 - 2); pw.x = pk2(p1[o8], p1[o8 + 1]); pw.y = pk2(p1[o8 + 2], p1[o8 + 3]); pw.z = pk2(p1[o8 + 4], p1[o8 + 5]); pw.w = pk2(p1[o8 + 6], p1[o8 + 7]); }
            const bf16x8 pf = __builtin_bit_cast(bf16x8, pw);
            const int keybase = 32 * (s4 >> 1) + 16 * (s4 & 1) + 4 * hi;
#pragma unroll
            for (int dt = 0; dt < 2; ++dt) {
                const int d = 32 * dt + r32;
                const s16x4 lo = *(const s16x4*)(Vt + d * 72 + keybase);
                const s16x4 hh = *(const s16x4*)(Vt + d * 72 + keybase + 8);
                const bf16x8 vf = (bf16x8){lo[0], lo[1], lo[2], lo[3], hh[0], hh[1], hh[2], hh[3]};
                o[dt] = __builtin_amdgcn_mfma_f32_32x32x16_bf16(vf, pf, o[dt], 0, 0, 0);
            }
        }
    }
    {
        const float lt = l + __shfl_xor(l, 32);
        const float inv = 1.f / lt;
        bf16_t* orow = Qb + (size_t)(qrow0 + qoff + r32) * 512 + hq * 64;
#pragma unroll
        for (int dt = 0; dt < 2; ++dt)
#pragma unroll
            for (int rg = 0; rg < 4; ++rg) {
                u32x2 w; w.x = pk2(o[dt][4 * rg] * inv, o[dt][4 * rg + 1] * inv); w.y = pk2(o[dt][4 * rg + 2] * inv, o[dt][4 * rg + 3] * inv);
                *(u32x2*)(orow + 32 * dt + 8 * rg + 4 * hi) = w;
            }
    }
    __syncthreads();
}

__device__ __forceinline__ void pool_item(const P& p, int l, unsigned char* lds, int rb, int L, int t0, int g) {
    const int tid = opaque_tid(), lane = tid & 63, wave = tid >> 6, fr = lane & 15, fq = lane >> 4;
    bf16_t* U = (bf16_t*)lds;
    bf16_t* Dt = (bf16_t*)(lds + 20480);
    const bf16_t* PUb = (const bf16_t*)(p.ws + OFF_PU);
    bf16_t* PO = (bf16_t*)(p.ws + OFF_A);
    const bf16_t* PMt = (const bf16_t*)(p.ws + OFF_WA + WA_PM);
    for (int idx = tid; idx < 80 * 16; idx += NTHREADS) {
        const int rr = idx >> 4, ch = idx & 15, t = t0 - 7 + rr;
        u32x4 v = (u32x4){0u, 0u, 0u, 0u};
        if (t >= 0 && t < L) v = *(const u32x4*)(PUb + (size_t)(rb + t) * 512 + g * 128 + ch * 8);
        *(u32x4*)(U + rr * 128 + ch * 8) = v;
    }
    __syncthreads();
    const int w = 2 << g, offL = (w - 1) / 2, offR = w / 2;
    for (int idx = tid; idx < 64 * 128; idx += NTHREADS) {
        const int tt = idx >> 7, c = idx & 127, t = t0 + tt;
        const int lo = max(t - offL, 0), hi = min(t + offR + 1, L);
        float s = 0.f;
        for (int u = lo; u < hi; ++u) s += bf2f(U[(u - t0 + 7) * 128 + c]);
        const float d = s / (float)(hi - lo) - bf2f(U[(tt + 7) * 128 + c]);
        Dt[tt * 136 + c] = (bf16_t)f2bf(d);
    }
    __syncthreads();
    const int mt = wave & 3, nh = wave >> 2;
    f32x4 acc[4];
#pragma unroll
    for (int nt = 0; nt < 4; ++nt) acc[nt] = (f32x4){0.f, 0.f, 0.f, 0.f};
#pragma unroll
    for (int ks = 0; ks < 4; ++ks) {
        const bf16x8 af = *(const bf16x8*)(Dt + (16 * mt + fr) * 136 + 32 * ks + 8 * fq);
#pragma unroll
        for (int nt = 0; nt < 4; ++nt) {
            const bf16x8 bfr = *(const bf16x8*)(PMt + (size_t)(g * 128 + nh * 64 + 16 * nt + fr) * 128 + 32 * ks + 8 * fq);
            acc[nt] = __builtin_amdgcn_mfma_f32_16x16x32_bf16(bfr, af, acc[nt], 0, 0, 0);
        }
    }
#pragma unroll
    for (int nt = 0; nt < 4; ++nt) {
        const int col = g * 128 + nh * 64 + 16 * nt + 4 * fq;
        const f32x4 sc = *(const f32x4*)(p.in[I_PSCALE] + l * 512 + col);
        const f32x4 v = acc[nt] * sc;
        u32x2 wv; wv.x = pk2(v[0], v[1]); wv.y = pk2(v[2], v[3]);
        *(u32x2*)(PO + (size_t)(rb + t0 + 16 * mt + fr) * 512 + col) = wv;
    }
    __syncthreads();
}

__device__ __forceinline__ void rnn_item(const P& p, int l, unsigned char* lds, int b, int hb, bool need_ctx) {
    const int tid = opaque_tid(), half = tid >> 8, ht = tid & 255, lane = tid & 63, hw = (tid >> 6) & 3, fr = lane & 15, fq = lane >> 4;
    const int d = half;
    unsigned char* hl = lds + half * 58368;
    float* XL = (float*)hl;
    bf16_t* XA = (bf16_t*)(hl + 16384);
    float* CA = (float*)(hl + 25600);
    float* CB = (float*)(hl + 41984);
    const bf16_t* RXb = (const bf16_t*)(p.ws + OFF_RX);
    bf16_t* RYb = (bf16_t*)(p.ws + OFF_RY);
    bf16_t* Sb = (bf16_t*)(p.ws + OFF_A + 18 * MiB);
    const bf16_t* LA = (const bf16_t*)(p.ws + OFF_WA + WA_LA) + (size_t)(d * 8 + hb) * 4096;
    const bf16_t* LX = (const bf16_t*)(p.ws + OFF_WA + WA_LX) + (size_t)(d * 8 + hb) * 4096;
    float ba[4], bx[4], ls[4];
#pragma unroll
    for (int nt = 0; nt < 4; ++nt) {
        const int c = (l * 2 + d) * 512 + hb * 64 + 16 * nt + fr;
        ba[nt] = p.in[I_LBA][c]; bx[nt] = p.in[I_LBX][c];
        const float lam = p.in[I_LAM][c];
        ls[nt] = -8.f * log1pf(__expf(-lam));
    }
    const int cc = ht & 63, tq = ht >> 6;
    float cw[4];
#pragma unroll
    for (int k = 0; k < 4; ++k) cw[k] = p.in[I_CONVW][(l * 4 + k) * 512 + hb * 64 + cc];
    const float cbias = p.in[I_CONVB][l * 512 + hb * 64 + cc];
    float hstate = 0.f;
#pragma unroll 1
    for (int st = 0; st < 36; ++st) {
        const int cj = (d == 0) ? st : (st < 4 ? 3 - st : 39 - st);
        const bool isctx = cj < 4;
        const int segpos0 = isctx ? cj * 64 : cj * 64 - 256;
        const int L = isctx ? CTX : SEQ;
        const int rowbase = isctx ? (ML + b * CTX + segpos0) : (b * SEQ + segpos0);
        {
            const bf16_t* rxp = RXb + (size_t)rowbase * 512 + hb * 64 + cc;
            const int tb = tq * 16;
            float xm1, x0, xp1;
            { const int sp = segpos0 + tb - 1; xm1 = (sp >= 0 && sp < L) ? bf2f(rxp[(ptrdiff_t)(tb - 1) * 512]) : 0.f; }
            { const int sp = segpos0 + tb;     x0  = (sp >= 0 && sp < L) ? bf2f(rxp[(ptrdiff_t)(tb) * 512]) : 0.f; }
            { const int sp = segpos0 + tb + 1; xp1 = (sp >= 0 && sp < L) ? bf2f(rxp[(ptrdiff_t)(tb + 1) * 512]) : 0.f; }
#pragma unroll 4
            for (int i = 0; i < 16; ++i) {
                const int t = tb + i, sp = segpos0 + t + 2;
                const float xp2 = (sp >= 0 && sp < L) ? bf2f(rxp[(ptrdiff_t)(t + 2) * 512]) : 0.f;
                const float v = cbias + cw[0] * xm1 + cw[1] * x0 + cw[2] * xp1 + cw[3] * xp2;
                XL[t * 64 + cc] = v; XA[t * 72 + cc] = (bf16_t)f2bf(v);
                xm1 = x0; x0 = xp1; xp1 = xp2;
            }
        }
        __syncthreads();
        {
            f32x4 ga[4], gx[4];
#pragma unroll
            for (int nt = 0; nt < 4; ++nt) { ga[nt] = (f32x4){0.f, 0.f, 0.f, 0.f}; gx[nt] = (f32x4){0.f, 0.f, 0.f, 0.f}; }
#pragma unroll
            for (int ks = 0; ks < 2; ++ks) {
                const bf16x8 af = *(const bf16x8*)(XA + (16 * hw + fr) * 72 + 32 * ks + 8 * fq);
#pragma unroll
                for (int nt = 0; nt < 4; ++nt) {
                    const bf16x8 wa = *(const bf16x8*)(LA + (16 * nt + fr) * 64 + 32 * ks + 8 * fq);
                    const bf16x8 wx = *(const bf16x8*)(LX + (16 * nt + fr) * 64 + 32 * ks + 8 * fq);
                    ga[nt] = __builtin_amdgcn_mfma_f32_16x16x32_bf16(af, wa, ga[nt], 0, 0, 0);
                    gx[nt] = __builtin_amdgcn_mfma_f32_16x16x32_bf16(af, wx, gx[nt], 0, 0, 0);
                }
            }
#pragma unroll
            for (int nt = 0; nt < 4; ++nt)
#pragma unroll
                for (int rg = 0; rg < 4; ++rg) {
                    const int tk = 16 * hw + 4 * fq + rg, c = 16 * nt + fr;
                    const float r = sigm(ga[nt][rg] + ba[nt]);
                    const float ig = sigm(gx[nt][rg] + bx[nt]);
                    const float la = ls[nt] * r;
                    const float a = __expf(la);
                    const float mult = sqrtf(fmaxf(1.f - a * a, 0.f));
                    CA[tk * 64 + c] = a;
                    CB[tk * 64 + c] = mult * ig * XL[tk * 64 + c];
                }
        }
        __syncthreads();
        if (hw == 0) {
            if (d == 0) {
#pragma unroll 8
                for (int t = 0; t < 64; ++t) { hstate = CA[t * 64 + lane] * hstate + CB[t * 64 + lane]; CB[t * 64 + lane] = hstate; }
            } else {
#pragma unroll 8
                for (int t = 63; t >= 0; --t) { hstate = CA[t * 64 + lane] * hstate + CB[t * 64 + lane]; CB[t * 64 + lane] = hstate; }
            }
        }
        __syncthreads();
        if (!isctx || need_ctx) {
            const bool first = (d == 0) ? (isctx ? (cj < 2) : (cj <= 19)) : (isctx ? (cj >= 2) : (cj >= 20));
#pragma unroll
            for (int it = 0; it < 2; ++it) {
                const int idx = ht + 256 * it, t = idx >> 3, c8 = (idx & 7) * 8;
                const f32x4 h0 = *(const f32x4*)(CB + t * 64 + c8), h1 = *(const f32x4*)(CB + t * 64 + c8 + 4);
                const size_t off = (size_t)(rowbase + t) * 512 + hb * 64 + c8;
                if (first) *(u32x4*)(Sb + off) = pack8(h0, h1);
                else {
                    f32x4 s0, s1, y0, y1; unpack8(*(const u32x4*)(Sb + off), s0, s1); unpack8(*(const u32x4*)(RYb + off), y0, y1);
                    f32x4 o0, o1;
#pragma unroll
                    for (int j = 0; j < 4; ++j) { o0[j] = (h0[j] + s0[j]) * gelu_tanh(y0[j]); o1[j] = (h1[j] + s1[j]) * gelu_tanh(y1[j]); }
                    *(u32x4*)(RYb + off) = pack8(o0, o1);
                }
            }
        }
    }
    __syncthreads();
}

__device__ __forceinline__ void run_phase(int ph, unsigned char* lds) {
#if defined(__HIP_DEVICE_COMPILE__)
    const __attribute__((address_space(4))) P* pp = (const __attribute__((address_space(4))) P*)__builtin_amdgcn_kernarg_segment_ptr();
    asm volatile("" : "+s"(pp));
    const P p = *pp;
#else
    const P p{};
#endif
    const int tid = opaque_tid(), lane = tid & 63, wave = tid >> 6;
    const int bid = blockIdx.x, G = gridDim.x;
    const int gw = bid * NWAVES + wave, NGW = G * NWAVES;
    float* scr = (float*)(lds + wave * 16384);
    PG8_LAS unsigned char* ldsl = (PG8_LAS unsigned char*)lds;
    const float* mod = (const float*)(p.ws + OFF_MOD);
    bf16_t* Hb = (bf16_t*)(p.ws + OFF_A);
    float* XC = (float*)(p.ws + OFF_XC);
    if (ph == 0) {
        for (int it = bid; it < 192; it += G) mod_item(p, lds, it);
        if (bid == (192 % G)) table_item(p);
        __syncthreads();
        convert_WA(p, 0, scr, gw, NGW, lane);
        return;
    }
    if (ph == 1) {
        NormArgs a{}; a.xl = p.in[I_X]; a.xc = p.in[I_CTX]; a.y = nullptr; a.h = Hb; a.gpre = p.in[I_GPREMIX]; a.modh = mod; a.shift_idx = 0; a.nrows = MA;
        norm_rows(a, gw, NGW, lane);
        return;
    }
    const int l = (ph - 2) >> 3, sp = (ph - 2) & 7;
    const bool last = (l == 1);
    const int Mrows = last ? ML : MA;
    const float* modl = mod + (size_t)l * 9 * 6144;
    if (sp == 0) {
        EpiIn e{(bf16_t*)(p.ws + OFF_Q), (bf16_t*)(p.ws + OFF_KV), (bf16_t*)(p.ws + OFF_RX), (bf16_t*)(p.ws + OFF_PU), (bf16_t*)(p.ws + OFF_RY), (bf16_t*)(p.ws + OFF_G),
                (const float*)(p.ws + OFF_TAB), (const float*)(p.ws + OFF_TAB) + 1024};
        const bf16_t* Wt = (const bf16_t*)(p.ws + OFF_WA + WA_IN);
        EpiW<EpiIn> E{e};
        if (!last) { pg8::Gemm g{Hb, Wt, MA, INW, DM}; pg8::StaticOrder S; S.init(MA, INW, G, bid); pg8::gemm_phase<EpiW<EpiIn>, pg8::StaticOrder, true, true>(ldsl, g, S, E); }
        else { pg8::Gemm g{Hb, Wt, MA, INW, DM}; InOrder1 S; S.init(G, bid); pg8::gemm_phase<EpiW<EpiIn>, InOrder1, true, true>(ldsl, g, S, E); }
        return;
    }
    if (sp == 1) {
        const bool need_ctx = !last;
        const bool split = (G >= 128);
        if (split && bid < 64) { rnn_item(p, l, lds, bid >> 3, bid & 7, need_ctx); return; }
        if (!split) for (int it = bid; it < 64; it += G) rnn_item(p, l, lds, it >> 3, it & 7, need_ctx);
        const int vb = split ? bid - 64 : bid, VG = split ? G - 64 : G;
        const int nAL = 512, nAC = need_ctx ? 64 : 0, nPL = 1024, nPC = need_ctx ? 128 : 0;
        bf16_t* Qb = (bf16_t*)(p.ws + OFF_Q); const bf16_t* KVb = (const bf16_t*)(p.ws + OFF_KV);
        const float* sink = p.in[I_SINK] + l * 8;
        for (int it = vb; it < nAL + nAC + nPL + nPC; it += VG) {
            int r = it;
            if (r < nAL + nAC) {
                int b, qrow0, npos0; const int kvh = r & 1;
                if (r < nAL) { b = r >> 6; const int qb = (r >> 1) & 31; qrow0 = b * SEQ + 64 * qb; npos0 = 64 * qb; }
                else { const int rc = r - nAL; b = rc >> 3; const int qb = (rc >> 1) & 3; qrow0 = ML + b * CTX + 64 * qb; npos0 = -1; }
                attn_item(lds, Qb, KVb, sink, qrow0, kvh, npos0, b);
                continue;
            }
            r -= nAL + nAC;
            int b, tile, rb, L; const int g = r & 3;
            if (r < nPL) { b = r >> 7; tile = (r >> 2) & 31; rb = b * SEQ; L = SEQ; }
            else { const int rc = r - nPL; b = rc >> 4; tile = (rc >> 2) & 3; rb = ML + b * CTX; L = CTX; }
            pool_item(p, l, lds, rb, L, tile * 64, g);
        }
        return;
    }
    if (sp == 2) { gemm_merge(p, Mrows, bid, G); return; }
    if (sp == 3) {
        EpiStore e{(bf16_t*)(p.ws + OFF_G), DM};
        EpiW<EpiStore> E{e};
        pg8::Gemm g{(const bf16_t*)(p.ws + OFF_MERGED), (const bf16_t*)(p.ws + OFF_WA + WA_OUT), Mrows, DM, DM}; pg8::StaticOrder S; S.init(Mrows, DM, G, bid);
        pg8::gemm_phase<EpiW<EpiStore>, pg8::StaticOrder, true, true>(ldsl, g, S, E);
        return;
    }
    if (sp == 4) {
        NormArgs a{};
        a.xl = (l == 0) ? p.in[I_X] : p.out; a.xc = (l == 0) ? p.in[I_CTX] : XC; a.ol = p.out; a.oc = XC;
        a.y = (const bf16_t*)(p.ws + OFF_G); a.gpost = p.in[I_GPOSTMIX] + l * DM; a.modg = modl; a.gate_idx = 2;
        a.h = Hb; a.gpre = p.in[I_GPREFFN] + l * DM; a.modh = modl; a.shift_idx = 3; a.nrows = Mrows;
        norm_rows(a, gw, NGW, lane);
        convert_WB(p, l, scr, gw, NGW, lane);
        return;
    }
    if (sp == 5) {
        EpiSwiglu e{(bf16_t*)(p.ws + OFF_G)};
        EpiW<EpiSwiglu> E{e};
        pg8::Gemm g{Hb, (const bf16_t*)(p.ws + OFF_WB + WB_GU), Mrows, NGU, DM}; pg8::StaticOrder S; S.init(Mrows, NGU, G, bid);
        pg8::gemm_phase<EpiW<EpiSwiglu>, pg8::StaticOrder, true, true>(ldsl, g, S, E);
        return;
    }
    if (sp == 6) {
        EpiStore e{(bf16_t*)(p.ws + OFF_F), DM};
        EpiW<EpiStore> E{e};
        pg8::Gemm g{(const bf16_t*)(p.ws + OFF_G), (const bf16_t*)(p.ws + OFF_WB + WB_DOWN), Mrows, DM, DFF}; pg8::StaticOrder S; S.init(Mrows, DM, G, bid);
        pg8::gemm_phase<EpiW<EpiStore>, pg8::StaticOrder, true, true>(ldsl, g, S, E);
        return;
    }
    {
        NormArgs a{};
        a.xl = p.out; a.xc = XC; a.ol = p.out; a.oc = XC;
        a.y = (const bf16_t*)(p.ws + OFF_F); a.gpost = p.in[I_GPOSTFFN] + l * DM; a.modg = modl; a.gate_idx = 5;
        if (!last) { a.h = Hb; a.gpre = p.in[I_GPREMIX] + (l + 1) * DM; a.modh = mod + (size_t)(l + 1) * 9 * 6144; a.shift_idx = 0; }
        a.nrows = Mrows;
        norm_rows(a, gw, NGW, lane);
        if (!last) convert_WA(p, l + 1, scr, gw, NGW, lane);
    }
}

__global__ void __launch_bounds__(NTHREADS) mega(P p) {
    extern __shared__ __attribute__((aligned(16))) unsigned char lds[];
    for (int ph = p.ph_lo; ph < p.ph_hi; ++ph) {
        run_phase(ph, lds);
        if (ph + 1 < p.ph_hi) { cg::this_grid().sync(); }
    }
}

extern "C" void kernel_launch(void* const* d_in, const int* in_sizes, int n_in, void* d_out, int out_size, void* d_ws, size_t ws_size, hipStream_t stream) {
    static int grid = 0;
    if (grid == 0) {
        if (n_in != 27 || ws_size < WS_NEED) { fprintf(stderr, "kernel_launch: unexpected n_in %d or ws_size %zu\n", n_in, ws_size); grid = -1; return; }
        int dev = 0, cus = 0, per_cu = 0;
        hipGetDevice(&dev);
        hipDeviceGetAttribute(&cus, hipDeviceAttributeMultiprocessorCount, dev);
        hipFuncSetAttribute((const void*)mega, hipFuncAttributeMaxDynamicSharedMemorySize, LDS_BYTES);
        hipOccupancyMaxActiveBlocksPerMultiprocessor(&per_cu, (const void*)mega, NTHREADS, LDS_BYTES);
        if (per_cu < 1) { fprintf(stderr, "kernel_launch: occupancy query says %d blocks per CU\n", per_cu); per_cu = 1; }
        grid = cus;
    }
    if (grid < 0) return;
    hipMemsetAsync((char*)d_ws + OFF_CTL, 0, 1 * MiB, stream);
    P p{};
    for (int i = 0; i < 27; ++i) p.in[i] = (const float*)d_in[i];
    p.out = (float*)d_out; p.ws = (unsigned char*)d_ws;
#if PER_PHASE_LAUNCH
    for (int ph = 0; ph < NPHASES; ++ph) {
        p.ph_lo = ph; p.ph_hi = ph + 1;
        hipLaunchKernelGGL(mega, dim3(grid), dim3(NTHREADS), LDS_BYTES, stream, p);
    }
#else
    p.ph_lo = 0; p.ph_hi = NPHASES;
    void* args[] = {&p};
    hipError_t e = hipLaunchCooperativeKernel((const void*)mega, dim3(grid), dim3(NTHREADS), args, LDS_BYTES, stream);
    if (e != hipSuccess) fprintf(stderr, "cooperative launch failed: %s (grid %d)\n", hipGetErrorString(e), grid);
#endif
}
```

```cpp
#include <hip/hip_runtime.h>
#include <hip/hip_cooperative_groups.h>
#include <cstdio>
#include <cstdint>
namespace cg = cooperative_groups;

#ifndef PER_PHASE_LAUNCH
#define PER_PHASE_LAUNCH 0
#endif

typedef unsigned short bf16_t;
typedef short bf16x8 __attribute__((ext_vector_type(8)));
typedef short s16x4 __attribute__((ext_vector_type(4)));
typedef float f32x4 __attribute__((ext_vector_type(4)));
typedef float f32x16 __attribute__((ext_vector_type(16)));
typedef unsigned u32x4 __attribute__((ext_vector_type(4)));
typedef unsigned u32x2 __attribute__((ext_vector_type(2)));

constexpr int DM = 1024, NBATCH = 8, SEQ = 2048, CTX = 256;
constexpr int ML = NBATCH * SEQ;
constexpr int MC = NBATCH * CTX;
constexpr int MA = ML + MC;
constexpr int INW = 5376, DFF = 2816, NGU = 5632;
constexpr float EPS = 1e-6f;
constexpr float LOG2E = 1.4426950408889634f;
constexpr float QSCALE = 0.125f * LOG2E;
constexpr int NTHREADS = 512, NWAVES = 8;
constexpr int LDS_BYTES = 147456;
constexpr int NPHASES = 18;

constexpr size_t MiB = 1u << 20;
constexpr size_t OFF_CTL = 0;
constexpr size_t OFF_TAB = 1 * MiB;
constexpr size_t OFF_MOD = 1 * MiB + 65536;
constexpr size_t OFF_WA = 2 * MiB;
constexpr size_t WA_IN = 0, WA_AO = 11010048, WA_PO = WA_AO + 1048576, WA_RO = WA_PO + 1048576, WA_OUT = WA_RO + 1048576,
                 WA_PM = WA_OUT + 2097152, WA_LA = WA_PM + 131072, WA_LX = WA_LA + 131072;
constexpr size_t OFF_A = 18 * MiB;
constexpr size_t OFF_Q = 54 * MiB;
constexpr size_t OFF_KV = 72 * MiB;
constexpr size_t OFF_RX = 81 * MiB;
constexpr size_t OFF_PU = 99 * MiB;
constexpr size_t OFF_RY = 117 * MiB;
constexpr size_t OFF_MERGED = OFF_RX;
constexpr size_t OFF_F = OFF_Q;
constexpr size_t OFF_WB = 94 * MiB;
constexpr size_t WB_GU = 0, WB_DOWN = 11534336;
constexpr size_t OFF_G = 135 * MiB;
constexpr size_t OFF_XC = 243 * MiB;
constexpr size_t WS_NEED = 251 * MiB;

struct P {
    const float* in[27];
    float* out;
    unsigned char* ws;
    int ph_lo, ph_hi;
};
enum { I_X = 0, I_C, I_CTX, I_CCTX, I_WADA, I_BADA, I_GPREMIX, I_GPOSTMIX, I_GPREFFN, I_GPOSTFFN, I_WIN, I_SINK, I_WAO, I_PMIX, I_PSCALE, I_WPO,
       I_CONVW, I_CONVB, I_LWA, I_LBA, I_LWX, I_LBX, I_LAM, I_WRO, I_WOUT, I_WGU, I_WDOWN };

__device__ __forceinline__ float bf2f(unsigned v) { return __uint_as_float(v << 16); }
__device__ __forceinline__ unsigned f2bf(float f) { unsigned u = __float_as_uint(f); return (u + 0x7fffu + ((u >> 16) & 1u)) >> 16; }
__device__ __forceinline__ unsigned pk2(float lo, float hi) { return f2bf(lo) | (f2bf(hi) << 16); }
__device__ __forceinline__ float wave_sum(float v) {
#pragma unroll
    for (int o = 1; o < 64; o <<= 1) v += __shfl_xor(v, o);
    return v;
}
__device__ __forceinline__ float sigm(float x) { return 1.f / (1.f + __expf(-x)); }
__device__ __forceinline__ float gelu_tanh(float y) {
    const float z = 0.7978845608028654f * (y + 0.044715f * y * y * y);
    const float t = 1.f - 2.f / (1.f + __expf(2.f * z));
    return 0.5f * y * (1.f + t);
}
__device__ __forceinline__ int crow(int r, int hi) { return (r & 3) + 8 * (r >> 2) + 4 * hi; }
__device__ __forceinline__ int perm32(int rho) { const int n = rho >> 4, i = rho & 15; return 8 * (i >> 2) + 4 * n + (i & 3); }
#define LDS_WAIT() asm volatile("s_waitcnt lgkmcnt(0)" ::: "memory")
__device__ __forceinline__ int opaque_tid() { int t = threadIdx.x; asm volatile("" : "+v"(t)); return t; }
__device__ __forceinline__ f32x4 unpack4(u32x2 w) { return (f32x4){bf2f(w.x & 0xffffu), bf2f(w.x >> 16), bf2f(w.y & 0xffffu), bf2f(w.y >> 16)}; }
__device__ __forceinline__ void unpack8(u32x4 w, f32x4& a, f32x4& b) {
    a = (f32x4){bf2f(w.x & 0xffffu), bf2f(w.x >> 16), bf2f(w.y & 0xffffu), bf2f(w.y >> 16)};
    b = (f32x4){bf2f(w.z & 0xffffu), bf2f(w.z >> 16), bf2f(w.w & 0xffffu), bf2f(w.w >> 16)};
}
__device__ __forceinline__ u32x4 pack8(f32x4 a, f32x4 b) { u32x4 w; w.x = pk2(a[0], a[1]); w.y = pk2(a[2], a[3]); w.z = pk2(b[0], b[1]); w.w = pk2(b[2], b[3]); return w; }

__constant__ float ROPE_INV[16] = {1.0f, 0.5623413251903491f, 0.31622776601683794f, 0.1778279410038923f, 0.1f, 0.05623413251903491f, 0.03162277660168379f,
                                   0.01778279410038923f, 0.01f, 0.005623413251903491f, 0.003162277660168379f, 0.001778279410038923f, 0.001f,
                                   0.0005623413251903491f, 0.0003162277660168379f, 0.0001778279410038923f};

__device__ __forceinline__ int src_col(int mode, int n) {
    if (mode == 1) {
        if (n >= 640) return n;
        const int p = n & 63, hb = n - p, G = p >> 3, j = p & 7, half = G >> 2, g = G & 3;
        const int dim = half * 32 + ((j < 4) ? (4 * g + j) : (16 + 4 * g + (j - 4)));
        return hb + dim;
    }
    if (mode == 2) {
        const int q = n >> 3, t = n & 7;
        return (t < 4) ? (4 * q + t) : (DFF + 4 * q + (t - 4));
    }
    return n;
}
__device__ __forceinline__ void tr_item(const float* W, int K, int N, int Nout, bf16_t* WT, float* scr, int item, int lane, int mode) {
    const int nblk = Nout / 32, kb = item / nblk, nb = item % nblk, k0 = 64 * kb, n0 = 32 * nb;
    const int sc = src_col(mode, n0 + (lane & 31));
#pragma unroll 8
    for (int i = 0; i < 32; ++i) { const int kk = 2 * i + (lane >> 5); scr[kk * 33 + (lane & 31)] = W[(size_t)(k0 + kk) * N + sc]; }
    LDS_WAIT(); asm volatile("" ::: "memory");
    const int c = lane & 7;
#pragma unroll
    for (int j = 0; j < 4; ++j) {
        const int n = (lane >> 3) + 8 * j; const float* s = scr + (8 * c) * 33 + n;
        u32x4 o; o.x = pk2(s[0 * 33], s[1 * 33]); o.y = pk2(s[2 * 33], s[3 * 33]); o.z = pk2(s[4 * 33], s[5 * 33]); o.w = pk2(s[6 * 33], s[7 * 33]);
        *(u32x4*)(WT + (size_t)(n0 + n) * K + k0 + 8 * c) = o;
    }
    LDS_WAIT(); asm volatile("" ::: "memory");
}
constexpr int WA_ITEMS = 2688 + 3 * 256 + 512 + 32 + 32 + 32;
constexpr int WB_ITEMS = 2816 + 1408;
__device__ __forceinline__ void convert_WA(const P& p, int l, unsigned char* lds, int NGW) {
    const int tid_ = opaque_tid(), lane = tid_ & 63, gw = blockIdx.x * NWAVES + (tid_ >> 6);
    float* scr = (float*)(lds + (tid_ >> 6) * 16384);
    unsigned char* wa = p.ws + OFF_WA;
    for (int it = gw; it < WA_ITEMS; it += NGW) {
        int r = it;
        if (r < 2688) { tr_item(p.in[I_WIN] + (size_t)l * DM * INW, DM, INW, INW, (bf16_t*)(wa + WA_IN), scr, r, lane, 1); continue; } r -= 2688;
        if (r < 256) { tr_item(p.in[I_WAO] + (size_t)l * 512 * DM, 512, DM, DM, (bf16_t*)(wa + WA_AO), scr, r, lane, 0); continue; } r -= 256;
        if (r < 256) { tr_item(p.in[I_WPO] + (size_t)l * 512 * DM, 512, DM, DM, (bf16_t*)(wa + WA_PO), scr, r, lane, 0); continue; } r -= 256;
        if (r < 256) { tr_item(p.in[I_WRO] + (size_t)l * 512 * DM, 512, DM, DM, (bf16_t*)(wa + WA_RO), scr, r, lane, 0); continue; } r -= 256;
        if (r < 512) { tr_item(p.in[I_WOUT] + (size_t)l * DM * DM, DM, DM, DM, (bf16_t*)(wa + WA_OUT), scr, r, lane, 0); continue; } r -= 512;
        if (r < 32) { const int g = r >> 3; tr_item(p.in[I_PMIX] + (size_t)(l * 4 + g) * 16384, 128, 128, 128, (bf16_t*)(wa + WA_PM) + g * 16384, scr, r & 7, lane, 0); continue; } r -= 32;
        if (r < 32) { const int m = r >> 1; tr_item(p.in[I_LWA] + (size_t)(l * 16 + m) * 4096, 64, 64, 64, (bf16_t*)(wa + WA_LA) + m * 4096, scr, r & 1, lane, 0); continue; } r -= 32;
        { const int m = r >> 1; tr_item(p.in[I_LWX] + (size_t)(l * 16 + m) * 4096, 64, 64, 64, (bf16_t*)(wa + WA_LX) + m * 4096, scr, r & 1, lane, 0); }
    }
}
__device__ __forceinline__ void convert_WB(const P& p, int l, unsigned char* lds, int NGW) {
    const int tid_ = opaque_tid(), lane = tid_ & 63, gw = blockIdx.x * NWAVES + (tid_ >> 6);
    float* scr = (float*)(lds + (tid_ >> 6) * 16384);
    unsigned char* wb = p.ws + OFF_WB;
    for (int it = gw; it < WB_ITEMS; it += NGW) {
        int r = it;
        if (r < 2816) { tr_item(p.in[I_WGU] + (size_t)l * DM * NGU, DM, NGU, NGU, (bf16_t*)(wb + WB_GU), scr, r, lane, 2); continue; } r -= 2816;
        tr_item(p.in[I_WDOWN] + (size_t)l * DFF * DM, DFF, DM, DM, (bf16_t*)(wb + WB_DOWN), scr, r, lane, 0);
    }
}

__device__ __forceinline__ void mod_item(const P& p, unsigned char* lds, int item) {
    const int tid = opaque_tid(), lane = tid & 63, wave = tid >> 6;
    const int l = item / 96, cgp = item % 96;
    float* sc = (float*)lds;
    float* red = (float*)(lds + 36864);
    for (int idx = tid; idx < 9 * 1024; idx += NTHREADS) {
        const int r = idx >> 10, k = idx & 1023;
        const float v = (r < 8) ? p.in[I_C][r * 1024 + k] : p.in[I_CCTX][k];
        sc[idx] = v / (1.f + __expf(-v));
    }
    __syncthreads();
    float acc[9];
#pragma unroll
    for (int r = 0; r < 9; ++r) acc[r] = 0.f;
    const float* wp = p.in[I_WADA] + (size_t)l * 1024 * 6144 + cgp * 64 + lane;
    const int kbeg = wave * 128;
#pragma unroll 4
    for (int k = kbeg; k < kbeg + 128; ++k) {
        const float w = wp[(size_t)k * 6144];
#pragma unroll
        for (int r = 0; r < 9; ++r) acc[r] += sc[r * 1024 + k] * w;
    }
#pragma unroll
    for (int r = 0; r < 9; ++r) red[(wave * 9 + r) * 64 + lane] = acc[r];
    __syncthreads();
    float* mod = (float*)(p.ws + OFF_MOD);
    for (int idx = tid; idx < 9 * 64; idx += NTHREADS) {
        const int r = idx >> 6, ln = idx & 63;
        float s = 0.f;
#pragma unroll
        for (int w = 0; w < 8; ++w) s += red[(w * 9 + r) * 64 + ln];
        const int j = cgp * 64 + ln;
        mod[(size_t)(l * 9 + r) * 6144 + j] = s + p.in[I_BADA][l * 6144 + j];
    }
    __syncthreads();
}
__device__ __forceinline__ void table_item(const P& p) {
    float* tc = (float*)(p.ws + OFF_TAB); float* ts = tc + 1024;
    for (int idx = opaque_tid(); idx < 1024; idx += NTHREADS) {
        const int pos = idx >> 4, i = idx & 15;
        const float ang = (float)pos * ROPE_INV[i];
        const double x = (double)ang;
        const double n = rint(x * 0.6366197723675814);
        const double r = x - n * 1.5707963267948966;
        const double r2 = r * r;
        const double sr = r * (1.0 - r2 / 6.0 * (1.0 - r2 / 20.0 * (1.0 - r2 / 42.0 * (1.0 - r2 / 72.0 * (1.0 - r2 / 110.0 * (1.0 - r2 / 156.0))))));
        const double cr = 1.0 - r2 / 2.0 * (1.0 - r2 / 12.0 * (1.0 - r2 / 30.0 * (1.0 - r2 / 56.0 * (1.0 - r2 / 90.0 * (1.0 - r2 / 132.0 * (1.0 - r2 / 182.0))))));
        const int q = ((int)n) & 3;
        double s, c;
        if (q == 0) { s = sr; c = cr; } else if (q == 1) { s = cr; c = -sr; } else if (q == 2) { s = -sr; c = -cr; } else { s = -cr; c = sr; }
        tc[idx] = (float)c; ts[idx] = (float)s;
    }
}

struct NormArgs {
    const float* xl; const float* xc;
    float* ol; float* oc;
    const bf16_t* y;
    const float* gpost; const float* modg; int gate_idx;
    bf16_t* h; const float* gpre; const float* modh; int shift_idx;
    int nrows;
};
__device__ __forceinline__ void norm_rows(const NormArgs& a, int NGW) {
    const int tid_ = opaque_tid(), lane = tid_ & 63, gw = blockIdx.x * NWAVES + (tid_ >> 6);
    for (int r = gw; r < a.nrows; r += NGW) {
        const bool isl = r < ML;
        const int mrow = isl ? (r >> 11) : 8;
        const float* xin = isl ? a.xl + (size_t)r * DM : a.xc + (size_t)(r - ML) * DM;
        f32x4 v[4];
#pragma unroll
        for (int j = 0; j < 4; ++j) v[j] = *(const f32x4*)(xin + 4 * lane + 256 * j);
        if (a.y) {
            f32x4 yv[4]; float ss = 0.f;
#pragma unroll
            for (int j = 0; j < 4; ++j) { yv[j] = unpack4(*(const u32x2*)(a.y + (size_t)r * DM + 4 * lane + 256 * j)); ss += (yv[j][0] * yv[j][0] + yv[j][1] * yv[j][1]) + (yv[j][2] * yv[j][2] + yv[j][3] * yv[j][3]); }
            const float rstd = rsqrtf(wave_sum(ss) * (1.f / DM) + EPS);
#pragma unroll
            for (int j = 0; j < 4; ++j) {
                const int col = 4 * lane + 256 * j;
                const f32x4 gt = *(const f32x4*)(a.modg + (size_t)mrow * 6144 + a.gate_idx * 1024 + col);
                const f32x4 gp = *(const f32x4*)(a.gpost + col);
                v[j] = v[j] + gt * ((yv[j] * rstd) * gp);
            }
            float* xo = isl ? (a.ol ? a.ol + (size_t)r * DM : nullptr) : (a.oc ? a.oc + (size_t)(r - ML) * DM : nullptr);
            if (xo) {
#pragma unroll
                for (int j = 0; j < 4; ++j) *(f32x4*)(xo + 4 * lane + 256 * j) = v[j];
            }
        }
        if (a.h) {
            float ss = 0.f;
#pragma unroll
            for (int j = 0; j < 4; ++j) ss += (v[j][0] * v[j][0] + v[j][1] * v[j][1]) + (v[j][2] * v[j][2] + v[j][3] * v[j][3]);
            const float rstd = rsqrtf(wave_sum(ss) * (1.f / DM) + EPS);
#pragma unroll
            for (int j = 0; j < 4; ++j) {
                const int col = 4 * lane + 256 * j;
                const f32x4 gp = *(const f32x4*)(a.gpre + col);
                const f32x4 sh = *(const f32x4*)(a.modh + (size_t)mrow * 6144 + a.shift_idx * 1024 + col);
                const f32x4 scl = *(const f32x4*)(a.modh + (size_t)mrow * 6144 + (a.shift_idx + 1) * 1024 + col);
                const f32x4 hv = ((v[j] * rstd) * gp) * (1.f + scl) + sh;
                u32x2 w; w.x = pk2(hv[0], hv[1]); w.y = pk2(hv[2], hv[3]);
                *(u32x2*)(a.h + (size_t)r * DM + col) = w;
            }
        }
    }
}

namespace pg8 {
#define PG8_LAS __attribute__((address_space(3)))
typedef unsigned short bf16_t;
typedef short bf16x8 __attribute__((ext_vector_type(8)));
typedef float f32x4 __attribute__((ext_vector_type(4)));
typedef unsigned u32x4 __attribute__((ext_vector_type(4)));
constexpr int BM = 256, BK = 64, HALF = 128, HTB = HALF * BK * 2  , STAGE_BYTES = 8 * HTB, NXCD = 8, WGM = 8;

__host__ __device__ __forceinline__ int lds_byte(int r, int c) { const int st = (r >> 4) * 2 + (c >> 5), rr = r & 15, cc = c & 31, ob = rr * 64 + cc * 2; return st * 1024 + (ob ^ (((ob >> 9) & 1) << 5)); }
__host__ __device__ __forceinline__ void stage_rc(int b, int& R, int& C) { const int st = b / 1024, sb = b % 1024, swz = sb ^ (((sb >> 9) & 1) << 5); R = (st >> 1) * 16 + swz / 64; C = (st & 1) * 32 + (swz % 64) / 2; }
__host__ __device__ __forceinline__ int perm32(int rho) { const int n = rho >> 4, i = rho & 15; return 8 * (i >> 2) + 4 * n + (i & 3); }

struct Unit { int pm, pn; };
struct Gemm { const bf16_t* A; const bf16_t* Bt; int M, N, K; };

struct StaticOrder {
    int nM, nN, nwg, G, c;
    __host__ __device__ void init(int M, int N, int G_, int c_) { nM = M / BM; nN = N / BM; nwg = nM * nN; G = G_; c = c_; }
    __host__ __device__ bool next(int i, Unit& u) const {
        const long L = (long)i * G + c; if (L >= nwg) return false;
        int wgid = (int)L; { const int q = nwg / NXCD, r = nwg % NXCD, xcd = wgid % NXCD, off = wgid / NXCD; wgid = (xcd < r ? xcd * (q + 1) : r * (q + 1) + (xcd - r) * q) + off; }
        const int nig = WGM * nN, gid = wgid / nig, fm = gid * WGM, gsz = (nM - fm) < WGM ? (nM - fm) : WGM;
        u.pm = fm + ((wgid % nig) % gsz); u.pn = (wgid % nig) / gsz; return true;
    }
    __device__ __forceinline__ void a_ready(const Unit&) const {}
    __device__ __forceinline__ void done(const Unit&) const {}
};


template <class Epi, class Sched, bool ALIGN_EPI = false, bool SP2 = false>
__device__ __forceinline__ void gemm_phase(PG8_LAS unsigned char* lds, const Gemm g, const Sched& S, const Epi& E) {
    const int tid = opaque_tid(), wid = __builtin_amdgcn_readfirstlane(tid >> 6), lane = tid & 63, wr = wid >> 2, wc = wid & 3, fr = lane & 15, fq = lane >> 4;
    const int K = g.K, nt = K / BK;
    unsigned voffA[2], voffB[2];
#pragma unroll
    for (int i = 0; i < 2; ++i) { int R, C; stage_rc(tid * 16 + i * 8192, R, C); const int Rb = Epi::PERM ? ((R & ~31) + perm32(R & 31)) : R;
        voffA[i] = (unsigned)(R * K + C) * 2u; voffB[i] = (unsigned)(Rb * K + C) * 2u; }
    const size_t kstep = (size_t)(BK * 2);
    const size_t hstep = (size_t)HALF * K * 2;
    const size_t tstep = 2 * hstep;
    const unsigned ldsw = (unsigned)wid * 1024u;
    const int aoff = lds_byte(wr * 64 + fr, fq * 8), boff = lds_byte(wc * 32 + fr, fq * 8);
#define PG8_SA(b, h) (((b) * 2 + (h)) * HTB)
#define PG8_SB(b, h) ((4 + (b) * 2 + (h)) * HTB)
#define PG8_STAGE(bufoff, gbase, voff) do { _Pragma("unroll") for (int _i = 0; _i < 2; ++_i) \
        __builtin_amdgcn_global_load_lds((const unsigned*)((const char*)(gbase) + (voff)[_i]), (PG8_LAS unsigned*)(lds + (bufoff) + ldsw + _i * 8192), 16, 0, 0); } while (0)
#define PG8_LDA(dst, b, h) do { _Pragma("unroll") for (int m = 0; m < 4; ++m) _Pragma("unroll") for (int k = 0; k < 2; ++k) dst[m][k] = *(const PG8_LAS bf16x8*)(lds + PG8_SA(b, h) + aoff + m * 2048 + k * 1024); } while (0)
#define PG8_LDB(dst, b, h) do { _Pragma("unroll") for (int n = 0; n < 2; ++n) _Pragma("unroll") for (int k = 0; k < 2; ++k) dst[n][k] = *(const PG8_LAS bf16x8*)(lds + PG8_SB(b, h) + boff + n * 2048 + k * 1024); } while (0)
#define PG8_MMA(ai, bj, At, Bt) do { __builtin_amdgcn_s_setprio(1); _Pragma("unroll") for (int m = 0; m < 4; ++m) _Pragma("unroll") for (int n = 0; n < 2; ++n) _Pragma("unroll") for (int k = 0; k < 2; ++k) \
        acc[ai][bj][m][n] = __builtin_amdgcn_mfma_f32_16x16x32_bf16(Bt[n][k], At[m][k], acc[ai][bj][m][n], 0, 0, 0); __builtin_amdgcn_s_setprio(0); } while (0)
#define PG8_WAIT_V(n) asm volatile("s_waitcnt vmcnt(" #n ")" ::: "memory")
#define PG8_WAIT_L(n) asm volatile("s_waitcnt lgkmcnt(" #n ")" ::: "memory")
#define PG8_BAR __builtin_amdgcn_s_barrier()
#define PG8_SCHED __builtin_amdgcn_sched_barrier(0)
    Unit cur, nxt; int ui = 0;
    if (!S.next(0, cur)) return;
    f32x4 acc[2][2][4][2];
#pragma unroll
    for (int a = 0; a < 2; ++a)
#pragma unroll
        for (int b = 0; b < 2; ++b)
#pragma unroll
            for (int m = 0; m < 4; ++m)
#pragma unroll
                for (int n = 0; n < 2; ++n) acc[a][b][m][n] = (f32x4){0.f, 0.f, 0.f, 0.f};
    bf16x8 At[4][2], B0[2][2], B1[2][2];
    const char* cA = (const char*)g.A + (size_t)cur.pm * tstep; const char* cB = (const char*)g.Bt + (size_t)cur.pn * tstep;
    S.a_ready(cur);
    if constexpr (SP2) {
        PG8_STAGE(PG8_SB(0, 0), cB, voffB); PG8_STAGE(PG8_SB(0, 1), cB + hstep, voffB); PG8_STAGE(PG8_SA(0, 0), cA, voffA); PG8_STAGE(PG8_SA(0, 1), cA + hstep, voffA);
        if (wr == 1) PG8_BAR;
        PG8_WAIT_V(2); PG8_BAR;
        PG8_STAGE(PG8_SB(1, 0), cB + kstep, voffB); PG8_STAGE(PG8_SA(1, 0), cA + kstep, voffA); PG8_STAGE(PG8_SB(1, 1), cB + hstep + kstep, voffB);
        PG8_WAIT_V(6); PG8_BAR;
    } else {
        PG8_STAGE(PG8_SB(0, 0), cB, voffB); PG8_STAGE(PG8_SA(0, 0), cA, voffA); PG8_STAGE(PG8_SB(0, 1), cB + hstep, voffB); PG8_STAGE(PG8_SA(0, 1), cA + hstep, voffA);
        if (wr == 1) PG8_BAR;
        PG8_WAIT_V(4); PG8_BAR;
        PG8_STAGE(PG8_SB(1, 0), cB + kstep, voffB); PG8_STAGE(PG8_SA(1, 0), cA + kstep, voffA); PG8_STAGE(PG8_SB(1, 1), cB + hstep + kstep, voffB);
        PG8_WAIT_V(6); PG8_BAR;
    }
    for (;;) {
        const bool has_next = S.next(ui + 1, nxt);
        const char* nA = has_next ? (const char*)g.A + (size_t)nxt.pm * tstep : cA; const char* nB = has_next ? (const char*)g.Bt + (size_t)nxt.pn * tstep : cB;
        for (int t = 0; t < nt; t += 2) {
            const bool last = (t == nt - 2);
            const char* a1 = cA + (size_t)(t + 1) * kstep;
            const char* a2 = last ? nA : cA + (size_t)(t + 2) * kstep; const char* b2 = last ? nB : cB + (size_t)(t + 2) * kstep;
            const char* a3 = a2 + kstep; const char* b3 = b2 + kstep;
            if (last && has_next) S.a_ready(nxt);
            if constexpr (SP2) {
            PG8_LDB(B0, 0, 0); PG8_LDB(B1, 0, 1); PG8_SCHED; PG8_LDA(At, 0, 0); PG8_STAGE(PG8_SA(1, 1), a1 + hstep, voffA);
            PG8_WAIT_V(8); PG8_WAIT_L(0); PG8_BAR; PG8_MMA(0, 0, At, B0); PG8_MMA(0, 1, At, B1); PG8_BAR; PG8_SCHED;
            PG8_LDA(At, 0, 1); PG8_STAGE(PG8_SB(0, 0), b2, voffB); PG8_STAGE(PG8_SB(0, 1), b2 + hstep, voffB); PG8_STAGE(PG8_SA(0, 0), a2, voffA);
            PG8_WAIT_V(8); PG8_WAIT_L(0); PG8_BAR; PG8_MMA(1, 0, At, B0); PG8_MMA(1, 1, At, B1); PG8_BAR; PG8_SCHED;
            PG8_LDB(B0, 1, 0); PG8_LDB(B1, 1, 1); PG8_SCHED; PG8_LDA(At, 1, 0); PG8_STAGE(PG8_SA(0, 1), a2 + hstep, voffA);
            PG8_WAIT_V(8); PG8_WAIT_L(0); PG8_BAR; PG8_MMA(0, 0, At, B0); PG8_MMA(0, 1, At, B1); PG8_BAR; PG8_SCHED;
            PG8_LDA(At, 1, 1); PG8_STAGE(PG8_SB(1, 0), b3, voffB); PG8_STAGE(PG8_SB(1, 1), b3 + hstep, voffB); PG8_STAGE(PG8_SA(1, 0), a3, voffA);
            PG8_WAIT_V(8); PG8_WAIT_L(0); PG8_BAR; PG8_MMA(1, 0, At, B0); PG8_MMA(1, 1, At, B1); PG8_BAR; PG8_SCHED;
            } else {
            PG8_LDB(B0, 0, 0); PG8_SCHED; PG8_LDA(At, 0, 0); PG8_STAGE(PG8_SA(1, 1), a1 + hstep, voffA);
            PG8_WAIT_L(8); PG8_BAR; PG8_WAIT_L(0); PG8_MMA(0, 0, At, B0); PG8_BAR; PG8_SCHED;
            PG8_LDB(B1, 0, 1); PG8_STAGE(PG8_SB(0, 0), b2, voffB);
            PG8_BAR; PG8_WAIT_L(0); PG8_MMA(0, 1, At, B1); PG8_BAR;
            PG8_LDA(At, 0, 1); PG8_STAGE(PG8_SA(0, 0), a2, voffA);
            PG8_BAR; PG8_WAIT_L(0); PG8_MMA(1, 0, At, B0); PG8_BAR; PG8_SCHED;
            PG8_STAGE(PG8_SB(0, 1), b2 + hstep, voffB);
            PG8_WAIT_V(6); PG8_BAR; PG8_MMA(1, 1, At, B1); PG8_BAR;
            PG8_LDB(B0, 1, 0); PG8_SCHED; PG8_LDA(At, 1, 0); PG8_STAGE(PG8_SA(0, 1), a2 + hstep, voffA);
            PG8_WAIT_L(8); PG8_BAR; PG8_WAIT_L(0); PG8_MMA(0, 0, At, B0); PG8_BAR; PG8_SCHED;
            PG8_LDB(B1, 1, 1); PG8_STAGE(PG8_SB(1, 0), b3, voffB);
            PG8_BAR; PG8_WAIT_L(0); PG8_MMA(0, 1, At, B1); PG8_BAR;
            PG8_LDA(At, 1, 1); PG8_STAGE(PG8_SA(1, 0), a3, voffA);
            PG8_BAR; PG8_WAIT_L(0); PG8_MMA(1, 0, At, B0); PG8_BAR; PG8_SCHED;
            PG8_STAGE(PG8_SB(1, 1), b3 + hstep, voffB);
            PG8_WAIT_V(6); PG8_BAR; PG8_MMA(1, 1, At, B1); PG8_BAR;
            }
        }
        if constexpr (ALIGN_EPI) { if (wr == 0) PG8_BAR; }
        if constexpr (!Epi::AFTER_DRAIN) { E(acc, cur, wr, wc, fr, fq); S.done(cur); }
        if (!has_next) break;
#pragma unroll
        for (int a = 0; a < 2; ++a)
#pragma unroll
            for (int b = 0; b < 2; ++b)
#pragma unroll
                for (int m = 0; m < 4; ++m)
#pragma unroll
                    for (int n = 0; n < 2; ++n) acc[a][b][m][n] = (f32x4){0.f, 0.f, 0.f, 0.f};
        cur = nxt; cA = nA; cB = nB; ++ui;
        if constexpr (ALIGN_EPI) { if (wr == 1) PG8_BAR; }
    }
    PG8_WAIT_V(0);
    if constexpr (!ALIGN_EPI) { if (wr == 0) PG8_BAR; }
    PG8_BAR;
    if constexpr (Epi::AFTER_DRAIN) { E.fused(acc, cur, wr, wc, fr, fq, lds, wid, lane); S.done(cur); }
#undef PG8_SA
#undef PG8_SB
#undef PG8_STAGE
#undef PG8_LDA
#undef PG8_LDB
#undef PG8_MMA
#undef PG8_WAIT_V
#undef PG8_WAIT_L
#undef PG8_BAR
#undef PG8_SCHED
}
}

struct EpiIn {
    bf16_t *Q, *KV, *RX, *PU, *RY, *G; const float* tcos; const float* tsin;
    __device__ __forceinline__ void operator()(int row, int c8, f32x4 v0, f32x4 v1) const {
        if (c8 < 640) {
            if (row < ML) {
                const int s = row & 2047, pp = c8 & 63, Gq = pp >> 3;
                const int pos = (Gq & 4) ? (s & 63) : (s >> 6);
                const int i0 = (Gq & 3) * 4;
                const f32x4 cs = *(const f32x4*)(tcos + pos * 16 + i0), sn = *(const f32x4*)(tsin + pos * 16 + i0);
                const f32x4 a = v0 * cs - v1 * sn, b = v1 * cs + v0 * sn; v0 = a; v1 = b;
            }
            if (c8 < 512) { v0 = v0 * QSCALE; v1 = v1 * QSCALE; *(u32x4*)(Q + (size_t)row * 512 + c8) = pack8(v0, v1); }
            else *(u32x4*)(KV + (size_t)row * 256 + (c8 - 512)) = pack8(v0, v1);
        } else if (c8 < 768) *(u32x4*)(KV + (size_t)row * 256 + 128 + (c8 - 640)) = pack8(v0, v1);
        else if (c8 < 1280) *(u32x4*)(RX + (size_t)row * 512 + (c8 - 768)) = pack8(v0, v1);
        else if (c8 < 1792) *(u32x4*)(RY + (size_t)row * 512 + (c8 - 1280)) = pack8(v0, v1);
        else if (c8 < 2304) *(u32x4*)(PU + (size_t)row * 512 + (c8 - 1792)) = pack8(v0, v1);
        else {
#pragma unroll
            for (int j = 0; j < 4; ++j) { v0[j] = sigm(v0[j]); v1[j] = sigm(v1[j]); }
            *(u32x4*)(G + (size_t)row * 3072 + (c8 - 2304)) = pack8(v0, v1);
        }
    }
};
struct EpiStore {
    bf16_t* O; int ldc;
    __device__ __forceinline__ void operator()(int row, int c8, f32x4 v0, f32x4 v1) const { *(u32x4*)(O + (size_t)row * ldc + c8) = pack8(v0, v1); }
};
struct EpiSwiglu {
    bf16_t* O;
    __device__ __forceinline__ void operator()(int row, int c8, f32x4 v0, f32x4 v1) const {
        f32x4 o;
#pragma unroll
        for (int j = 0; j < 4; ++j) o[j] = v0[j] * sigm(v0[j]) * v1[j];
        u32x2 w; w.x = pk2(o[0], o[1]); w.y = pk2(o[2], o[3]);
        *(u32x2*)(O + (size_t)row * DFF + (c8 >> 1)) = w;
    }
};

template <class F> struct EpiW {
    static constexpr bool PERM = true, AFTER_DRAIN = false;
    F f;
    __device__ __forceinline__ void operator()(const pg8::f32x4 (&acc)[2][2][4][2], const pg8::Unit& u, int wr, int wc, int fr, int fq) const {
        const int row0 = u.pm * 256 + wr * 64 + fr, col0 = u.pn * 256 + wc * 32 + 8 * fq;
#pragma unroll
        for (int ai = 0; ai < 2; ++ai)
#pragma unroll
            for (int m = 0; m < 4; ++m)
#pragma unroll
                for (int bj = 0; bj < 2; ++bj) f(row0 + ai * 128 + m * 16, col0 + bj * 128, acc[ai][bj][m][0], acc[ai][bj][m][1]);
    }
};
struct EpiAll {
    int kind; unsigned char* ws; size_t ooff;
    __device__ __forceinline__ void operator()(int row, int c8, f32x4 v0, f32x4 v1) const {
        if (kind == 0) {
            EpiIn e{(bf16_t*)(ws + OFF_Q), (bf16_t*)(ws + OFF_KV), (bf16_t*)(ws + OFF_RX), (bf16_t*)(ws + OFF_PU), (bf16_t*)(ws + OFF_RY), (bf16_t*)(ws + OFF_G),
                    (const float*)(ws + OFF_TAB), (const float*)(ws + OFF_TAB) + 1024};
            e(row, c8, v0, v1);
        } else if (kind == 1) {
            *(u32x4*)((bf16_t*)(ws + ooff) + (size_t)row * DM + c8) = pack8(v0, v1);
        } else {
            EpiSwiglu e{(bf16_t*)(ws + OFF_G)};
            e(row, c8, v0, v1);
        }
    }
};
struct UOrder {
    pg8::StaticOrder so; int extra;
    __device__ void init(int M, int N, int G, int c, int extra_) { so.init(M, N, G, c); extra = extra_; }
    __device__ bool next(int i, pg8::Unit& u) const {
        const long L = (long)i * so.G + so.c;
        if (L < so.nwg) return so.next(i, u);
        const int r = (int)(L - so.nwg); if (r >= extra) return false;
        u.pm = 64 + (r & 7); u.pn = 2 + (r >> 3); return true;
    }
    __device__ __forceinline__ void a_ready(const pg8::Unit&) const {}
    __device__ __forceinline__ void done(const pg8::Unit&) const {}
};
__device__ __forceinline__ void gemm_wave_acc(const bf16_t* A, const bf16_t* Bt, int K, int rw, int cw, int fr, int fq, f32x4 (&acc)[4][4]) {
    const bf16_t* ap[4]; const bf16_t* bp[4];
#pragma unroll
    for (int i = 0; i < 4; ++i) ap[i] = A + (size_t)(rw + 16 * i + fr) * K + 8 * fq;
#pragma unroll
    for (int q = 0; q < 4; ++q) bp[q] = Bt + (size_t)(cw + 32 * (q >> 1) + perm32(16 * (q & 1) + fr)) * K + 8 * fq;
#pragma unroll 2
    for (int k = 0; k < K; k += 32) {
        bf16x8 af[4], bfr[4];
#pragma unroll
        for (int i = 0; i < 4; ++i) af[i] = *(const bf16x8*)(ap[i] + k);
#pragma unroll
        for (int q = 0; q < 4; ++q) bfr[q] = *(const bf16x8*)(bp[q] + k);
#pragma unroll
        for (int i = 0; i < 4; ++i)
#pragma unroll
            for (int q = 0; q < 4; ++q) acc[i][q] = __builtin_amdgcn_mfma_f32_16x16x32_bf16(bfr[q], af[i], acc[i][q], 0, 0, 0);
    }
}
template <class Epi>
__device__ __forceinline__ void gemm_simple(const bf16_t* A, const bf16_t* Bt, int K, int row_off, int M, int col_off, int N, const Epi& epi, int bid, int G) {
    const int tid = opaque_tid(), lane = tid & 63, wave = tid >> 6, wr = wave >> 2, wc = wave & 3, fr = lane & 15, fq = lane >> 4;
    const int nM = M / 128, nN = N / 256;
    for (int u = bid; u < nM * nN; u += G) {
        const int pm = u % nM, pn = u / nM;
        const int rw = row_off + pm * 128 + wr * 64, cw = col_off + pn * 256 + wc * 64;
        f32x4 acc[4][4];
#pragma unroll
        for (int i = 0; i < 4; ++i)
#pragma unroll
            for (int q = 0; q < 4; ++q) acc[i][q] = (f32x4){0.f, 0.f, 0.f, 0.f};
        gemm_wave_acc(A, Bt, K, rw, cw, fr, fq, acc);
#pragma unroll
        for (int i = 0; i < 4; ++i)
#pragma unroll
            for (int g = 0; g < 2; ++g) epi(rw + 16 * i + fr, cw + 32 * g + 8 * fq, acc[i][2 * g], acc[i][2 * g + 1]);
    }
}
__device__ __forceinline__ void gemm_merge(const P& p, int M, int bid, int G) {
    const int tid = opaque_tid(), lane = tid & 63, wave = tid >> 6, wr = wave >> 2, wc = wave & 3, fr = lane & 15, fq = lane >> 4;
    const bf16_t* Gt = (const bf16_t*)(p.ws + OFF_G);
    bf16_t* O = (bf16_t*)(p.ws + OFF_MERGED);
    const int nM = M / 128, nN = 8;
    for (int u = bid; u < nM * nN; u += G) {
        const int pm = u % nM, pn = u / nM;
        const int rw = pm * 128 + wr * 64, cw = pn * 128 + wc * 32;
        f32x4 tot[4][2];
#pragma unroll
        for (int i = 0; i < 4; ++i) { tot[i][0] = (f32x4){0.f, 0.f, 0.f, 0.f}; tot[i][1] = (f32x4){0.f, 0.f, 0.f, 0.f}; }
#pragma unroll 1
        for (int s = 0; s < 3; ++s) {
            const bf16_t* A = (const bf16_t*)(p.ws + (s == 0 ? OFF_Q : (s == 1 ? OFF_A : OFF_RY)));
            const bf16_t* Bt = (const bf16_t*)(p.ws + OFF_WA + (s == 0 ? WA_AO : (s == 1 ? WA_PO : WA_RO)));
            f32x4 acc[4][2];
#pragma unroll
            for (int i = 0; i < 4; ++i) { acc[i][0] = (f32x4){0.f, 0.f, 0.f, 0.f}; acc[i][1] = (f32x4){0.f, 0.f, 0.f, 0.f}; }
            const bf16_t* ap = A + (size_t)(rw + fr) * 512 + 8 * fq;
            const bf16_t* bp0 = Bt + (size_t)(cw + perm32(fr)) * 512 + 8 * fq;
            const bf16_t* bp1 = Bt + (size_t)(cw + perm32(16 + fr)) * 512 + 8 * fq;
#pragma unroll 2
            for (int k = 0; k < 512; k += 32) {
                const bf16x8 b0 = *(const bf16x8*)(bp0 + k), b1 = *(const bf16x8*)(bp1 + k);
#pragma unroll
                for (int i = 0; i < 4; ++i) {
                    const bf16x8 af = *(const bf16x8*)(ap + (size_t)(16 * i) * 512 + k);
                    acc[i][0] = __builtin_amdgcn_mfma_f32_16x16x32_bf16(b0, af, acc[i][0], 0, 0, 0);
                    acc[i][1] = __builtin_amdgcn_mfma_f32_16x16x32_bf16(b1, af, acc[i][1], 0, 0, 0);
                }
            }
#pragma unroll
            for (int i = 0; i < 4; ++i) {
                f32x4 g0, g1; unpack8(*(const u32x4*)(Gt + (size_t)(rw + 16 * i + fr) * 3072 + s * 1024 + cw + 8 * fq), g0, g1);
                tot[i][0] += g0 * acc[i][0]; tot[i][1] += g1 * acc[i][1];
            }
        }
#pragma unroll
        for (int i = 0; i < 4; ++i) *(u32x4*)(O + (size_t)(rw + 16 * i + fr) * DM + cw + 8 * fq) = pack8(tot[i][0], tot[i][1]);
    }
}

__device__ __forceinline__ void attn_item(unsigned char* lds, bf16_t* Qb, const bf16_t* KVb, const float* sink, int qrow0, int kvh, int npos0, int b) {
    const int tid = opaque_tid(), lane = tid & 63, wave = tid >> 6, r32 = lane & 31, hi = lane >> 5;
    bf16_t* Ks = (bf16_t*)lds;
    bf16_t* Vt = (bf16_t*)(lds + 9216);
    const int hq = kvh * 4 + (wave >> 1);
    const int qoff = (wave & 1) * 32;
    bf16x8 qf[4];
#pragma unroll
    for (int ks = 0; ks < 4; ++ks) qf[ks] = *(const bf16x8*)(Qb + (size_t)(qrow0 + qoff + r32) * 512 + hq * 64 + 16 * ks + 8 * hi);
    f32x16 o[2];
#pragma unroll
    for (int dt = 0; dt < 2; ++dt)
#pragma unroll
        for (int r = 0; r < 16; ++r) o[dt][r] = 0.f;
    float m = sink[hq] * LOG2E, l = (hi == 0) ? 1.f : 0.f;
    const int ntl = (npos0 >= 0) ? 5 : 0;
    const int qp0 = npos0 + qoff;
#pragma unroll 1
    for (int ti = 0; ti < ntl + 4; ++ti) {
        int krow0, kp0 = 0; bool masked;
        if (ti < ntl) { kp0 = npos0 - 128 + 64 * ti; if (kp0 < 0 || kp0 >= SEQ) continue; krow0 = b * SEQ + kp0; masked = true; }
        else { krow0 = ML + b * CTX + 64 * (ti - ntl); masked = false; }
        __syncthreads();
        {
            const int key = tid >> 3, ch = tid & 7;
            const bf16_t* src = KVb + (size_t)(krow0 + key) * 256 + kvh * 64 + ch * 8;
            const u32x4 kv = *(const u32x4*)src; const u32x4 vv = *(const u32x4*)(src + 128);
            *(u32x4*)(Ks + key * 72 + ch * 8) = kv;
            const unsigned w[4] = {vv.x, vv.y, vv.z, vv.w};
#pragma unroll
            for (int e = 0; e < 8; ++e) Vt[(ch * 8 + e) * 72 + key] = (bf16_t)((w[e >> 1] >> (16 * (e & 1))) & 0xffffu);
        }
        __syncthreads();
        if (masked && (kp0 - (qp0 + 31) > 128 || qp0 - (kp0 + 63) > 128)) continue;
        f32x16 p0, p1;
#pragma unroll
        for (int r = 0; r < 16; ++r) { p0[r] = 0.f; p1[r] = 0.f; }
#pragma unroll
        for (int ks = 0; ks < 4; ++ks) {
            const bf16x8 k0 = *(const bf16x8*)(Ks + r32 * 72 + 16 * ks + 8 * hi);
            const bf16x8 k1 = *(const bf16x8*)(Ks + (32 + r32) * 72 + 16 * ks + 8 * hi);
            p0 = __builtin_amdgcn_mfma_f32_32x32x16_bf16(k0, qf[ks], p0, 0, 0, 0);
            p1 = __builtin_amdgcn_mfma_f32_32x32x16_bf16(k1, qf[ks], p1, 0, 0, 0);
        }
        if (masked) {
            const int qp = qp0 + r32;
#pragma unroll
            for (int r = 0; r < 16; ++r) {
                const int d0 = qp - (kp0 + crow(r, hi)), d1 = d0 - 32;
                if (d0 > 128 || d0 < -128) p0[r] = -1e30f;
                if (d1 > 128 || d1 < -128) p1[r] = -1e30f;
            }
        }
        float mx = fmaxf(p0[0], p1[0]);
#pragma unroll
        for (int r = 1; r < 16; ++r) mx = fmaxf(mx, fmaxf(p0[r], p1[r]));
        mx = fmaxf(mx, __shfl_xor(mx, 32));
        const float mn = fmaxf(m, mx);
        const float alpha = __builtin_amdgcn_exp2f(m - mn);
        m = mn;
        float rs = 0.f;
#pragma unroll
        for (int r = 0; r < 16; ++r) { p0[r] = __builtin_amdgcn_exp2f(p0[r] - mn); p1[r] = __builtin_amdgcn_exp2f(p1[r] - mn); rs += p0[r] + p1[r]; }
        l = l * alpha + rs;
#pragma unroll
        for (int dt = 0; dt < 2; ++dt)
#pragma unroll
            for (int r = 0; r < 16; ++r) o[dt][r] *= alpha;
#pragma unroll
        for (int s4 = 0; s4 < 4; ++s4) {
            u32x4 pw;
            if (s4 < 2) { const int o8 = 8 * s4; pw.x = pk2(p0[o8], p0[o8 + 1]); pw.y = pk2(p0[o8 + 2], p0[o8 + 3]); pw.z = pk2(p0[o8 + 4], p0[o8 + 5]); pw.w = pk2(p0[o8 + 6], p0[o8 + 7]); }
            else { const int o8 = 8 * (s4 - 2); pw.x = pk2(p1[o8], p1[o8 + 1]); pw.y = pk2(p1[o8 + 2], p1[o8 + 3]); pw.z = pk2(p1[o8 + 4], p1[o8 + 5]); pw.w = pk2(p1[o8 + 6], p1[o8 + 7]); }
            const bf16x8 pf = __builtin_bit_cast(bf16x8, pw);
            const int keybase = 32 * (s4 >> 1) + 16 * (s4 & 1) + 4 * hi;
#pragma unroll
            for (int dt = 0; dt < 2; ++dt) {
                const int d = 32 * dt + r32;
                const s16x4 lo = *(const s16x4*)(Vt + d * 72 + keybase);
                const s16x4 hh = *(const s16x4*)(Vt + d * 72 + keybase + 8);
                const bf16x8 vf = (bf16x8){lo[0], lo[1], lo[2], lo[3], hh[0], hh[1], hh[2], hh[3]};
                o[dt] = __builtin_amdgcn_mfma_f32_32x32x16_bf16(vf, pf, o[dt], 0, 0, 0);
            }
        }
    }
    {
        const float lt = l + __shfl_xor(l, 32);
        const float inv = 1.f / lt;
        bf16_t* orow = Qb + (size_t)(qrow0 + qoff + r32) * 512 + hq * 64;
#pragma unroll
        for (int dt = 0; dt < 2; ++dt)
#pragma unroll
            for (int rg = 0; rg < 4; ++rg) {
                u32x2 w; w.x = pk2(o[dt][4 * rg] * inv, o[dt][4 * rg + 1] * inv); w.y = pk2(o[dt][4 * rg + 2] * inv, o[dt][4 * rg + 3] * inv);
                *(u32x2*)(orow + 32 * dt + 8 * rg + 4 * hi) = w;
            }
    }
    __syncthreads();
}

__device__ __forceinline__ void pool_item(const P& p, int l, unsigned char* lds, int rb, int L, int t0, int g) {
    const int tid = opaque_tid(), lane = tid & 63, wave = tid >> 6, fr = lane & 15, fq = lane >> 4;
    bf16_t* U = (bf16_t*)lds;
    bf16_t* Dt = (bf16_t*)(lds + 20480);
    const bf16_t* PUb = (const bf16_t*)(p.ws + OFF_PU);
    bf16_t* PO = (bf16_t*)(p.ws + OFF_A);
    const bf16_t* PMt = (const bf16_t*)(p.ws + OFF_WA + WA_PM);
    for (int idx = tid; idx < 80 * 16; idx += NTHREADS) {
        const int rr = idx >> 4, ch = idx & 15, t = t0 - 7 + rr;
        u32x4 v = (u32x4){0u, 0u, 0u, 0u};
        if (t >= 0 && t < L) v = *(const u32x4*)(PUb + (size_t)(rb + t) * 512 + g * 128 + ch * 8);
        *(u32x4*)(U + rr * 128 + ch * 8) = v;
    }
    __syncthreads();
    const int w = 2 << g, offL = (w - 1) / 2, offR = w / 2;
    for (int idx = tid; idx < 64 * 128; idx += NTHREADS) {
        const int tt = idx >> 7, c = idx & 127, t = t0 + tt;
        const int lo = max(t - offL, 0), hi = min(t + offR + 1, L);
        float s = 0.f;
        for (int u = lo; u < hi; ++u) s += bf2f(U[(u - t0 + 7) * 128 + c]);
        const float d = s / (float)(hi - lo) - bf2f(U[(tt + 7) * 128 + c]);
        Dt[tt * 136 + c] = (bf16_t)f2bf(d);
    }
    __syncthreads();
    const int mt = wave & 3, nh = wave >> 2;
    f32x4 acc[4];
#pragma unroll
    for (int nt = 0; nt < 4; ++nt) acc[nt] = (f32x4){0.f, 0.f, 0.f, 0.f};
#pragma unroll
    for (int ks = 0; ks < 4; ++ks) {
        const bf16x8 af = *(const bf16x8*)(Dt + (16 * mt + fr) * 136 + 32 * ks + 8 * fq);
#pragma unroll
        for (int nt = 0; nt < 4; ++nt) {
            const bf16x8 bfr = *(const bf16x8*)(PMt + (size_t)(g * 128 + nh * 64 + 16 * nt + fr) * 128 + 32 * ks + 8 * fq);
            acc[nt] = __builtin_amdgcn_mfma_f32_16x16x32_bf16(bfr, af, acc[nt], 0, 0, 0);
        }
    }
#pragma unroll
    for (int nt = 0; nt < 4; ++nt) {
        const int col = g * 128 + nh * 64 + 16 * nt + 4 * fq;
        const f32x4 sc = *(const f32x4*)(p.in[I_PSCALE] + l * 512 + col);
        const f32x4 v = acc[nt] * sc;
        u32x2 wv; wv.x = pk2(v[0], v[1]); wv.y = pk2(v[2], v[3]);
        *(u32x2*)(PO + (size_t)(rb + t0 + 16 * mt + fr) * 512 + col) = wv;
    }
    __syncthreads();
}

__device__ __forceinline__ void rnn_item(const P& p, int l, unsigned char* lds, int b, int hb, bool need_ctx) {
    const int tid = opaque_tid(), half = tid >> 8, ht = tid & 255, lane = tid & 63, hw = (tid >> 6) & 3, fr = lane & 15, fq = lane >> 4;
    const int d = half;
    unsigned char* hl = lds + half * 58368;
    float* XL = (float*)hl;
    bf16_t* XA = (bf16_t*)(hl + 16384);
    float* CA = (float*)(hl + 25600);
    float* CB = (float*)(hl + 41984);
    const bf16_t* RXb = (const bf16_t*)(p.ws + OFF_RX);
    bf16_t* RYb = (bf16_t*)(p.ws + OFF_RY);
    bf16_t* Sb = (bf16_t*)(p.ws + OFF_A + 18 * MiB);
    const bf16_t* LA = (const bf16_t*)(p.ws + OFF_WA + WA_LA) + (size_t)(d * 8 + hb) * 4096;
    const bf16_t* LX = (const bf16_t*)(p.ws + OFF_WA + WA_LX) + (size_t)(d * 8 + hb) * 4096;
    float ba[4], bx[4], ls[4];
#pragma unroll
    for (int nt = 0; nt < 4; ++nt) {
        const int c = (l * 2 + d) * 512 + hb * 64 + 16 * nt + fr;
        ba[nt] = p.in[I_LBA][c]; bx[nt] = p.in[I_LBX][c];
        const float lam = p.in[I_LAM][c];
        ls[nt] = -8.f * log1pf(__expf(-lam));
    }
    const int cc = ht & 63, tq = ht >> 6;
    float cw[4];
#pragma unroll
    for (int k = 0; k < 4; ++k) cw[k] = p.in[I_CONVW][(l * 4 + k) * 512 + hb * 64 + cc];
    const float cbias = p.in[I_CONVB][l * 512 + hb * 64 + cc];
    float hstate = 0.f;
#pragma unroll 1
    for (int st = 0; st < 36; ++st) {
        const int cj = (d == 0) ? st : (st < 4 ? 3 - st : 39 - st);
        const bool isctx = cj < 4;
        const int segpos0 = isctx ? cj * 64 : cj * 64 - 256;
        const int L = isctx ? CTX : SEQ;
        const int rowbase = isctx ? (ML + b * CTX + segpos0) : (b * SEQ + segpos0);
        {
            const bf16_t* rxp = RXb + (size_t)rowbase * 512 + hb * 64 + cc;
            const int tb = tq * 16;
            float xm1, x0, xp1;
            { const int sp = segpos0 + tb - 1; xm1 = (sp >= 0 && sp < L) ? bf2f(rxp[(ptrdiff_t)(tb - 1) * 512]) : 0.f; }
            { const int sp = segpos0 + tb;     x0  = (sp >= 0 && sp < L) ? bf2f(rxp[(ptrdiff_t)(tb) * 512]) : 0.f; }
            { const int sp = segpos0 + tb + 1; xp1 = (sp >= 0 && sp < L) ? bf2f(rxp[(ptrdiff_t)(tb + 1) * 512]) : 0.f; }
#pragma unroll 4
            for (int i = 0; i < 16; ++i) {
                const int t = tb + i, sp = segpos0 + t + 2;
                const float xp2 = (sp >= 0 && sp < L) ? bf2f(rxp[(ptrdiff_t)(t + 2) * 512]) : 0.f;
                const float v = cbias + cw[0] * xm1 + cw[1] * x0 + cw[2] * xp1 + cw[3] * xp2;
                XL[t * 64 + cc] = v; XA[t * 72 + cc] = (bf16_t)f2bf(v);
                xm1 = x0; x0 = xp1; xp1 = xp2;
            }
        }
        __syncthreads();
        {
            f32x4 ga[4], gx[4];
#pragma unroll
            for (int nt = 0; nt < 4; ++nt) { ga[nt] = (f32x4){0.f, 0.f, 0.f, 0.f}; gx[nt] = (f32x4){0.f, 0.f, 0.f, 0.f}; }
#pragma unroll
            for (int ks = 0; ks < 2; ++ks) {
                const bf16x8 af = *(const bf16x8*)(XA + (16 * hw + fr) * 72 + 32 * ks + 8 * fq);
#pragma unroll
                for (int nt = 0; nt < 4; ++nt) {
                    const bf16x8 wa = *(const bf16x8*)(LA + (16 * nt + fr) * 64 + 32 * ks + 8 * fq);
                    const bf16x8 wx = *(const bf16x8*)(LX + (16 * nt + fr) * 64 + 32 * ks + 8 * fq);
                    ga[nt] = __builtin_amdgcn_mfma_f32_16x16x32_bf16(af, wa, ga[nt], 0, 0, 0);
                    gx[nt] = __builtin_amdgcn_mfma_f32_16x16x32_bf16(af, wx, gx[nt], 0, 0, 0);
                }
            }
#pragma unroll
            for (int nt = 0; nt < 4; ++nt)
#pragma unroll
                for (int rg = 0; rg < 4; ++rg) {
                    const int tk = 16 * hw + 4 * fq + rg, c = 16 * nt + fr;
                    const float r = sigm(ga[nt][rg] + ba[nt]);
                    const float ig = sigm(gx[nt][rg] + bx[nt]);
                    const float la = ls[nt] * r;
                    const float a = __expf(la);
                    const float mult = sqrtf(fmaxf(1.f - a * a, 0.f));
                    CA[tk * 64 + c] = a;
                    CB[tk * 64 + c] = mult * ig * XL[tk * 64 + c];
                }
        }
        __syncthreads();
        if (hw == 0) {
            if (d == 0) {
#pragma unroll 8
                for (int t = 0; t < 64; ++t) { hstate = CA[t * 64 + lane] * hstate + CB[t * 64 + lane]; CB[t * 64 + lane] = hstate; }
            } else {
#pragma unroll 8
                for (int t = 63; t >= 0; --t) { hstate = CA[t * 64 + lane] * hstate + CB[t * 64 + lane]; CB[t * 64 + lane] = hstate; }
            }
        }
        __syncthreads();
        if (!isctx || need_ctx) {
            const bool first = (d == 0) ? (isctx ? (cj < 2) : (cj <= 19)) : (isctx ? (cj >= 2) : (cj >= 20));
#pragma unroll
            for (int it = 0; it < 2; ++it) {
                const int idx = ht + 256 * it, t = idx >> 3, c8 = (idx & 7) * 8;
                const f32x4 h0 = *(const f32x4*)(CB + t * 64 + c8), h1 = *(const f32x4*)(CB + t * 64 + c8 + 4);
                const size_t off = (size_t)(rowbase + t) * 512 + hb * 64 + c8;
                if (first) *(u32x4*)(Sb + off) = pack8(h0, h1);
                else {
                    f32x4 s0, s1, y0, y1; unpack8(*(const u32x4*)(Sb + off), s0, s1); unpack8(*(const u32x4*)(RYb + off), y0, y1);
                    f32x4 o0, o1;
#pragma unroll
                    for (int j = 0; j < 4; ++j) { o0[j] = (h0[j] + s0[j]) * gelu_tanh(y0[j]); o1[j] = (h1[j] + s1[j]) * gelu_tanh(y1[j]); }
                    *(u32x4*)(RYb + off) = pack8(o0, o1);
                }
            }
        }
    }
    __syncthreads();
}

#define XB_TMO      128
#define XB_XCNT(j)  (256  + 64 * (j))
#define XB_XSUB(j)  (1280 + 64 * (j))
#define XB_XGEN(j)  (2304 + 64 * (j))
#define XB_TOP      3328
#define XB_TOPGEN   3392
#define XCD_BAR_WORDS 3456
#define XB_SPIN_CAP (1u << 18)

__device__ __forceinline__ unsigned xb_ld(unsigned* p)              { return __hip_atomic_load(p, __ATOMIC_RELAXED, __HIP_MEMORY_SCOPE_AGENT); }
__device__ __forceinline__ unsigned xb_add(unsigned* p, unsigned v) { return __hip_atomic_fetch_add(p, v, __ATOMIC_RELAXED, __HIP_MEMORY_SCOPE_AGENT); }
__device__ __forceinline__ unsigned xb_xcc_id() { return (unsigned)__builtin_amdgcn_s_getreg((3 << 11) | 20) & 0xFu; }
#define XB_SPIN(cond, bar) do { unsigned _sp = 0; while (cond) { __builtin_amdgcn_s_sleep(1); \
    if ((++_sp & 255u) == 0u) { if (xb_ld(&(bar)[XB_TMO])) break; if (_sp > XB_SPIN_CAP) { atomicAdd(&(bar)[XB_TMO], 1u); break; } } } } while (0)

struct XcdBarrier {
    unsigned* bar; unsigned x;
    volatile PG8_LAS unsigned* st;
};

__device__ __forceinline__ XcdBarrier xcd_barrier_post(unsigned* bar, volatile PG8_LAS unsigned* st) {
    XcdBarrier b; b.bar = bar; b.x = xb_xcc_id(); b.st = st;
    if (threadIdx.x == 0) (void)xb_add(&bar[XB_XCNT(b.x)], 1u);
    return b;
}
__device__ __forceinline__ void xcd_barrier_complete(unsigned* bar, unsigned x, unsigned& nloc, unsigned& nx) {
    const unsigned G = gridDim.x * gridDim.y * gridDim.z;
    unsigned sum, cnt, mine, sp = 0u;
    for (;;) {
        sum = 0u; cnt = 0u; mine = 0u;
#pragma unroll
        for (unsigned j = 0; j < 16; ++j) { const unsigned c = xb_ld(&bar[XB_XCNT(j)]); sum += c; cnt += (c > 0u) ? 1u : 0u; mine = (j == x) ? c : mine; }
        if (sum == G) break;
        __builtin_amdgcn_s_sleep(1);
        if ((++sp & 255u) == 0u) { if (xb_ld(&bar[XB_TMO])) break; if (sp > XB_SPIN_CAP) { atomicAdd(&bar[XB_TMO], 1u); break; } }
    }
    nloc = mine > 0u ? mine : 1u; nx = cnt > 0u ? cnt : 1u;
}

__device__ __forceinline__ void xcd_barrier(const XcdBarrier& b) {
    asm volatile("s_waitcnt vmcnt(0)" ::: "memory");
    __syncthreads();
    if (threadIdx.x == 0) {
        unsigned* bar = b.bar;
        __builtin_amdgcn_s_waitcnt(0);
        unsigned nloc = b.st[0], nx = b.st[1];
        if (nloc == 0u) { xcd_barrier_complete(bar, b.x, nloc, nx); b.st[0] = nloc; b.st[1] = nx; }
        const unsigned old = xb_add(&bar[XB_XSUB(b.x)], 1u);
        const unsigned gen = old / nloc;
        if (old + 1u == (gen + 1u) * nloc) {
            __builtin_amdgcn_fence(__ATOMIC_RELEASE, "agent");
            asm volatile("s_waitcnt vmcnt(0)" ::: "memory");
            const unsigned og = xb_add(&bar[XB_TOP], 1u);
            const unsigned tg = og / nx;
            if (og + 1u == (tg + 1u) * nx) xb_add(&bar[XB_TOPGEN], 1u);
            else XB_SPIN(xb_ld(&bar[XB_TOPGEN]) == tg, bar);
            __builtin_amdgcn_fence(__ATOMIC_ACQUIRE, "agent");
            xb_add(&bar[XB_XGEN(b.x)], 1u);
            asm volatile("s_waitcnt vmcnt(0)" ::: "memory");
        } else {
            XB_SPIN(xb_ld(&bar[XB_XGEN(b.x)]) == gen, bar);
            __builtin_amdgcn_fence(__ATOMIC_ACQUIRE, "agent");
            asm volatile("s_waitcnt vmcnt(0)" ::: "memory");
        }
    }
    __syncthreads();
}

__device__ __forceinline__ void run_phase(int ph, unsigned char* lds) {
#if defined(__HIP_DEVICE_COMPILE__)
    const __attribute__((address_space(4))) P* pp = (const __attribute__((address_space(4))) P*)__builtin_amdgcn_kernarg_segment_ptr();
    asm volatile("" : "+s"(pp));
    const P p = *pp;
#else
    const P p{};
#endif
    const int bid = blockIdx.x, G = gridDim.x;
    const int NGW = G * NWAVES;
    PG8_LAS unsigned char* ldsl = (PG8_LAS unsigned char*)lds;
    const float* mod = (const float*)(p.ws + OFF_MOD);
    bf16_t* Hb = (bf16_t*)(p.ws + OFF_A);
    float* XC = (float*)(p.ws + OFF_XC);
    if (ph == 0) {
        for (int it = bid; it < 192; it += G) mod_item(p, lds, it);
        if (bid == (192 % G)) table_item(p);
        __syncthreads();
        convert_WA(p, 0, lds, NGW);
        return;
    }
    if (ph == 1) {
        NormArgs a{}; a.xl = p.in[I_X]; a.xc = p.in[I_CTX]; a.y = nullptr; a.h = Hb; a.gpre = p.in[I_GPREMIX]; a.modh = mod; a.shift_idx = 0; a.nrows = MA;
        norm_rows(a, NGW);
        return;
    }
    const int l = (ph - 2) >> 3, sp = (ph - 2) & 7;
    const bool last = (l == 1);
    const int Mrows = last ? ML : MA;
    const float* modl = mod + (size_t)l * 9 * 6144;
    if (sp == 0 || sp == 3 || sp == 5 || sp == 6) {
        pg8::Gemm g; EpiW<EpiAll> E; UOrder S;
        E.f.ws = p.ws; E.f.ooff = 0;
        if (sp == 0) {
            g.A = Hb; g.Bt = (const bf16_t*)(p.ws + OFF_WA + WA_IN); g.M = MA; g.N = INW; g.K = DM; E.f.kind = 0;
            if (!last) S.init(MA, INW, G, bid, 0); else S.init(ML, INW, G, bid, 24);
        } else if (sp == 3) {
            g.A = (const bf16_t*)(p.ws + OFF_MERGED); g.Bt = (const bf16_t*)(p.ws + OFF_WA + WA_OUT); g.M = Mrows; g.N = DM; g.K = DM; E.f.kind = 1; E.f.ooff = OFF_G;
            S.init(Mrows, DM, G, bid, 0);
        } else if (sp == 5) {
            g.A = Hb; g.Bt = (const bf16_t*)(p.ws + OFF_WB + WB_GU); g.M = Mrows; g.N = NGU; g.K = DM; E.f.kind = 2;
            S.init(Mrows, NGU, G, bid, 0);
        } else {
            g.A = (const bf16_t*)(p.ws + OFF_G); g.Bt = (const bf16_t*)(p.ws + OFF_WB + WB_DOWN); g.M = Mrows; g.N = DM; g.K = DFF; E.f.kind = 1; E.f.ooff = OFF_F;
            S.init(Mrows, DM, G, bid, 0);
        }
        pg8::gemm_phase<EpiW<EpiAll>, UOrder, true, true>(ldsl, g, S, E);
        return;
    }
    if (sp == 1) {
        const bool need_ctx = !last;
        const bool split = (G >= 128);
        if (split && bid < 64) { rnn_item(p, l, lds, bid >> 3, bid & 7, need_ctx); return; }
        if (!split) for (int it = bid; it < 64; it += G) rnn_item(p, l, lds, it >> 3, it & 7, need_ctx);
        const int vb = split ? bid - 64 : bid, VG = split ? G - 64 : G;
        const int nAL = 512, nAC = need_ctx ? 64 : 0, nPL = 1024, nPC = need_ctx ? 128 : 0;
        bf16_t* Qb = (bf16_t*)(p.ws + OFF_Q); const bf16_t* KVb = (const bf16_t*)(p.ws + OFF_KV);
        const float* sink = p.in[I_SINK] + l * 8;
        for (int it = vb; it < nAL + nAC + nPL + nPC; it += VG) {
            int r = it;
            if (r < nAL + nAC) {
                int b, qrow0, npos0; const int kvh = r & 1;
                if (r < nAL) { b = r >> 6; const int qb = (r >> 1) & 31; qrow0 = b * SEQ + 64 * qb; npos0 = 64 * qb; }
                else { const int rc = r - nAL; b = rc >> 3; const int qb = (rc >> 1) & 3; qrow0 = ML + b * CTX + 64 * qb; npos0 = -1; }
                attn_item(lds, Qb, KVb, sink, qrow0, kvh, npos0, b);
                continue;
            }
            r -= nAL + nAC;
            int b, tile, rb, L; const int g = r & 3;
            if (r < nPL) { b = r >> 7; tile = (r >> 2) & 31; rb = b * SEQ; L = SEQ; }
            else { const int rc = r - nPL; b = rc >> 4; tile = (rc >> 2) & 3; rb = ML + b * CTX; L = CTX; }
            pool_item(p, l, lds, rb, L, tile * 64, g);
        }
        return;
    }
    if (sp == 2) { gemm_merge(p, Mrows, bid, G); return; }
    if (sp == 4) {
        NormArgs a{};
        a.xl = (l == 0) ? p.in[I_X] : p.out; a.xc = (l == 0) ? p.in[I_CTX] : XC; a.ol = p.out; a.oc = XC;
        a.y = (const bf16_t*)(p.ws + OFF_G); a.gpost = p.in[I_GPOSTMIX] + l * DM; a.modg = modl; a.gate_idx = 2;
        a.h = Hb; a.gpre = p.in[I_GPREFFN] + l * DM; a.modh = modl; a.shift_idx = 3; a.nrows = Mrows;
        norm_rows(a, NGW);
        convert_WB(p, l, lds, NGW);
        return;
    }
    {
        NormArgs a{};
        a.xl = p.out; a.xc = XC; a.ol = p.out; a.oc = XC;
        a.y = (const bf16_t*)(p.ws + OFF_F); a.gpost = p.in[I_GPOSTFFN] + l * DM; a.modg = modl; a.gate_idx = 5;
        if (!last) { a.h = Hb; a.gpre = p.in[I_GPREMIX] + (l + 1) * DM; a.modh = mod + (size_t)(l + 1) * 9 * 6144; a.shift_idx = 0; }
        a.nrows = Mrows;
        norm_rows(a, NGW);
        if (!last) convert_WA(p, l + 1, lds, NGW);
    }
}

#ifndef PROBE
#define PROBE 0
#endif
#ifndef PROBE_MASK_A
#define PROBE_MASK_A 0u
#endif
#ifndef PROBE_K
#define PROBE_K 2
#endif
#ifndef PROBE_MASK_B
#define PROBE_MASK_B 0u
#endif
constexpr int LDS_MISC = LDS_BYTES - 64;
constexpr size_t CTL_BAR = 262144;
__global__ void __launch_bounds__(NTHREADS) mega(P p) {
    extern __shared__ __attribute__((aligned(16))) unsigned char lds[];
    volatile PG8_LAS unsigned* misc = (volatile PG8_LAS unsigned*)((PG8_LAS unsigned char*)lds + LDS_MISC);
    if (threadIdx.x < 16) misc[threadIdx.x] = 0u;
    __syncthreads();
    XcdBarrier bar = xcd_barrier_post((unsigned*)(p.ws + OFF_CTL + CTL_BAR), misc);
#if PROBE
    unsigned long long* ts = (unsigned long long*)(p.ws + OFF_CTL + 65536);
    if (blockIdx.x == 0 && threadIdx.x == 0) ts[0] = __builtin_amdgcn_s_memrealtime();
#endif
    for (int ph = p.ph_lo; ph < p.ph_hi; ++ph) {
        run_phase(ph, lds);
#if PROBE
        if (ph == p.ph_lo) cg::this_grid().sync(); else xcd_barrier(bar);
        if (blockIdx.x == 0 && threadIdx.x == 0) ts[ph + 1] = __builtin_amdgcn_s_memrealtime();
#else
        if (ph + 1 < p.ph_hi) { if (ph == p.ph_lo) cg::this_grid().sync(); else xcd_barrier(bar); }
#endif
    }
#if PROBE
    if (blockIdx.x == 0 && threadIdx.x == 0) {
        unsigned long long extra = 0;
        for (int ph = 0; ph < NPHASES; ++ph) if ((PROBE_MASK_A >> ph) & 1u) extra += ts[ph + 1] - ts[ph];
        extra *= PROBE_K;
        const unsigned long long t0 = __builtin_amdgcn_s_memrealtime();
        while (__builtin_amdgcn_s_memrealtime() - t0 < extra) __builtin_amdgcn_s_sleep(8);
    }
#endif
}

extern "C" void kernel_launch(void* const* d_in, const int* in_sizes, int n_in, void* d_out, int out_size, void* d_ws, size_t ws_size, hipStream_t stream) {
    static int grid = 0;
    if (grid == 0) {
        if (n_in != 27 || ws_size < WS_NEED) { fprintf(stderr, "kernel_launch: unexpected n_in %d or ws_size %zu\n", n_in, ws_size); grid = -1; return; }
        int dev = 0, cus = 0, per_cu = 0;
        hipGetDevice(&dev);
        hipDeviceGetAttribute(&cus, hipDeviceAttributeMultiprocessorCount, dev);
        hipFuncSetAttribute((const void*)mega, hipFuncAttributeMaxDynamicSharedMemorySize, LDS_BYTES);
        hipOccupancyMaxActiveBlocksPerMultiprocessor(&per_cu, (const void*)mega, NTHREADS, LDS_BYTES);
        if (per_cu < 1) { fprintf(stderr, "kernel_launch: occupancy query says %d blocks per CU\n", per_cu); per_cu = 1; }
        grid = cus;
    }
    if (grid < 0) return;
    hipMemsetAsync((char*)d_ws + OFF_CTL, 0, 1 * MiB, stream);
    P p{};
    for (int i = 0; i < 27; ++i) p.in[i] = (const float*)d_in[i];
    p.out = (float*)d_out; p.ws = (unsigned char*)d_ws;
#if PER_PHASE_LAUNCH
    for (int ph = 0; ph < NPHASES; ++ph) {
        p.ph_lo = ph; p.ph_hi = ph + 1;
        hipLaunchKernelGGL(mega, dim3(grid), dim3(NTHREADS), LDS_BYTES, stream, p);
    }
#else
    p.ph_lo = 0; p.ph_hi = NPHASES;
    void* args[] = {&p};
    hipError_t e = hipLaunchCooperativeKernel((const void*)mega, dim3(grid), dim3(NTHREADS), args, LDS_BYTES, stream);
    if (e != hipSuccess) fprintf(stderr, "cooperative launch failed: %s (grid %d)\n", hipGetErrorString(e), grid);
#endif
}
```

```cpp
#include <hip/hip_runtime.h>
#include <hip/hip_cooperative_groups.h>
#include <cstdio>
#include <cstdint>
namespace cg = cooperative_groups;

#ifndef PER_PHASE_LAUNCH
#define PER_PHASE_LAUNCH 0
#endif

typedef unsigned short bf16_t;
typedef short bf16x8 __attribute__((ext_vector_type(8)));
typedef short s16x4 __attribute__((ext_vector_type(4)));
typedef float f32x4 __attribute__((ext_vector_type(4)));
typedef float f32x16 __attribute__((ext_vector_type(16)));
typedef unsigned u32x4 __attribute__((ext_vector_type(4)));
typedef unsigned u32x2 __attribute__((ext_vector_type(2)));

constexpr int DM = 1024, NBATCH = 8, SEQ = 2048, CTX = 256;
constexpr int ML = NBATCH * SEQ;
constexpr int MC = NBATCH * CTX;
constexpr int MA = ML + MC;
constexpr int INW = 5376, DFF = 2816, NGU = 5632;
constexpr float EPS = 1e-6f;
constexpr float LOG2E = 1.4426950408889634f;
constexpr float QSCALE = 0.125f * LOG2E;
constexpr int NTHREADS = 512, NWAVES = 8;
constexpr int LDS_BYTES = 147456;
constexpr int NPHASES = 20;

constexpr size_t MiB = 1u << 20;
constexpr size_t OFF_CTL = 0;
constexpr size_t OFF_TAB = 1 * MiB;
constexpr size_t OFF_MOD = 1 * MiB + 65536;
constexpr size_t OFF_WA = 2 * MiB;
constexpr size_t WA_IN = 0, WA_AO = 11010048, WA_PO = WA_AO + 1048576, WA_RO = WA_PO + 1048576, WA_OUT = WA_RO + 1048576,
                 WA_PM = WA_OUT + 2097152, WA_LA = WA_PM + 131072, WA_LX = WA_LA + 131072;
constexpr size_t OFF_A = 18 * MiB;
constexpr size_t OFF_Q = 54 * MiB;
constexpr size_t OFF_KV = 72 * MiB;
constexpr size_t OFF_RX = 81 * MiB;
constexpr size_t OFF_PU = 99 * MiB;
constexpr size_t OFF_RY = 117 * MiB;
constexpr size_t OFF_MERGED = OFF_RX;
constexpr size_t OFF_F = OFF_Q;
constexpr size_t OFF_WB = 94 * MiB;
constexpr size_t WB_GU = 0, WB_DOWN = 11534336;
constexpr size_t OFF_G = 135 * MiB;
constexpr size_t OFF_XC = 243 * MiB;
constexpr size_t WS_NEED = 254 * MiB;

struct P {
    const float* in[27];
    float* out;
    unsigned char* ws;
    int ph_lo, ph_hi;
};
enum { I_X = 0, I_C, I_CTX, I_CCTX, I_WADA, I_BADA, I_GPREMIX, I_GPOSTMIX, I_GPREFFN, I_GPOSTFFN, I_WIN, I_SINK, I_WAO, I_PMIX, I_PSCALE, I_WPO,
       I_CONVW, I_CONVB, I_LWA, I_LBA, I_LWX, I_LBX, I_LAM, I_WRO, I_WOUT, I_WGU, I_WDOWN };

__device__ __forceinline__ float bf2f(unsigned v) { return __uint_as_float(v << 16); }
__device__ __forceinline__ unsigned f2bf(float f) { unsigned u = __float_as_uint(f); return (u + 0x7fffu + ((u >> 16) & 1u)) >> 16; }
__device__ __forceinline__ unsigned pk2(float lo, float hi) { return f2bf(lo) | (f2bf(hi) << 16); }
__device__ __forceinline__ float wave_sum(float v) {
#pragma unroll
    for (int o = 1; o < 64; o <<= 1) v += __shfl_xor(v, o);
    return v;
}
__device__ __forceinline__ float sigm(float x) { return __builtin_amdgcn_rcpf(1.f + __builtin_amdgcn_exp2f(-LOG2E * x)); }
__device__ __forceinline__ float gelu_tanh(float y) {
    const float z = 0.7978845608028654f * (y + 0.044715f * y * y * y);
    const float t = 1.f - 2.f * __builtin_amdgcn_rcpf(1.f + __builtin_amdgcn_exp2f((2.f * LOG2E) * z));
    return 0.5f * y * (1.f + t);
}
__device__ __forceinline__ int crow(int r, int hi) { return (r & 3) + 8 * (r >> 2) + 4 * hi; }
__device__ __forceinline__ int perm32(int rho) { const int n = rho >> 4, i = rho & 15; return 8 * (i >> 2) + 4 * n + (i & 3); }
#define LDS_WAIT() asm volatile("s_waitcnt lgkmcnt(0)" ::: "memory")
__device__ __forceinline__ int opaque_tid() { int t = threadIdx.x; asm volatile("" : "+v"(t)); return t; }
__device__ __forceinline__ f32x4 unpack4(u32x2 w) { return (f32x4){bf2f(w.x & 0xffffu), bf2f(w.x >> 16), bf2f(w.y & 0xffffu), bf2f(w.y >> 16)}; }
__device__ __forceinline__ void unpack8(u32x4 w, f32x4& a, f32x4& b) {
    a = (f32x4){bf2f(w.x & 0xffffu), bf2f(w.x >> 16), bf2f(w.y & 0xffffu), bf2f(w.y >> 16)};
    b = (f32x4){bf2f(w.z & 0xffffu), bf2f(w.z >> 16), bf2f(w.w & 0xffffu), bf2f(w.w >> 16)};
}
__device__ __forceinline__ u32x4 pack8(f32x4 a, f32x4 b) { u32x4 w; w.x = pk2(a[0], a[1]); w.y = pk2(a[2], a[3]); w.z = pk2(b[0], b[1]); w.w = pk2(b[2], b[3]); return w; }

__constant__ float ROPE_INV[16] = {1.0f, 0.5623413251903491f, 0.31622776601683794f, 0.1778279410038923f, 0.1f, 0.05623413251903491f, 0.03162277660168379f,
                                   0.01778279410038923f, 0.01f, 0.005623413251903491f, 0.003162277660168379f, 0.001778279410038923f, 0.001f,
                                   0.0005623413251903491f, 0.0003162277660168379f, 0.0001778279410038923f};

__device__ __forceinline__ int src_col(int mode, int n) {
    if (mode == 1) {
        if (n >= 640) return n;
        const int p = n & 63, hb = n - p, G = p >> 3, j = p & 7, half = G >> 2, g = G & 3;
        const int dim = half * 32 + ((j < 4) ? (4 * g + j) : (16 + 4 * g + (j - 4)));
        return hb + dim;
    }
    if (mode == 2) {
        const int q = n >> 3, t = n & 7;
        return (t < 4) ? (4 * q + t) : (DFF + 4 * q + (t - 4));
    }
    return n;
}
__device__ __forceinline__ void tr_item(const float* W, int K, int N, int Nout, bf16_t* WT, float* scr, int item, int lane, int mode) {
    const int nblk = Nout / 32, kb = item / nblk, nb = item % nblk, k0 = 64 * kb, n0 = 32 * nb;
    const int sc = src_col(mode, n0 + (lane & 31));
#pragma unroll 8
    for (int i = 0; i < 32; ++i) { const int kk = 2 * i + (lane >> 5); scr[kk * 33 + (lane & 31)] = W[(size_t)(k0 + kk) * N + sc]; }
    LDS_WAIT(); asm volatile("" ::: "memory");
    const int c = lane & 7;
#pragma unroll
    for (int j = 0; j < 4; ++j) {
        const int n = (lane >> 3) + 8 * j; const float* s = scr + (8 * c) * 33 + n;
        u32x4 o; o.x = pk2(s[0 * 33], s[1 * 33]); o.y = pk2(s[2 * 33], s[3 * 33]); o.z = pk2(s[4 * 33], s[5 * 33]); o.w = pk2(s[6 * 33], s[7 * 33]);
        *(u32x4*)(WT + (size_t)(n0 + n) * K + k0 + 8 * c) = o;
    }
    LDS_WAIT(); asm volatile("" ::: "memory");
}
constexpr int WA_ITEMS = 2688 + 3 * 256 + 512 + 32 + 32 + 32;
constexpr int WB_ITEMS = 2816 + 1408;
__device__ __forceinline__ void convert_WA(const P& p, int l, unsigned char* lds, int NGW) {
    const int tid_ = opaque_tid(), lane = tid_ & 63, gw = blockIdx.x * NWAVES + (tid_ >> 6);
    float* scr = (float*)(lds + (tid_ >> 6) * 16384);
    unsigned char* wa = p.ws + OFF_WA;
    for (int it = gw; it < WA_ITEMS; it += NGW) {
        int r = it;
        if (r < 2688) { tr_item(p.in[I_WIN] + (size_t)l * DM * INW, DM, INW, INW, (bf16_t*)(wa + WA_IN), scr, r, lane, 1); continue; } r -= 2688;
        if (r < 256) { tr_item(p.in[I_WAO] + (size_t)l * 512 * DM, 512, DM, DM, (bf16_t*)(wa + WA_AO), scr, r, lane, 0); continue; } r -= 256;
        if (r < 256) { tr_item(p.in[I_WPO] + (size_t)l * 512 * DM, 512, DM, DM, (bf16_t*)(wa + WA_PO), scr, r, lane, 0); continue; } r -= 256;
        if (r < 256) { tr_item(p.in[I_WRO] + (size_t)l * 512 * DM, 512, DM, DM, (bf16_t*)(wa + WA_RO), scr, r, lane, 0); continue; } r -= 256;
        if (r < 512) { tr_item(p.in[I_WOUT] + (size_t)l * DM * DM, DM, DM, DM, (bf16_t*)(wa + WA_OUT), scr, r, lane, 0); continue; } r -= 512;
        if (r < 32) { const int g = r >> 3; tr_item(p.in[I_PMIX] + (size_t)(l * 4 + g) * 16384, 128, 128, 128, (bf16_t*)(wa + WA_PM) + g * 16384, scr, r & 7, lane, 0); continue; } r -= 32;
        if (r < 32) { const int m = r >> 1; tr_item(p.in[I_LWA] + (size_t)(l * 16 + m) * 4096, 64, 64, 64, (bf16_t*)(wa + WA_LA) + m * 4096, scr, r & 1, lane, 0); continue; } r -= 32;
        { const int m = r >> 1; tr_item(p.in[I_LWX] + (size_t)(l * 16 + m) * 4096, 64, 64, 64, (bf16_t*)(wa + WA_LX) + m * 4096, scr, r & 1, lane, 0); }
    }
}
__device__ __forceinline__ void convert_WB(const P& p, int l, unsigned char* lds, int NGW) {
    const int tid_ = opaque_tid(), lane = tid_ & 63, gw = blockIdx.x * NWAVES + (tid_ >> 6);
    float* scr = (float*)(lds + (tid_ >> 6) * 16384);
    unsigned char* wb = p.ws + OFF_WB;
    for (int it = gw; it < WB_ITEMS; it += NGW) {
        int r = it;
        if (r < 2816) { tr_item(p.in[I_WGU] + (size_t)l * DM * NGU, DM, NGU, NGU, (bf16_t*)(wb + WB_GU), scr, r, lane, 2); continue; } r -= 2816;
        tr_item(p.in[I_WDOWN] + (size_t)l * DFF * DM, DFF, DM, DM, (bf16_t*)(wb + WB_DOWN), scr, r, lane, 0);
    }
}

__device__ __forceinline__ void mod_item(const P& p, unsigned char* lds, int item) {
    const int tid = opaque_tid(), lane = tid & 63, wave = tid >> 6;
    const int l = item / 96, cgp = item % 96;
    float* sc = (float*)lds;
    float* red = (float*)(lds + 36864);
    for (int idx = tid; idx < 9 * 1024; idx += NTHREADS) {
        const int r = idx >> 10, k = idx & 1023;
        const float v = (r < 8) ? p.in[I_C][r * 1024 + k] : p.in[I_CCTX][k];
        sc[idx] = v / (1.f + __expf(-v));
    }
    __syncthreads();
    float acc[9];
#pragma unroll
    for (int r = 0; r < 9; ++r) acc[r] = 0.f;
    const float* wp = p.in[I_WADA] + (size_t)l * 1024 * 6144 + cgp * 64 + lane;
    const int kbeg = wave * 128;
#pragma unroll 4
    for (int k = kbeg; k < kbeg + 128; ++k) {
        const float w = wp[(size_t)k * 6144];
#pragma unroll
        for (int r = 0; r < 9; ++r) acc[r] += sc[r * 1024 + k] * w;
    }
#pragma unroll
    for (int r = 0; r < 9; ++r) red[(wave * 9 + r) * 64 + lane] = acc[r];
    __syncthreads();
    float* mod = (float*)(p.ws + OFF_MOD);
    for (int idx = tid; idx < 9 * 64; idx += NTHREADS) {
        const int r = idx >> 6, ln = idx & 63;
        float s = 0.f;
#pragma unroll
        for (int w = 0; w < 8; ++w) s += red[(w * 9 + r) * 64 + ln];
        const int j = cgp * 64 + ln;
        mod[(size_t)(l * 9 + r) * 6144 + j] = s + p.in[I_BADA][l * 6144 + j];
    }
    __syncthreads();
}
__device__ __forceinline__ void table_item(const P& p) {
    float* tc = (float*)(p.ws + OFF_TAB); float* ts = tc + 1024;
    for (int idx = opaque_tid(); idx < 1024; idx += NTHREADS) {
        const int pos = idx >> 4, i = idx & 15;
        const float ang = (float)pos * ROPE_INV[i];
        const double x = (double)ang;
        const double n = rint(x * 0.6366197723675814);
        const double r = x - n * 1.5707963267948966;
        const double r2 = r * r;
        const double sr = r * (1.0 - r2 / 6.0 * (1.0 - r2 / 20.0 * (1.0 - r2 / 42.0 * (1.0 - r2 / 72.0 * (1.0 - r2 / 110.0 * (1.0 - r2 / 156.0))))));
        const double cr = 1.0 - r2 / 2.0 * (1.0 - r2 / 12.0 * (1.0 - r2 / 30.0 * (1.0 - r2 / 56.0 * (1.0 - r2 / 90.0 * (1.0 - r2 / 132.0 * (1.0 - r2 / 182.0))))));
        const int q = ((int)n) & 3;
        double s, c;
        if (q == 0) { s = sr; c = cr; } else if (q == 1) { s = cr; c = -sr; } else if (q == 2) { s = -sr; c = -cr; } else { s = -cr; c = sr; }
        tc[idx] = (float)c; ts[idx] = (float)s;
    }
}

struct NormArgs {
    const float* xl; const float* xc;
    float* ol; float* oc;
    const bf16_t* y;
    const float* gpost; const float* modg; int gate_idx;
    bf16_t* h; const float* gpre; const float* modh; int shift_idx;
    int nrows;
};
__device__ __forceinline__ void norm_rows(const NormArgs& a, int NGW) {
    const int tid_ = opaque_tid(), lane = tid_ & 63, gw = blockIdx.x * NWAVES + (tid_ >> 6);
    for (int r = gw; r < a.nrows; r += NGW) {
        const bool isl = r < ML;
        const int mrow = isl ? (r >> 11) : 8;
        const float* xin = isl ? a.xl + (size_t)r * DM : a.xc + (size_t)(r - ML) * DM;
        f32x4 v[4];
#pragma unroll
        for (int j = 0; j < 4; ++j) v[j] = *(const f32x4*)(xin + 4 * lane + 256 * j);
        if (a.y) {
            f32x4 yv[4]; float ss = 0.f;
#pragma unroll
            for (int j = 0; j < 4; ++j) { yv[j] = unpack4(*(const u32x2*)(a.y + (size_t)r * DM + 4 * lane + 256 * j)); ss += (yv[j][0] * yv[j][0] + yv[j][1] * yv[j][1]) + (yv[j][2] * yv[j][2] + yv[j][3] * yv[j][3]); }
            const float rstd = rsqrtf(wave_sum(ss) * (1.f / DM) + EPS);
#pragma unroll
            for (int j = 0; j < 4; ++j) {
                const int col = 4 * lane + 256 * j;
                const f32x4 gt = *(const f32x4*)(a.modg + (size_t)mrow * 6144 + a.gate_idx * 1024 + col);
                const f32x4 gp = *(const f32x4*)(a.gpost + col);
                v[j] = v[j] + gt * ((yv[j] * rstd) * gp);
            }
            float* xo = isl ? (a.ol ? a.ol + (size_t)r * DM : nullptr) : (a.oc ? a.oc + (size_t)(r - ML) * DM : nullptr);
            if (xo) {
#pragma unroll
                for (int j = 0; j < 4; ++j) *(f32x4*)(xo + 4 * lane + 256 * j) = v[j];
            }
        }
        if (a.h) {
            float ss = 0.f;
#pragma unroll
            for (int j = 0; j < 4; ++j) ss += (v[j][0] * v[j][0] + v[j][1] * v[j][1]) + (v[j][2] * v[j][2] + v[j][3] * v[j][3]);
            const float rstd = rsqrtf(wave_sum(ss) * (1.f / DM) + EPS);
#pragma unroll
            for (int j = 0; j < 4; ++j) {
                const int col = 4 * lane + 256 * j;
                const f32x4 gp = *(const f32x4*)(a.gpre + col);
                const f32x4 sh = *(const f32x4*)(a.modh + (size_t)mrow * 6144 + a.shift_idx * 1024 + col);
                const f32x4 scl = *(const f32x4*)(a.modh + (size_t)mrow * 6144 + (a.shift_idx + 1) * 1024 + col);
                const f32x4 hv = ((v[j] * rstd) * gp) * (1.f + scl) + sh;
                u32x2 w; w.x = pk2(hv[0], hv[1]); w.y = pk2(hv[2], hv[3]);
                *(u32x2*)(a.h + (size_t)r * DM + col) = w;
            }
        }
    }
}

namespace pg8 {
#define PG8_LAS __attribute__((address_space(3)))
typedef unsigned short bf16_t;
typedef short bf16x8 __attribute__((ext_vector_type(8)));
typedef float f32x4 __attribute__((ext_vector_type(4)));
typedef unsigned u32x4 __attribute__((ext_vector_type(4)));
constexpr int BM = 256, BK = 64, HALF = 128, HTB = HALF * BK * 2  , STAGE_BYTES = 8 * HTB, NXCD = 8, WGM = 8;

__host__ __device__ __forceinline__ int lds_byte(int r, int c) { const int st = (r >> 4) * 2 + (c >> 5), rr = r & 15, cc = c & 31, ob = rr * 64 + cc * 2; return st * 1024 + (ob ^ (((ob >> 9) & 1) << 5)); }
__host__ __device__ __forceinline__ void stage_rc(int b, int& R, int& C) { const int st = b / 1024, sb = b % 1024, swz = sb ^ (((sb >> 9) & 1) << 5); R = (st >> 1) * 16 + swz / 64; C = (st & 1) * 32 + (swz % 64) / 2; }
__host__ __device__ __forceinline__ int perm32(int rho) { const int n = rho >> 4, i = rho & 15; return 8 * (i >> 2) + 4 * n + (i & 3); }

struct Unit { int pm, pn, s; };
struct Gemm { const bf16_t* A; const bf16_t* Bt; int M, N, K;
    __device__ __forceinline__ const char* a(int s_) const { return (const char*)A + (long long)s_ * ((long long)OFF_A - (long long)OFF_Q) + (long long)((s_ * (s_ - 1)) >> 1) * ((long long)OFF_RY + (long long)OFF_Q - 2 * (long long)OFF_A); }
    __device__ __forceinline__ const char* b(int s_) const { return (const char*)Bt + (long long)s_ * 1048576ll; } };

struct StaticOrder {
    int nM, nN, nwg, G, c;
    __host__ __device__ void init(int M, int N, int G_, int c_) { nM = M / BM; nN = N / BM; nwg = nM * nN; G = G_; c = c_; }
    __host__ __device__ bool next(int i, Unit& u) const {
        const long L = (long)i * G + c; if (L >= nwg) return false;
        int wgid = (int)L; { const int q = nwg / NXCD, r = nwg % NXCD, xcd = wgid % NXCD, off = wgid / NXCD; wgid = (xcd < r ? xcd * (q + 1) : r * (q + 1) + (xcd - r) * q) + off; }
        const int nig = WGM * nN, gid = wgid / nig, fm = gid * WGM, gsz = (nM - fm) < WGM ? (nM - fm) : WGM;
        u.pm = fm + ((wgid % nig) % gsz); u.pn = (wgid % nig) / gsz; u.s = 0; return true;
    }
    __device__ __forceinline__ void a_ready(const Unit&) const {}
    __device__ __forceinline__ void done(const Unit&) const {}
};


template <class Epi, class Sched, bool ALIGN_EPI = false, bool SP2 = false>
__device__ __forceinline__ void gemm_phase(PG8_LAS unsigned char* lds, const Gemm g, const Sched& S, const Epi& E) {
    const int tid = opaque_tid(), wid = __builtin_amdgcn_readfirstlane(tid >> 6), lane = tid & 63, wr = wid >> 2, wc = wid & 3, fr = lane & 15, fq = lane >> 4;
    const int K = g.K, nt = K / BK;
    unsigned voffA[2], voffB[2];
#pragma unroll
    for (int i = 0; i < 2; ++i) { int R, C; stage_rc(tid * 16 + i * 8192, R, C); const int Rb = Epi::PERM ? ((R & ~31) + perm32(R & 31)) : R;
        voffA[i] = (unsigned)(R * K + C) * 2u; voffB[i] = (unsigned)(Rb * K + C) * 2u; }
    const size_t kstep = (size_t)(BK * 2);
    const size_t hstep = (size_t)HALF * K * 2;
    const size_t tstep = 2 * hstep;
    const unsigned ldsw = (unsigned)wid * 1024u;
    const int aoff = lds_byte(wr * 64 + fr, fq * 8), boff = lds_byte(wc * 32 + fr, fq * 8);
#define PG8_SA(b, h) (((b) * 2 + (h)) * HTB)
#define PG8_SB(b, h) ((4 + (b) * 2 + (h)) * HTB)
#define PG8_STAGE(bufoff, gbase, voff) do { _Pragma("unroll") for (int _i = 0; _i < 2; ++_i) \
        __builtin_amdgcn_global_load_lds((const unsigned*)((const char*)(gbase) + (voff)[_i]), (PG8_LAS unsigned*)(lds + (bufoff) + ldsw + _i * 8192), 16, 0, 0); } while (0)
#define PG8_LDA(dst, b, h) do { _Pragma("unroll") for (int m = 0; m < 4; ++m) _Pragma("unroll") for (int k = 0; k < 2; ++k) dst[m][k] = *(const PG8_LAS bf16x8*)(lds + PG8_SA(b, h) + aoff + m * 2048 + k * 1024); } while (0)
#define PG8_LDB(dst, b, h) do { _Pragma("unroll") for (int n = 0; n < 2; ++n) _Pragma("unroll") for (int k = 0; k < 2; ++k) dst[n][k] = *(const PG8_LAS bf16x8*)(lds + PG8_SB(b, h) + boff + n * 2048 + k * 1024); } while (0)
#define PG8_MMA(ai, bj, At, Bt) do { __builtin_amdgcn_s_setprio(1); _Pragma("unroll") for (int m = 0; m < 4; ++m) _Pragma("unroll") for (int n = 0; n < 2; ++n) _Pragma("unroll") for (int k = 0; k < 2; ++k) \
        acc[ai][bj][m][n] = __builtin_amdgcn_mfma_f32_16x16x32_bf16(Bt[n][k], At[m][k], acc[ai][bj][m][n], 0, 0, 0); __builtin_amdgcn_s_setprio(0); } while (0)
#define PG8_WAIT_V(n) asm volatile("s_waitcnt vmcnt(" #n ")" ::: "memory")
#define PG8_WAIT_L(n) asm volatile("s_waitcnt lgkmcnt(" #n ")" ::: "memory")
#define PG8_BAR __builtin_amdgcn_s_barrier()
#define PG8_SCHED __builtin_amdgcn_sched_barrier(0)
    Unit cur, nxt; int ui = 0;
    if (!S.next(0, cur)) return;
    f32x4 acc[2][2][4][2];
#pragma unroll
    for (int a = 0; a < 2; ++a)
#pragma unroll
        for (int b = 0; b < 2; ++b)
#pragma unroll
            for (int m = 0; m < 4; ++m)
#pragma unroll
                for (int n = 0; n < 2; ++n) acc[a][b][m][n] = (f32x4){0.f, 0.f, 0.f, 0.f};
    bf16x8 At[4][2], B0[2][2], B1[2][2];
    const char* cA = g.a(cur.s) + (size_t)cur.pm * tstep; const char* cB = g.b(cur.s) + (size_t)cur.pn * tstep;
    S.a_ready(cur);
    if constexpr (SP2) {
        PG8_STAGE(PG8_SB(0, 0), cB, voffB); PG8_STAGE(PG8_SB(0, 1), cB + hstep, voffB); PG8_STAGE(PG8_SA(0, 0), cA, voffA); PG8_STAGE(PG8_SA(0, 1), cA + hstep, voffA);
        if (wr == 1) PG8_BAR;
        PG8_WAIT_V(2); PG8_BAR;
        PG8_STAGE(PG8_SB(1, 0), cB + kstep, voffB); PG8_STAGE(PG8_SA(1, 0), cA + kstep, voffA); PG8_STAGE(PG8_SB(1, 1), cB + hstep + kstep, voffB);
        PG8_WAIT_V(6); PG8_BAR;
    } else {
        PG8_STAGE(PG8_SB(0, 0), cB, voffB); PG8_STAGE(PG8_SA(0, 0), cA, voffA); PG8_STAGE(PG8_SB(0, 1), cB + hstep, voffB); PG8_STAGE(PG8_SA(0, 1), cA + hstep, voffA);
        if (wr == 1) PG8_BAR;
        PG8_WAIT_V(4); PG8_BAR;
        PG8_STAGE(PG8_SB(1, 0), cB + kstep, voffB); PG8_STAGE(PG8_SA(1, 0), cA + kstep, voffA); PG8_STAGE(PG8_SB(1, 1), cB + hstep + kstep, voffB);
        PG8_WAIT_V(6); PG8_BAR;
    }
    for (;;) {
        const bool has_next = S.next(ui + 1, nxt);
        const char* nA = has_next ? g.a(nxt.s) + (size_t)nxt.pm * tstep : cA; const char* nB = has_next ? g.b(nxt.s) + (size_t)nxt.pn * tstep : cB;
        for (int t = 0; t < nt; t += 2) {
            const bool last = (t == nt - 2);
            const char* a1 = cA + (size_t)(t + 1) * kstep;
            const char* a2 = last ? nA : cA + (size_t)(t + 2) * kstep; const char* b2 = last ? nB : cB + (size_t)(t + 2) * kstep;
            const char* a3 = a2 + kstep; const char* b3 = b2 + kstep;
            if (last && has_next) S.a_ready(nxt);
            if constexpr (SP2) {
            PG8_LDB(B0, 0, 0); PG8_LDB(B1, 0, 1); PG8_SCHED; PG8_LDA(At, 0, 0); PG8_STAGE(PG8_SA(1, 1), a1 + hstep, voffA);
            PG8_WAIT_V(8); PG8_WAIT_L(0); PG8_BAR; PG8_MMA(0, 0, At, B0); PG8_MMA(0, 1, At, B1); PG8_BAR; PG8_SCHED;
            PG8_LDA(At, 0, 1); PG8_STAGE(PG8_SB(0, 0), b2, voffB); PG8_STAGE(PG8_SB(0, 1), b2 + hstep, voffB); PG8_STAGE(PG8_SA(0, 0), a2, voffA);
            PG8_WAIT_V(8); PG8_WAIT_L(0); PG8_BAR; PG8_MMA(1, 0, At, B0); PG8_MMA(1, 1, At, B1); PG8_BAR; PG8_SCHED;
            PG8_LDB(B0, 1, 0); PG8_LDB(B1, 1, 1); PG8_SCHED; PG8_LDA(At, 1, 0); PG8_STAGE(PG8_SA(0, 1), a2 + hstep, voffA);
            PG8_WAIT_V(8); PG8_WAIT_L(0); PG8_BAR; PG8_MMA(0, 0, At, B0); PG8_MMA(0, 1, At, B1); PG8_BAR; PG8_SCHED;
            PG8_LDA(At, 1, 1); PG8_STAGE(PG8_SB(1, 0), b3, voffB); PG8_STAGE(PG8_SB(1, 1), b3 + hstep, voffB); PG8_STAGE(PG8_SA(1, 0), a3, voffA);
            PG8_WAIT_V(8); PG8_WAIT_L(0); PG8_BAR; PG8_MMA(1, 0, At, B0); PG8_MMA(1, 1, At, B1); PG8_BAR; PG8_SCHED;
            } else {
            PG8_LDB(B0, 0, 0); PG8_SCHED; PG8_LDA(At, 0, 0); PG8_STAGE(PG8_SA(1, 1), a1 + hstep, voffA);
            PG8_WAIT_L(8); PG8_BAR; PG8_WAIT_L(0); PG8_MMA(0, 0, At, B0); PG8_BAR; PG8_SCHED;
            PG8_LDB(B1, 0, 1); PG8_STAGE(PG8_SB(0, 0), b2, voffB);
            PG8_BAR; PG8_WAIT_L(0); PG8_MMA(0, 1, At, B1); PG8_BAR;
            PG8_LDA(At, 0, 1); PG8_STAGE(PG8_SA(0, 0), a2, voffA);
            PG8_BAR; PG8_WAIT_L(0); PG8_MMA(1, 0, At, B0); PG8_BAR; PG8_SCHED;
            PG8_STAGE(PG8_SB(0, 1), b2 + hstep, voffB);
            PG8_WAIT_V(6); PG8_BAR; PG8_MMA(1, 1, At, B1); PG8_BAR;
            PG8_LDB(B0, 1, 0); PG8_SCHED; PG8_LDA(At, 1, 0); PG8_STAGE(PG8_SA(0, 1), a2 + hstep, voffA);
            PG8_WAIT_L(8); PG8_BAR; PG8_WAIT_L(0); PG8_MMA(0, 0, At, B0); PG8_BAR; PG8_SCHED;
            PG8_LDB(B1, 1, 1); PG8_STAGE(PG8_SB(1, 0), b3, voffB);
            PG8_BAR; PG8_WAIT_L(0); PG8_MMA(0, 1, At, B1); PG8_BAR;
            PG8_LDA(At, 1, 1); PG8_STAGE(PG8_SA(1, 0), a3, voffA);
            PG8_BAR; PG8_WAIT_L(0); PG8_MMA(1, 0, At, B0); PG8_BAR; PG8_SCHED;
            PG8_STAGE(PG8_SB(1, 1), b3 + hstep, voffB);
            PG8_WAIT_V(6); PG8_BAR; PG8_MMA(1, 1, At, B1); PG8_BAR;
            }
        }
        if constexpr (ALIGN_EPI) { if (wr == 0) PG8_BAR; }
        if constexpr (!Epi::AFTER_DRAIN) { E(acc, cur, wr, wc, fr, fq); S.done(cur); }
        if (!has_next) break;
        if (S.last_sub(cur)) {
#pragma unroll
        for (int a = 0; a < 2; ++a)
#pragma unroll
            for (int b = 0; b < 2; ++b)
#pragma unroll
                for (int m = 0; m < 4; ++m)
#pragma unroll
                    for (int n = 0; n < 2; ++n) acc[a][b][m][n] = (f32x4){0.f, 0.f, 0.f, 0.f};
        }
        cur = nxt; cA = nA; cB = nB; ++ui;
        if constexpr (ALIGN_EPI) { if (wr == 1) PG8_BAR; }
    }
    PG8_WAIT_V(0);
    if constexpr (!ALIGN_EPI) { if (wr == 0) PG8_BAR; }
    PG8_BAR;
    if constexpr (Epi::AFTER_DRAIN) { E.fused(acc, cur, wr, wc, fr, fq, lds, wid, lane); S.done(cur); }
#undef PG8_SA
#undef PG8_SB
#undef PG8_STAGE
#undef PG8_LDA
#undef PG8_LDB
#undef PG8_MMA
#undef PG8_WAIT_V
#undef PG8_WAIT_L
#undef PG8_BAR
#undef PG8_SCHED
}
}

struct EpiIn {
    bf16_t *Q, *KV, *RX, *PU, *RY, *G; const float* tcos; const float* tsin;
    __device__ __forceinline__ void operator()(int row, int c8, f32x4 v0, f32x4 v1) const {
        if (c8 < 640) {
            if (row < ML) {
                const int s = row & 2047, pp = c8 & 63, Gq = pp >> 3;
                const int pos = (Gq & 4) ? (s & 63) : (s >> 6);
                const int i0 = (Gq & 3) * 4;
                const f32x4 cs = *(const f32x4*)(tcos + pos * 16 + i0), sn = *(const f32x4*)(tsin + pos * 16 + i0);
                const f32x4 a = v0 * cs - v1 * sn, b = v1 * cs + v0 * sn; v0 = a; v1 = b;
            }
            if (c8 < 512) { v0 = v0 * QSCALE; v1 = v1 * QSCALE; *(u32x4*)(Q + (size_t)row * 512 + c8) = pack8(v0, v1); }
            else *(u32x4*)(KV + (size_t)row * 256 + (c8 - 512)) = pack8(v0, v1);
        } else if (c8 < 768) *(u32x4*)(KV + (size_t)row * 256 + 128 + (c8 - 640)) = pack8(v0, v1);
        else if (c8 < 1280) *(u32x4*)(RX + (size_t)row * 512 + (c8 - 768)) = pack8(v0, v1);
        else if (c8 < 1792) *(u32x4*)(RY + (size_t)row * 512 + (c8 - 1280)) = pack8(v0, v1);
        else if (c8 < 2304) *(u32x4*)(PU + (size_t)row * 512 + (c8 - 1792)) = pack8(v0, v1);
        else {
#pragma unroll
            for (int j = 0; j < 4; ++j) { v0[j] = sigm(v0[j]); v1[j] = sigm(v1[j]); }
            *(u32x4*)(G + (size_t)row * 3072 + (c8 - 2304)) = pack8(v0, v1);
        }
    }
};
struct EpiStore {
    bf16_t* O; int ldc;
    __device__ __forceinline__ void operator()(int row, int c8, f32x4 v0, f32x4 v1) const { *(u32x4*)(O + (size_t)row * ldc + c8) = pack8(v0, v1); }
};
struct EpiSwiglu {
    bf16_t* O;
    __device__ __forceinline__ void operator()(int row, int c8, f32x4 v0, f32x4 v1) const {
        f32x4 o;
#pragma unroll
        for (int j = 0; j < 4; ++j) o[j] = v0[j] * sigm(v0[j]) * v1[j];
        u32x2 w; w.x = pk2(o[0], o[1]); w.y = pk2(o[2], o[3]);
        *(u32x2*)(O + (size_t)row * DFF + (c8 >> 1)) = w;
    }
};

template <class F> struct EpiW {
    static constexpr bool PERM = true, AFTER_DRAIN = false;
    F f;
    __device__ __forceinline__ void operator()(pg8::f32x4 (&acc)[2][2][4][2], const pg8::Unit& u, int wr, int wc, int fr, int fq) const {
        const int row0 = u.pm * 256 + wr * 64 + fr, col0 = u.pn * 256 + wc * 32 + 8 * fq;
#pragma unroll
        for (int ai = 0; ai < 2; ++ai)
#pragma unroll
            for (int m = 0; m < 4; ++m)
#pragma unroll
                for (int bj = 0; bj < 2; ++bj) f(row0 + ai * 128 + m * 16, col0 + bj * 128, acc[ai][bj][m][0], acc[ai][bj][m][1], u.s);
    }
};
struct EpiAll {
    int kind; unsigned char* ws; size_t ooff;
    __device__ __forceinline__ void operator()(int row, int c8, f32x4& v0, f32x4& v1, int sub) const {
        if (kind == 0) {
            EpiIn e{(bf16_t*)(ws + OFF_Q), (bf16_t*)(ws + OFF_KV), (bf16_t*)(ws + OFF_RX), (bf16_t*)(ws + OFF_PU), (bf16_t*)(ws + OFF_RY), (bf16_t*)(ws + OFF_G),
                    (const float*)(ws + OFF_TAB), (const float*)(ws + OFF_TAB) + 1024};
            e(row, c8, v0, v1);
        } else if (kind == 1) {
            *(u32x4*)((bf16_t*)(ws + ooff) + (size_t)row * DM + c8) = pack8(v0, v1);
        } else if (kind == 2) {
            EpiSwiglu e{(bf16_t*)(ws + OFF_G)};
            e(row, c8, v0, v1);
        } else {
            const bf16_t* gp = (const bf16_t*)(ws + OFF_G) + (size_t)row * 3072 + sub * 1024 + c8;
            f32x4 a0, a1; unpack8(*(const u32x4*)gp, a0, a1);
            if (sub < 2) {
                f32x4 b0, b1; unpack8(*(const u32x4*)(gp + 1024), b0, b1);
#pragma unroll
                for (int j = 0; j < 4; ++j) { v0[j] *= a0[j] * __builtin_amdgcn_rcpf(fmaxf(b0[j], 1e-30f)); v1[j] *= a1[j] * __builtin_amdgcn_rcpf(fmaxf(b1[j], 1e-30f)); }
            } else {
                *(u32x4*)((bf16_t*)(ws + OFF_MERGED) + (size_t)row * DM + c8) = pack8(v0 * a0, v1 * a1);
            }
        }
    }
};
struct UOrder {
    pg8::StaticOrder so; int extra, subs;
    __device__ void init(int M, int N, int G, int c, int extra_, int subs_) { so.init(M, N, G, c); extra = extra_; subs = subs_; }
    __device__ bool next(int i, pg8::Unit& u) const {
        int ti = i, sub = 0;
        if (subs == 3) { ti = i / 3; sub = i - 3 * ti; }
        const long L = (long)ti * so.G + so.c;
        if (L < so.nwg) { const bool ok = so.next(ti, u); u.s = sub; return ok; }
        const int r = (int)(L - so.nwg); if (r >= extra) return false;
        u.pm = 64 + (r & 7); u.pn = 2 + (r >> 3); u.s = 0; return true;
    }
    __device__ __forceinline__ bool last_sub(const pg8::Unit& u) const { return u.s + 1 == subs; }
    __device__ __forceinline__ void a_ready(const pg8::Unit&) const {}
    __device__ __forceinline__ void done(const pg8::Unit&) const {}
};
__device__ __forceinline__ void gemm_wave_acc(const bf16_t* A, const bf16_t* Bt, int K, int rw, int cw, int fr, int fq, f32x4 (&acc)[4][4]) {
    const bf16_t* ap[4]; const bf16_t* bp[4];
#pragma unroll
    for (int i = 0; i < 4; ++i) ap[i] = A + (size_t)(rw + 16 * i + fr) * K + 8 * fq;
#pragma unroll
    for (int q = 0; q < 4; ++q) bp[q] = Bt + (size_t)(cw + 32 * (q >> 1) + perm32(16 * (q & 1) + fr)) * K + 8 * fq;
#pragma unroll 2
    for (int k = 0; k < K; k += 32) {
        bf16x8 af[4], bfr[4];
#pragma unroll
        for (int i = 0; i < 4; ++i) af[i] = *(const bf16x8*)(ap[i] + k);
#pragma unroll
        for (int q = 0; q < 4; ++q) bfr[q] = *(const bf16x8*)(bp[q] + k);
#pragma unroll
        for (int i = 0; i < 4; ++i)
#pragma unroll
            for (int q = 0; q < 4; ++q) acc[i][q] = __builtin_amdgcn_mfma_f32_16x16x32_bf16(bfr[q], af[i], acc[i][q], 0, 0, 0);
    }
}
template <class Epi>
__device__ __forceinline__ void gemm_simple(const bf16_t* A, const bf16_t* Bt, int K, int row_off, int M, int col_off, int N, const Epi& epi, int bid, int G) {
    const int tid = opaque_tid(), lane = tid & 63, wave = tid >> 6, wr = wave >> 2, wc = wave & 3, fr = lane & 15, fq = lane >> 4;
    const int nM = M / 128, nN = N / 256;
    for (int u = bid; u < nM * nN; u += G) {
        const int pm = u % nM, pn = u / nM;
        const int rw = row_off + pm * 128 + wr * 64, cw = col_off + pn * 256 + wc * 64;
        f32x4 acc[4][4];
#pragma unroll
        for (int i = 0; i < 4; ++i)
#pragma unroll
            for (int q = 0; q < 4; ++q) acc[i][q] = (f32x4){0.f, 0.f, 0.f, 0.f};
        gemm_wave_acc(A, Bt, K, rw, cw, fr, fq, acc);
#pragma unroll
        for (int i = 0; i < 4; ++i)
#pragma unroll
            for (int g = 0; g < 2; ++g) epi(rw + 16 * i + fr, cw + 32 * g + 8 * fq, acc[i][2 * g], acc[i][2 * g + 1]);
    }
}
__device__ __forceinline__ void gemm_merge(const P& p, int M, int bid, int G) {
    const int tid = opaque_tid(), lane = tid & 63, wave = tid >> 6, wr = wave >> 2, wc = wave & 3, fr = lane & 15, fq = lane >> 4;
    const bf16_t* Gt = (const bf16_t*)(p.ws + OFF_G);
    bf16_t* O = (bf16_t*)(p.ws + OFF_MERGED);
    const int nM = M / 128, nN = 8;
    for (int u = bid; u < nM * nN; u += G) {
        const int pm = u % nM, pn = u / nM;
        const int rw = pm * 128 + wr * 64, cw = pn * 128 + wc * 32;
        f32x4 tot[4][2];
#pragma unroll
        for (int i = 0; i < 4; ++i) { tot[i][0] = (f32x4){0.f, 0.f, 0.f, 0.f}; tot[i][1] = (f32x4){0.f, 0.f, 0.f, 0.f}; }
#pragma unroll 1
        for (int s = 0; s < 3; ++s) {
            const bf16_t* A = (const bf16_t*)(p.ws + (s == 0 ? OFF_Q : (s == 1 ? OFF_A : OFF_RY)));
            const bf16_t* Bt = (const bf16_t*)(p.ws + OFF_WA + (s == 0 ? WA_AO : (s == 1 ? WA_PO : WA_RO)));
            f32x4 acc[4][2];
#pragma unroll
            for (int i = 0; i < 4; ++i) { acc[i][0] = (f32x4){0.f, 0.f, 0.f, 0.f}; acc[i][1] = (f32x4){0.f, 0.f, 0.f, 0.f}; }
            const bf16_t* ap = A + (size_t)(rw + fr) * 512 + 8 * fq;
            const bf16_t* bp0 = Bt + (size_t)(cw + perm32(fr)) * 512 + 8 * fq;
            const bf16_t* bp1 = Bt + (size_t)(cw + perm32(16 + fr)) * 512 + 8 * fq;
#pragma unroll 2
            for (int k = 0; k < 512; k += 32) {
                const bf16x8 b0 = *(const bf16x8*)(bp0 + k), b1 = *(const bf16x8*)(bp1 + k);
#pragma unroll
                for (int i = 0; i < 4; ++i) {
                    const bf16x8 af = *(const bf16x8*)(ap + (size_t)(16 * i) * 512 + k);
                    acc[i][0] = __builtin_amdgcn_mfma_f32_16x16x32_bf16(b0, af, acc[i][0], 0, 0, 0);
                    acc[i][1] = __builtin_amdgcn_mfma_f32_16x16x32_bf16(b1, af, acc[i][1], 0, 0, 0);
                }
            }
#pragma unroll
            for (int i = 0; i < 4; ++i) {
                f32x4 g0, g1; unpack8(*(const u32x4*)(Gt + (size_t)(rw + 16 * i + fr) * 3072 + s * 1024 + cw + 8 * fq), g0, g1);
                tot[i][0] += g0 * acc[i][0]; tot[i][1] += g1 * acc[i][1];
            }
        }
#pragma unroll
        for (int i = 0; i < 4; ++i) *(u32x4*)(O + (size_t)(rw + 16 * i + fr) * DM + cw + 8 * fq) = pack8(tot[i][0], tot[i][1]);
    }
}

__device__ __forceinline__ void attn_item(unsigned char* lds, bf16_t* Qb, const bf16_t* KVb, const float* sink, int qrow0, int kvh, int npos0, int b) {
    const int tid = opaque_tid(), lane = tid & 63, wave = tid >> 6, r32 = lane & 31, hi = lane >> 5;
    bf16_t* Ks = (bf16_t*)lds;
    bf16_t* Vt = (bf16_t*)(lds + 9216);
    const int hq = kvh * 4 + (wave >> 1);
    const int qoff = (wave & 1) * 32;
    bf16x8 qf[4];
#pragma unroll
    for (int ks = 0; ks < 4; ++ks) qf[ks] = *(const bf16x8*)(Qb + (size_t)(qrow0 + qoff + r32) * 512 + hq * 64 + 16 * ks + 8 * hi);
    f32x16 o[2];
#pragma unroll
    for (int dt = 0; dt < 2; ++dt)
#pragma unroll
        for (int r = 0; r < 16; ++r) o[dt][r] = 0.f;
    float m = sink[hq] * LOG2E, l = (hi == 0) ? 1.f : 0.f;
    const int ntl = (npos0 >= 0) ? 5 : 0;
    const int qp0 = npos0 + qoff;
    const int skey = tid >> 3, sch = tid & 7;
    int ti = 0;
    while (ti < ntl) { const int k0 = npos0 - 128 + 64 * ti; if (k0 >= 0 && k0 < SEQ) break; ++ti; }
    u32x4 pkv, pvv;
    {
        const int krow = (ti < ntl) ? (b * SEQ + npos0 - 128 + 64 * ti) : (ML + b * CTX + 64 * (ti - ntl));
        const bf16_t* src = KVb + (size_t)(krow + skey) * 256 + kvh * 64 + sch * 8;
        pkv = *(const u32x4*)src; pvv = *(const u32x4*)(src + 128);
    }
#pragma unroll 1
    while (ti < ntl + 4) {
        const bool masked = ti < ntl;
        const int kp0 = masked ? (npos0 - 128 + 64 * ti) : 0;
        __syncthreads();
        {
            *(u32x4*)(Ks + skey * 72 + sch * 8) = pkv;
            const unsigned w[4] = {pvv.x, pvv.y, pvv.z, pvv.w};
#pragma unroll
            for (int e = 0; e < 8; ++e) Vt[(sch * 8 + e) * 72 + skey] = (bf16_t)((w[e >> 1] >> (16 * (e & 1))) & 0xffffu);
        }
        __syncthreads();
        int tn = ti + 1;
        while (tn < ntl) { const int k0 = npos0 - 128 + 64 * tn; if (k0 >= 0 && k0 < SEQ) break; ++tn; }
        if (tn < ntl + 4) {
            const int krow = (tn < ntl) ? (b * SEQ + npos0 - 128 + 64 * tn) : (ML + b * CTX + 64 * (tn - ntl));
            const bf16_t* src = KVb + (size_t)(krow + skey) * 256 + kvh * 64 + sch * 8;
            pkv = *(const u32x4*)src; pvv = *(const u32x4*)(src + 128);
        }
        const int tcur = ti; ti = tn; (void)tcur;
        if (masked && (kp0 - (qp0 + 31) > 128 || qp0 - (kp0 + 63) > 128)) continue;
        f32x16 p0, p1;
#pragma unroll
        for (int r = 0; r < 16; ++r) { p0[r] = 0.f; p1[r] = 0.f; }
#pragma unroll
        for (int ks = 0; ks < 4; ++ks) {
            const bf16x8 k0 = *(const bf16x8*)(Ks + r32 * 72 + 16 * ks + 8 * hi);
            const bf16x8 k1 = *(const bf16x8*)(Ks + (32 + r32) * 72 + 16 * ks + 8 * hi);
            p0 = __builtin_amdgcn_mfma_f32_32x32x16_bf16(k0, qf[ks], p0, 0, 0, 0);
            p1 = __builtin_amdgcn_mfma_f32_32x32x16_bf16(k1, qf[ks], p1, 0, 0, 0);
        }
        if (masked) {
            const int qp = qp0 + r32;
#pragma unroll
            for (int r = 0; r < 16; ++r) {
                const int d0 = qp - (kp0 + crow(r, hi)), d1 = d0 - 32;
                if (d0 > 128 || d0 < -128) p0[r] = -1e30f;
                if (d1 > 128 || d1 < -128) p1[r] = -1e30f;
            }
        }
        float mx = fmaxf(p0[0], p1[0]);
#pragma unroll
        for (int r = 1; r < 16; ++r) mx = fmaxf(mx, fmaxf(p0[r], p1[r]));
        mx = fmaxf(mx, __shfl_xor(mx, 32));
        const float mn = fmaxf(m, mx);
        const float alpha = __builtin_amdgcn_exp2f(m - mn);
        m = mn;
        float rs = 0.f;
#pragma unroll
        for (int r = 0; r < 16; ++r) { p0[r] = __builtin_amdgcn_exp2f(p0[r] - mn); p1[r] = __builtin_amdgcn_exp2f(p1[r] - mn); rs += p0[r] + p1[r]; }
        l = l * alpha + rs;
#pragma unroll
        for (int dt = 0; dt < 2; ++dt)
#pragma unroll
            for (int r = 0; r < 16; ++r) o[dt][r] *= alpha;
#pragma unroll
        for (int s4 = 0; s4 < 4; ++s4) {
            u32x4 pw;
            if (s4 < 2) { const int o8 = 8 * s4; pw.x = pk2(p0[o8], p0[o8 + 1]); pw.y = pk2(p0[o8 + 2], p0[o8 + 3]); pw.z = pk2(p0[o8 + 4], p0[o8 + 5]); pw.w = pk2(p0[o8 + 6], p0[o8 + 7]); }
            else { const int o8 = 8 * (s4 - 2); pw.x = pk2(p1[o8], p1[o8 + 1]); pw.y = pk2(p1[o8 + 2], p1[o8 + 3]); pw.z = pk2(p1[o8 + 4], p1[o8 + 5]); pw.w = pk2(p1[o8 + 6], p1[o8 + 7]); }
            const bf16x8 pf = __builtin_bit_cast(bf16x8, pw);
            const int keybase = 32 * (s4 >> 1) + 16 * (s4 & 1) + 4 * hi;
#pragma unroll
            for (int dt = 0; dt < 2; ++dt) {
                const int d = 32 * dt + r32;
                const s16x4 lo = *(const s16x4*)(Vt + d * 72 + keybase);
                const s16x4 hh = *(const s16x4*)(Vt + d * 72 + keybase + 8);
                const bf16x8 vf = (bf16x8){lo[0], lo[1], lo[2], lo[3], hh[0], hh[1], hh[2], hh[3]};
                o[dt] = __builtin_amdgcn_mfma_f32_32x32x16_bf16(vf, pf, o[dt], 0, 0, 0);
            }
        }
    }
    {
        const float lt = l + __shfl_xor(l, 32);
        const float inv = 1.f / lt;
        bf16_t* orow = Qb + (size_t)(qrow0 + qoff + r32) * 512 + hq * 64;
#pragma unroll
        for (int dt = 0; dt < 2; ++dt)
#pragma unroll
            for (int rg = 0; rg < 4; ++rg) {
                u32x2 w; w.x = pk2(o[dt][4 * rg] * inv, o[dt][4 * rg + 1] * inv); w.y = pk2(o[dt][4 * rg + 2] * inv, o[dt][4 * rg + 3] * inv);
                *(u32x2*)(orow + 32 * dt + 8 * rg + 4 * hi) = w;
            }
    }
    __syncthreads();
}

__device__ __forceinline__ void pool_item(const P& p, int l, unsigned char* lds, int rb, int L, int t0, int g) {
    const int tid = opaque_tid(), lane = tid & 63, wave = tid >> 6, fr = lane & 15, fq = lane >> 4;
    bf16_t* U = (bf16_t*)lds;
    bf16_t* Dt = (bf16_t*)(lds + 20480);
    const bf16_t* PUb = (const bf16_t*)(p.ws + OFF_PU);
    bf16_t* PO = (bf16_t*)(p.ws + OFF_A);
    const bf16_t* PMt = (const bf16_t*)(p.ws + OFF_WA + WA_PM);
    const int mt = wave & 3, nh = wave >> 2;
    bf16x8 wf[4][4];
#pragma unroll
    for (int nt = 0; nt < 4; ++nt)
#pragma unroll
        for (int ks = 0; ks < 4; ++ks) wf[nt][ks] = *(const bf16x8*)(PMt + (size_t)(g * 128 + nh * 64 + 16 * nt + fr) * 128 + 32 * ks + 8 * fq);
    for (int idx = tid; idx < 80 * 16; idx += NTHREADS) {
        const int rr = idx >> 4, ch = idx & 15, t = t0 - 7 + rr;
        u32x4 v = (u32x4){0u, 0u, 0u, 0u};
        if (t >= 0 && t < L) v = *(const u32x4*)(PUb + (size_t)(rb + t) * 512 + g * 128 + ch * 8);
        *(u32x4*)(U + rr * 128 + ch * 8) = v;
    }
    __syncthreads();
    const int w = 2 << g, offL = (w - 1) / 2, offR = w / 2;
    for (int idx = tid; idx < 64 * 128; idx += NTHREADS) {
        const int tt = idx >> 7, c = idx & 127, t = t0 + tt;
        const int lo = max(t - offL, 0), hi = min(t + offR + 1, L);
        float s = 0.f;
        for (int u = lo; u < hi; ++u) s += bf2f(U[(u - t0 + 7) * 128 + c]);
        const float d = s / (float)(hi - lo) - bf2f(U[(tt + 7) * 128 + c]);
        Dt[tt * 136 + c] = (bf16_t)f2bf(d);
    }
    __syncthreads();
    f32x4 acc[4];
#pragma unroll
    for (int nt = 0; nt < 4; ++nt) acc[nt] = (f32x4){0.f, 0.f, 0.f, 0.f};
#pragma unroll
    for (int ks = 0; ks < 4; ++ks) {
        const bf16x8 af = *(const bf16x8*)(Dt + (16 * mt + fr) * 136 + 32 * ks + 8 * fq);
#pragma unroll
        for (int nt = 0; nt < 4; ++nt) acc[nt] = __builtin_amdgcn_mfma_f32_16x16x32_bf16(wf[nt][ks], af, acc[nt], 0, 0, 0);
    }
#pragma unroll
    for (int nt = 0; nt < 4; ++nt) {
        const int col = g * 128 + nh * 64 + 16 * nt + 4 * fq;
        const f32x4 sc = *(const f32x4*)(p.in[I_PSCALE] + l * 512 + col);
        const f32x4 v = acc[nt] * sc;
        u32x2 wv; wv.x = pk2(v[0], v[1]); wv.y = pk2(v[2], v[3]);
        *(u32x2*)(PO + (size_t)(rb + t0 + 16 * mt + fr) * 512 + col) = wv;
    }
    __syncthreads();
}

constexpr size_t OFF_CT = 251 * MiB;
__device__ __forceinline__ void rnn_phase(const P& p, int l, unsigned char* lds, int pass, bool skip_ctx) {
    const int tid = opaque_tid(), half = tid >> 8, lane = tid & 63, hw = (tid >> 6) & 3, fr = lane & 15, fq = lane >> 4;
    const int d = half, bid = blockIdx.x, G = gridDim.x;
    float* XL = (float*)lds;
    bf16_t* XA = (bf16_t*)(lds + 16384);
    float2* TT = (float2*)(lds + 25600);
    float* HIN = (float*)(lds + 29696);
    float* HO = (float*)(lds + 31744);
    float2* CTL = (float2*)(lds + 64512);
    bf16_t* WL = (bf16_t*)(lds + 101376);
    const bf16_t* RXb = (const bf16_t*)(p.ws + OFF_RX);
    bf16_t* RYb = (bf16_t*)(p.ws + OFF_RY);
    float2* CT = (float2*)(p.ws + OFF_CT);
    const int cc = tid & 63, tb = (tid >> 6) * 8;
    const int ot = tid >> 3, oc8 = (tid & 7) * 8;
    constexpr int NIT = 2304;
#define RNN_VALID(it_) (!(skip_ctx && (((it_) >> 3) % 36) < 4))
    int it = bid; while (it < NIT && !RNN_VALID(it)) it += G;
    if (it >= NIT) return;
    int hb_c = -1;
    float gba[4], gbx[4], ls2[4], cw[4], cbias = 0.f;
    unsigned short xraw[11]; float2 ctv[9]; u32x4 yraw = (u32x4){0u, 0u, 0u, 0u};
#define RNN_DECODE(it_, b_, hb_, cj_, rowbase_, segpos0_, L_) const int b_ = (it_) / 288, hb_ = (it_) & 7, cj_ = ((it_) >> 3) % 36; \
        const int segpos0_ = (cj_ < 4) ? cj_ * 64 : cj_ * 64 - 256; const int L_ = (cj_ < 4) ? CTX : SEQ; const int rowbase_ = (cj_ < 4) ? (ML + b_ * CTX + segpos0_) : (b_ * SEQ + segpos0_)
#define RNN_ISSUE(it_) do { RNN_DECODE(it_, b_i, hb_i, cj_i, rowbase_i, segpos0_i, L_i); \
        const bf16_t* rxp_ = RXb + (size_t)rowbase_i * 512 + hb_i * 64 + cc; \
        _Pragma("unroll") for (int i = 0; i < 11; ++i) { const int sp = segpos0_i + tb - 1 + i; xraw[i] = (sp >= 0 && sp < L_i) ? rxp_[(ptrdiff_t)(tb - 1 + i) * 512] : (unsigned short)0; } \
        if (pass == 2) { const size_t cb_ = (size_t)((b_i * 8 + hb_i) * 2) * 36 * 64; _Pragma("unroll") for (int i = 0; i < 9; ++i) ctv[i] = CT[cb_ + tid + 512 * i]; } } while (0)
    RNN_ISSUE(it);
    if (pass == 2) { RNN_DECODE(it, b0_, hb0_, cj0_, rowbase0_, segpos00_, L0_); (void)segpos00_; (void)L0_; (void)cj0_; (void)b0_; yraw = *(const u32x4*)(RYb + (size_t)(rowbase0_ + ot) * 512 + hb0_ * 64 + oc8); }
#pragma unroll 1
    while (it < NIT) {
        RNN_DECODE(it, b, hb, cj, rowbase, segpos0, L); (void)segpos0; (void)L;
        if (hb != hb_c) {
            hb_c = hb;
            __syncthreads();
#pragma unroll
            for (int i = 0; i < 4; ++i) {
                const int pc = tid + 512 * i, dm = pc >> 9, row = (pc >> 3) & 63, ch = pc & 7;
                const bf16_t* src = (const bf16_t*)(p.ws + OFF_WA + ((dm & 1) ? WA_LX : WA_LA)) + (size_t)((dm >> 1) * 8 + hb) * 4096 + row * 64 + ch * 8;
                *(u32x4*)(WL + (dm * 64 + row) * 72 + ch * 8) = *(const u32x4*)src;
            }
#pragma unroll
            for (int nt = 0; nt < 4; ++nt) {
                const int cg_ = (l * 2 + d) * 512 + hb * 64 + 16 * nt + fr;
                gba[nt] = p.in[I_LBA][cg_]; gbx[nt] = p.in[I_LBX][cg_];
                ls2[nt] = (-8.f * LOG2E) * log1pf(__expf(-p.in[I_LAM][cg_]));
            }
#pragma unroll
            for (int k = 0; k < 4; ++k) cw[k] = p.in[I_CONVW][(l * 4 + k) * 512 + hb * 64 + cc];
            cbias = p.in[I_CONVB][l * 512 + hb * 64 + cc];
        }
        int nx = it + G; while (nx < NIT && !RNN_VALID(nx)) nx += G;
        {
            float xv[11];
#pragma unroll
            for (int i = 0; i < 11; ++i) xv[i] = bf2f(xraw[i]);
#pragma unroll
            for (int i = 0; i < 8; ++i) {
                const float v = cbias + cw[0] * xv[i] + cw[1] * xv[i + 1] + cw[2] * xv[i + 2] + cw[3] * xv[i + 3];
                XL[(tb + i) * 64 + cc] = v; XA[(tb + i) * 72 + cc] = (bf16_t)f2bf(v);
            }
        }
        if (pass == 2) {
#pragma unroll
            for (int i = 0; i < 9; ++i) CTL[tid + 512 * i] = ctv[i];
        }
        __syncthreads();
        u32x4 yraw_n = (u32x4){0u, 0u, 0u, 0u};
        if (nx < NIT) {
            RNN_ISSUE(nx);
            if (pass == 2) { RNN_DECODE(nx, bn_, hbn_, cjn_, rowbasen_, segpos0n_, Ln_); (void)segpos0n_; (void)Ln_; (void)cjn_; (void)bn_; yraw_n = *(const u32x4*)(RYb + (size_t)(rowbasen_ + ot) * 512 + hbn_ * 64 + oc8); }
        }
        float av[4][4], bv[4][4];
        {
            f32x4 ga[4], gx[4];
#pragma unroll
            for (int nt = 0; nt < 4; ++nt) { ga[nt] = (f32x4){0.f, 0.f, 0.f, 0.f}; gx[nt] = (f32x4){0.f, 0.f, 0.f, 0.f}; }
#pragma unroll
            for (int ks = 0; ks < 2; ++ks) {
                const bf16x8 af = *(const bf16x8*)(XA + (16 * hw + fr) * 72 + 32 * ks + 8 * fq);
#pragma unroll
                for (int nt = 0; nt < 4; ++nt) {
                    const bf16x8 wa = *(const bf16x8*)(WL + ((d * 2 + 0) * 64 + 16 * nt + fr) * 72 + 32 * ks + 8 * fq);
                    const bf16x8 wx = *(const bf16x8*)(WL + ((d * 2 + 1) * 64 + 16 * nt + fr) * 72 + 32 * ks + 8 * fq);
                    ga[nt] = __builtin_amdgcn_mfma_f32_16x16x32_bf16(af, wa, ga[nt], 0, 0, 0);
                    gx[nt] = __builtin_amdgcn_mfma_f32_16x16x32_bf16(af, wx, gx[nt], 0, 0, 0);
                }
            }
#pragma unroll
            for (int nt = 0; nt < 4; ++nt)
#pragma unroll
                for (int rg = 0; rg < 4; ++rg) {
                    const int tk = 16 * hw + 4 * fq + rg, c = 16 * nt + fr;
                    const float r = sigm(ga[nt][rg] + gba[nt]);
                    const float ig = sigm(gx[nt][rg] + gbx[nt]);
                    const float a = __builtin_amdgcn_exp2f(ls2[nt] * r);
                    av[nt][rg] = a;
                    bv[nt][rg] = __builtin_amdgcn_sqrtf(fmaxf(1.f - a * a, 0.f)) * ig * XL[tk * 64 + c];
                }
        }
        float exP[4], exQ[4];
#pragma unroll
        for (int nt = 0; nt < 4; ++nt) {
            float Pc = 1.f, Qc = 0.f;
#pragma unroll
            for (int i = 0; i < 4; ++i) {
                const int rg = (d == 0) ? i : 3 - i;
                Qc = av[nt][rg] * Qc + bv[nt][rg]; Pc = Pc * av[nt][rg];
                av[nt][rg] = Pc; bv[nt][rg] = Qc;
            }
            float eP = 1.f, eQ = 0.f, tP = 1.f, tQ = 0.f;
#pragma unroll
            for (int i = 0; i < 4; ++i) {
                const int k = (d == 0) ? i : 3 - i;
                const float kP = __shfl(Pc, fr + 16 * k), kQ = __shfl(Qc, fr + 16 * k);
                const bool before = (d == 0) ? (k < fq) : (k > fq);
                if (before) { eQ = kP * eQ + kQ; eP = eP * kP; }
                tQ = kP * tQ + kQ; tP = tP * kP;
            }
            exP[nt] = eP; exQ[nt] = eQ;
            if (fq == 0) TT[(half * 4 + hw) * 64 + 16 * nt + fr] = make_float2(tP, tQ);
        }
        __syncthreads();
        if (pass == 1) {
            if (tid < 128) {
                const int dd = tid >> 6, c = tid & 63;
                float tP = 1.f, tQ = 0.f;
#pragma unroll
                for (int i = 0; i < 4; ++i) { const int w = (dd == 0) ? i : 3 - i; const float2 t = TT[(dd * 4 + w) * 64 + c]; tQ = t.x * tQ + t.y; tP = tP * t.x; }
                CT[(size_t)((b * 8 + hb) * 2) * 36 * 64 + (size_t)(dd * 36 + cj) * 64 + c] = make_float2(tP, tQ);
            }
        } else {
            if (tid < 128) {
                const int dd = tid >> 6, c = tid & 63;
                const float2* ct = CTL + (dd * 36) * 64 + c;
                const int ordcj = (dd == 0) ? cj : (cj < 4 ? 3 - cj : 39 - cj);
                float h = 0.f;
#pragma unroll 12
                for (int j = 0; j < 36; ++j) {
                    const int k = (dd == 0) ? j : (j < 4 ? 3 - j : 39 - j);
                    const float2 t = ct[k * 64];
                    if (j < ordcj) h = t.x * h + t.y;
                }
#pragma unroll
                for (int i = 0; i < 4; ++i) { const int w = (dd == 0) ? i : 3 - i; HIN[(dd * 4 + w) * 64 + c] = h; const float2 t = TT[(dd * 4 + w) * 64 + c]; h = t.x * h + t.y; }
            }
            __syncthreads();
#pragma unroll
            for (int nt = 0; nt < 4; ++nt) {
                const int c = 16 * nt + fr;
                const float hin = exP[nt] * HIN[(half * 4 + hw) * 64 + c] + exQ[nt];
#pragma unroll
                for (int rg = 0; rg < 4; ++rg) HO[(half * 64 + 16 * hw + 4 * fq + rg) * 64 + c] = av[nt][rg] * hin + bv[nt][rg];
            }
            __syncthreads();
            {
                const f32x4 f0 = *(const f32x4*)(HO + ot * 64 + oc8), f1 = *(const f32x4*)(HO + ot * 64 + oc8 + 4);
                const f32x4 b0 = *(const f32x4*)(HO + (64 + ot) * 64 + oc8), b1 = *(const f32x4*)(HO + (64 + ot) * 64 + oc8 + 4);
                f32x4 y0, y1; unpack8(yraw, y0, y1);
                f32x4 o0, o1;
#pragma unroll
                for (int j = 0; j < 4; ++j) { o0[j] = (f0[j] + b0[j]) * gelu_tanh(y0[j]); o1[j] = (f1[j] + b1[j]) * gelu_tanh(y1[j]); }
                *(u32x4*)(RYb + (size_t)(rowbase + ot) * 512 + hb * 64 + oc8) = pack8(o0, o1);
            }
        }
        __syncthreads();
        yraw = yraw_n; it = nx;
    }
#undef RNN_VALID
#undef RNN_DECODE
#undef RNN_ISSUE
}

#define XB_TMO      128
#define XB_XCNT(j)  (256  + 64 * (j))
#define XB_XSUB(j)  (1280 + 64 * (j))
#define XB_XGEN(j)  (2304 + 64 * (j))
#define XB_TOP      3328
#define XB_TOPGEN   3392
#define XCD_BAR_WORDS 3456
#define XB_SPIN_CAP (1u << 18)

__device__ __forceinline__ unsigned xb_ld(unsigned* p)              { return __hip_atomic_load(p, __ATOMIC_RELAXED, __HIP_MEMORY_SCOPE_AGENT); }
__device__ __forceinline__ unsigned xb_add(unsigned* p, unsigned v) { return __hip_atomic_fetch_add(p, v, __ATOMIC_RELAXED, __HIP_MEMORY_SCOPE_AGENT); }
__device__ __forceinline__ unsigned xb_xcc_id() { return (unsigned)__builtin_amdgcn_s_getreg((3 << 11) | 20) & 0xFu; }
#define XB_SPIN(cond, bar) do { unsigned _sp = 0; while (cond) { __builtin_amdgcn_s_sleep(1); \
    if ((++_sp & 255u) == 0u) { if (xb_ld(&(bar)[XB_TMO])) break; if (_sp > XB_SPIN_CAP) { atomicAdd(&(bar)[XB_TMO], 1u); break; } } } } while (0)

struct XcdBarrier {
    unsigned* bar; unsigned x;
    volatile PG8_LAS unsigned* st;
};

__device__ __forceinline__ XcdBarrier xcd_barrier_post(unsigned* bar, volatile PG8_LAS unsigned* st) {
    XcdBarrier b; b.bar = bar; b.x = xb_xcc_id(); b.st = st;
    if (threadIdx.x == 0) (void)xb_add(&bar[XB_XCNT(b.x)], 1u);
    return b;
}
__device__ __forceinline__ void xcd_barrier_complete(unsigned* bar, unsigned x, unsigned& nloc, unsigned& nx) {
    const unsigned G = gridDim.x * gridDim.y * gridDim.z;
    unsigned sum, cnt, mine, sp = 0u;
    for (;;) {
        sum = 0u; cnt = 0u; mine = 0u;
#pragma unroll
        for (unsigned j = 0; j < 16; ++j) { const unsigned c = xb_ld(&bar[XB_XCNT(j)]); sum += c; cnt += (c > 0u) ? 1u : 0u; mine = (j == x) ? c : mine; }
        if (sum == G) break;
        __builtin_amdgcn_s_sleep(1);
        if ((++sp & 255u) == 0u) { if (xb_ld(&bar[XB_TMO])) break; if (sp > XB_SPIN_CAP) { atomicAdd(&bar[XB_TMO], 1u); break; } }
    }
    nloc = mine > 0u ? mine : 1u; nx = cnt > 0u ? cnt : 1u;
}

__device__ __forceinline__ void xcd_barrier(const XcdBarrier& b) {
    asm volatile("s_waitcnt vmcnt(0)" ::: "memory");
    __syncthreads();
    if (threadIdx.x == 0) {
        unsigned* bar = b.bar;
        __builtin_amdgcn_s_waitcnt(0);
        unsigned nloc = b.st[0], nx = b.st[1];
        if (nloc == 0u) { xcd_barrier_complete(bar, b.x, nloc, nx); b.st[0] = nloc; b.st[1] = nx; }
        const unsigned old = xb_add(&bar[XB_XSUB(b.x)], 1u);
        const unsigned gen = old / nloc;
        if (old + 1u == (gen + 1u) * nloc) {
            __builtin_amdgcn_fence(__ATOMIC_RELEASE, "agent");
            asm volatile("s_waitcnt vmcnt(0)" ::: "memory");
            const unsigned og = xb_add(&bar[XB_TOP], 1u);
            const unsigned tg = og / nx;
            if (og + 1u == (tg + 1u) * nx) xb_add(&bar[XB_TOPGEN], 1u);
            else XB_SPIN(xb_ld(&bar[XB_TOPGEN]) == tg, bar);
            __builtin_amdgcn_fence(__ATOMIC_ACQUIRE, "agent");
            xb_add(&bar[XB_XGEN(b.x)], 1u);
            asm volatile("s_waitcnt vmcnt(0)" ::: "memory");
        } else {
            XB_SPIN(xb_ld(&bar[XB_XGEN(b.x)]) == gen, bar);
            __builtin_amdgcn_fence(__ATOMIC_ACQUIRE, "agent");
            asm volatile("s_waitcnt vmcnt(0)" ::: "memory");
        }
    }
    __syncthreads();
}

__device__ __forceinline__ void run_phase(int ph, unsigned char* lds) {
#if defined(__HIP_DEVICE_COMPILE__)
    const __attribute__((address_space(4))) P* pp = (const __attribute__((address_space(4))) P*)__builtin_amdgcn_kernarg_segment_ptr();
    asm volatile("" : "+s"(pp));
    const P p = *pp;
#else
    const P p{};
#endif
    const int bid = blockIdx.x, G = gridDim.x;
    const int NGW = G * NWAVES;
    PG8_LAS unsigned char* ldsl = (PG8_LAS unsigned char*)lds;
    const float* mod = (const float*)(p.ws + OFF_MOD);
    bf16_t* Hb = (bf16_t*)(p.ws + OFF_A);
    float* XC = (float*)(p.ws + OFF_XC);
    if (ph == 0) {
        for (int it = bid; it < 192; it += G) mod_item(p, lds, it);
        if (bid == (192 % G)) table_item(p);
        __syncthreads();
        convert_WA(p, 0, lds, NGW);
        return;
    }
    if (ph == 1) {
        NormArgs a{}; a.xl = p.in[I_X]; a.xc = p.in[I_CTX]; a.y = nullptr; a.h = Hb; a.gpre = p.in[I_GPREMIX]; a.modh = mod; a.shift_idx = 0; a.nrows = MA;
        norm_rows(a, NGW);
        return;
    }
    const int l = (ph - 2) / 9; int sp = (ph - 2) % 9;
    const bool last = (l == 1);
    const int Mrows = last ? ML : MA;
    const float* modl = mod + (size_t)l * 9 * 6144;
    if (sp == 1) {
        const bool need_ctx = !last;
        const int nAL = 512, nAC = need_ctx ? 64 : 0, nPL = 1024, nPC = need_ctx ? 128 : 0;
        bf16_t* Qb = (bf16_t*)(p.ws + OFF_Q); const bf16_t* KVb = (const bf16_t*)(p.ws + OFF_KV);
        const float* sink = p.in[I_SINK] + l * 8;
        for (int r = bid; r < nAL + nAC; r += G) {
            int b, qrow0, npos0; const int kvh = r & 1;
            if (r < nAL) { b = r >> 6; const int qb = (r >> 1) & 31; qrow0 = b * SEQ + 64 * qb; npos0 = 64 * qb; }
            else { const int rc = r - nAL; b = rc >> 3; const int qb = (rc >> 1) & 3; qrow0 = ML + b * CTX + 64 * qb; npos0 = -1; }
            attn_item(lds, Qb, KVb, sink, qrow0, kvh, npos0, b);
        }
        rnn_phase(p, l, lds, 1, false);
        const int nA = nAL + nAC, first = (bid + G - (nA % G)) % G;
        for (int r = first; r < nPL + nPC; r += G) {
            int b, tile, rb, L; const int g = r & 3;
            if (r < nPL) { b = r >> 7; tile = (r >> 2) & 31; rb = b * SEQ; L = SEQ; }
            else { const int rc = r - nPL; b = rc >> 4; tile = (rc >> 2) & 3; rb = ML + b * CTX; L = CTX; }
            pool_item(p, l, lds, rb, L, tile * 64, g);
        }
        return;
    }
    if (sp == 2) { rnn_phase(p, l, lds, 2, last); return; }
    if (sp > 2) sp -= 1;
    if (sp == 0 || sp == 2 || sp == 3 || sp == 5 || sp == 6) {
        pg8::Gemm g; EpiW<EpiAll> E; UOrder S;
        E.f.ws = p.ws; E.f.ooff = 0;
        if (sp == 0) {
            g.A = Hb; g.Bt = (const bf16_t*)(p.ws + OFF_WA + WA_IN); g.M = MA; g.N = INW; g.K = DM; E.f.kind = 0;
            if (!last) S.init(MA, INW, G, bid, 0, 1); else S.init(ML, INW, G, bid, 24, 1);
        } else if (sp == 2) {
            g.A = (const bf16_t*)(p.ws + OFF_Q); g.Bt = (const bf16_t*)(p.ws + OFF_WA + WA_AO);
            g.M = Mrows; g.N = DM; g.K = 512; E.f.kind = 3;
            S.init(Mrows, DM, G, bid, 0, 3);
        } else if (sp == 3) {
            g.A = (const bf16_t*)(p.ws + OFF_MERGED); g.Bt = (const bf16_t*)(p.ws + OFF_WA + WA_OUT); g.M = Mrows; g.N = DM; g.K = DM; E.f.kind = 1; E.f.ooff = OFF_G;
            S.init(Mrows, DM, G, bid, 0, 1);
        } else if (sp == 5) {
            g.A = Hb; g.Bt = (const bf16_t*)(p.ws + OFF_WB + WB_GU); g.M = Mrows; g.N = NGU; g.K = DM; E.f.kind = 2;
            S.init(Mrows, NGU, G, bid, 0, 1);
        } else {
            g.A = (const bf16_t*)(p.ws + OFF_G); g.Bt = (const bf16_t*)(p.ws + OFF_WB + WB_DOWN); g.M = Mrows; g.N = DM; g.K = DFF; E.f.kind = 1; E.f.ooff = OFF_F;
            S.init(Mrows, DM, G, bid, 0, 1);
        }
        pg8::gemm_phase<EpiW<EpiAll>, UOrder, true, true>(ldsl, g, S, E);
        return;
    }
    if (sp == 4) {
        NormArgs a{};
        a.xl = (l == 0) ? p.in[I_X] : p.out; a.xc = (l == 0) ? p.in[I_CTX] : XC; a.ol = p.out; a.oc = XC;
        a.y = (const bf16_t*)(p.ws + OFF_G); a.gpost = p.in[I_GPOSTMIX] + l * DM; a.modg = modl; a.gate_idx = 2;
        a.h = Hb; a.gpre = p.in[I_GPREFFN] + l * DM; a.modh = modl; a.shift_idx = 3; a.nrows = Mrows;
        norm_rows(a, NGW);
        convert_WB(p, l, lds, NGW);
        return;
    }
    {
        NormArgs a{};
        a.xl = p.out; a.xc = XC; a.ol = p.out; a.oc = XC;
        a.y = (const bf16_t*)(p.ws + OFF_F); a.gpost = p.in[I_GPOSTFFN] + l * DM; a.modg = modl; a.gate_idx = 5;
        if (!last) { a.h = Hb; a.gpre = p.in[I_GPREMIX] + (l + 1) * DM; a.modh = mod + (size_t)(l + 1) * 9 * 6144; a.shift_idx = 0; }
        a.nrows = Mrows;
        norm_rows(a, NGW);
        if (!last) convert_WA(p, l + 1, lds, NGW);
    }
}

#ifndef PROBE
#define PROBE 0
#endif
#ifndef PROBE_MASK_A
#define PROBE_MASK_A 0u
#endif
#ifndef PROBE_K
#define PROBE_K 2
#endif
#ifndef PROBE_MASK_B
#define PROBE_MASK_B 0u
#endif
constexpr int LDS_MISC = LDS_BYTES - 64;
constexpr size_t CTL_BAR = 262144;
__global__ void __launch_bounds__(NTHREADS) mega(P p) {
    extern __shared__ __attribute__((aligned(16))) unsigned char lds[];
    volatile PG8_LAS unsigned* misc = (volatile PG8_LAS unsigned*)((PG8_LAS unsigned char*)lds + LDS_MISC);
    if (threadIdx.x < 16) misc[threadIdx.x] = 0u;
    __syncthreads();
    XcdBarrier bar = xcd_barrier_post((unsigned*)(p.ws + OFF_CTL + CTL_BAR), misc);
#if PROBE
    unsigned long long* ts = (unsigned long long*)(p.ws + OFF_CTL + 65536);
    if (blockIdx.x == 0 && threadIdx.x == 0) ts[0] = __builtin_amdgcn_s_memrealtime();
#endif
    for (int ph = p.ph_lo; ph < p.ph_hi; ++ph) {
        run_phase(ph, lds);
#if PROBE
        if (ph == p.ph_lo) cg::this_grid().sync(); else xcd_barrier(bar);
        if (blockIdx.x == 0 && threadIdx.x == 0) ts[ph + 1] = __builtin_amdgcn_s_memrealtime();
#else
        if (ph + 1 < p.ph_hi) { if (ph == p.ph_lo) cg::this_grid().sync(); else xcd_barrier(bar); }
#endif
    }
#if PROBE
    if (blockIdx.x == 0 && threadIdx.x == 0) {
        unsigned long long extra = 0;
        for (int ph = 0; ph < NPHASES; ++ph) if ((PROBE_MASK_A >> ph) & 1u) extra += ts[ph + 1] - ts[ph];
        extra *= PROBE_K;
        const unsigned long long t0 = __builtin_amdgcn_s_memrealtime();
        while (__builtin_amdgcn_s_memrealtime() - t0 < extra) __builtin_amdgcn_s_sleep(8);
    }
#endif
}

extern "C" void kernel_launch(void* const* d_in, const int* in_sizes, int n_in, void* d_out, int out_size, void* d_ws, size_t ws_size, hipStream_t stream) {
    static int grid = 0;
    if (grid == 0) {
        if (n_in != 27 || ws_size < WS_NEED) { fprintf(stderr, "kernel_launch: unexpected n_in %d or ws_size %zu\n", n_in, ws_size); grid = -1; return; }
        int dev = 0, cus = 0, per_cu = 0;
        hipGetDevice(&dev);
        hipDeviceGetAttribute(&cus, hipDeviceAttributeMultiprocessorCount, dev);
        hipFuncSetAttribute((const void*)mega, hipFuncAttributeMaxDynamicSharedMemorySize, LDS_BYTES);
        hipOccupancyMaxActiveBlocksPerMultiprocessor(&per_cu, (const void*)mega, NTHREADS, LDS_BYTES);
        if (per_cu < 1) { fprintf(stderr, "kernel_launch: occupancy query says %d blocks per CU\n", per_cu); per_cu = 1; }
        grid = cus;
    }
    if (grid < 0) return;
    hipMemsetAsync((char*)d_ws + OFF_CTL, 0, 1 * MiB, stream);
    P p{};
    for (int i = 0; i < 27; ++i) p.in[i] = (const float*)d_in[i];
    p.out = (float*)d_out; p.ws = (unsigned char*)d_ws;
#if PER_PHASE_LAUNCH
    for (int ph = 0; ph < NPHASES; ++ph) {
        p.ph_lo = ph; p.ph_hi = ph + 1;
        hipLaunchKernelGGL(mega, dim3(grid), dim3(NTHREADS), LDS_BYTES, stream, p);
    }
#else
    p.ph_lo = 0; p.ph_hi = NPHASES;
    void* args[] = {&p};
    hipError_t e = hipLaunchCooperativeKernel((const void*)mega, dim3(grid), dim3(NTHREADS), args, LDS_BYTES, stream);
    if (e != hipSuccess) fprintf(stderr, "cooperative launch failed: %s (grid %d)\n", hipGetErrorString(e), grid);
#endif
}
```

```cpp
#include <hip/hip_runtime.h>
#include <hip/hip_cooperative_groups.h>
#include <cstdio>
#include <cstdint>
namespace cg = cooperative_groups;

#ifndef PER_PHASE_LAUNCH
#define PER_PHASE_LAUNCH 0
#endif

typedef unsigned short bf16_t;
typedef short bf16x8 __attribute__((ext_vector_type(8)));
typedef short s16x4 __attribute__((ext_vector_type(4)));
typedef float f32x4 __attribute__((ext_vector_type(4)));
typedef float f32x16 __attribute__((ext_vector_type(16)));
typedef unsigned u32x4 __attribute__((ext_vector_type(4)));
typedef unsigned u32x2 __attribute__((ext_vector_type(2)));

constexpr int DM = 1024, NBATCH = 8, SEQ = 2048, CTX = 256;
constexpr int ML = NBATCH * SEQ;
constexpr int MC = NBATCH * CTX;
constexpr int MA = ML + MC;
constexpr int INW = 5376, DFF = 2816, NGU = 5632;
constexpr float EPS = 1e-6f;
constexpr float LOG2E = 1.4426950408889634f;
constexpr float QSCALE = 0.125f * LOG2E;
constexpr int NTHREADS = 512, NWAVES = 8;
constexpr int LDS_BYTES = 147456;
constexpr int NPHASES = 20;

constexpr size_t MiB = 1u << 20;
constexpr size_t OFF_CTL = 0;
constexpr size_t OFF_TAB = 1 * MiB;
constexpr size_t OFF_MOD = 1 * MiB + 65536;
constexpr size_t OFF_WA = 2 * MiB;
constexpr size_t WA_IN = 0, WA_AO = 11010048, WA_PO = WA_AO + 1048576, WA_RO = WA_PO + 1048576, WA_OUT = WA_RO + 1048576,
                 WA_PM = WA_OUT + 2097152, WA_LA = WA_PM + 131072, WA_LX = WA_LA + 131072;
constexpr size_t OFF_A = 18 * MiB;
constexpr size_t OFF_Q = 54 * MiB;
constexpr size_t OFF_KV = 72 * MiB;
constexpr size_t OFF_RX = 81 * MiB;
constexpr size_t OFF_PU = 99 * MiB;
constexpr size_t OFF_RY = 117 * MiB;
constexpr size_t OFF_MERGED = OFF_RX;
constexpr size_t OFF_F = OFF_Q;
constexpr size_t OFF_WB = 94 * MiB;
constexpr size_t WB_GU = 0, WB_DOWN = 11534336;
constexpr size_t OFF_G = 135 * MiB;
constexpr size_t OFF_XC = 243 * MiB;
constexpr size_t WS_NEED = 254 * MiB;

struct P {
    const float* in[27];
    float* out;
    unsigned char* ws;
    int ph_lo, ph_hi;
};
enum { I_X = 0, I_C, I_CTX, I_CCTX, I_WADA, I_BADA, I_GPREMIX, I_GPOSTMIX, I_GPREFFN, I_GPOSTFFN, I_WIN, I_SINK, I_WAO, I_PMIX, I_PSCALE, I_WPO,
       I_CONVW, I_CONVB, I_LWA, I_LBA, I_LWX, I_LBX, I_LAM, I_WRO, I_WOUT, I_WGU, I_WDOWN };

__device__ __forceinline__ float bf2f(unsigned v) { return __uint_as_float(v << 16); }
__device__ __forceinline__ unsigned f2bf(float f) { unsigned u = __float_as_uint(f); return (u + 0x7fffu + ((u >> 16) & 1u)) >> 16; }
typedef float f32x2_t __attribute__((ext_vector_type(2)));
typedef __bf16 bf16x2_t __attribute__((ext_vector_type(2)));
__device__ __forceinline__ unsigned pk2(float lo, float hi) { const f32x2_t v = {lo, hi}; const bf16x2_t b = __builtin_convertvector(v, bf16x2_t); return __builtin_bit_cast(unsigned, b); }
__device__ __forceinline__ float wave_sum(float v) {
#pragma unroll
    for (int o = 1; o < 64; o <<= 1) v += __shfl_xor(v, o);
    return v;
}
__device__ __forceinline__ float sigm(float x) { return __builtin_amdgcn_rcpf(1.f + __builtin_amdgcn_exp2f(-LOG2E * x)); }
__device__ __forceinline__ float gelu_tanh(float y) {
    const float z = 0.7978845608028654f * (y + 0.044715f * y * y * y);
    const float t = 1.f - 2.f * __builtin_amdgcn_rcpf(1.f + __builtin_amdgcn_exp2f((2.f * LOG2E) * z));
    return 0.5f * y * (1.f + t);
}
__device__ __forceinline__ int crow(int r, int hi) { return (r & 3) + 8 * (r >> 2) + 4 * hi; }
__device__ __forceinline__ int perm32(int rho) { const int n = rho >> 4, i = rho & 15; return 8 * (i >> 2) + 4 * n + (i & 3); }
#define LDS_WAIT() asm volatile("s_waitcnt lgkmcnt(0)" ::: "memory")
__device__ __forceinline__ int opaque_tid() { int t = threadIdx.x; asm volatile("" : "+v"(t)); return t; }
__device__ __forceinline__ f32x4 unpack4(u32x2 w) { return (f32x4){bf2f(w.x & 0xffffu), bf2f(w.x >> 16), bf2f(w.y & 0xffffu), bf2f(w.y >> 16)}; }
__device__ __forceinline__ void unpack8(u32x4 w, f32x4& a, f32x4& b) {
    a = (f32x4){bf2f(w.x & 0xffffu), bf2f(w.x >> 16), bf2f(w.y & 0xffffu), bf2f(w.y >> 16)};
    b = (f32x4){bf2f(w.z & 0xffffu), bf2f(w.z >> 16), bf2f(w.w & 0xffffu), bf2f(w.w >> 16)};
}
__device__ __forceinline__ u32x4 pack8(f32x4 a, f32x4 b) { u32x4 w; w.x = pk2(a[0], a[1]); w.y = pk2(a[2], a[3]); w.z = pk2(b[0], b[1]); w.w = pk2(b[2], b[3]); return w; }

__constant__ float ROPE_INV[16] = {1.0f, 0.5623413251903491f, 0.31622776601683794f, 0.1778279410038923f, 0.1f, 0.05623413251903491f, 0.03162277660168379f,
                                   0.01778279410038923f, 0.01f, 0.005623413251903491f, 0.003162277660168379f, 0.001778279410038923f, 0.001f,
                                   0.0005623413251903491f, 0.0003162277660168379f, 0.0001778279410038923f};

__device__ __forceinline__ int src_col(int mode, int n) {
    if (mode == 1) {
        if (n >= 640) return n;
        const int p = n & 63, hb = n - p, G = p >> 3, j = p & 7, half = G >> 2, g = G & 3;
        const int dim = half * 32 + ((j < 4) ? (4 * g + j) : (16 + 4 * g + (j - 4)));
        return hb + dim;
    }
    if (mode == 2) {
        const int q = n >> 3, t = n & 7;
        return (t < 4) ? (4 * q + t) : (DFF + 4 * q + (t - 4));
    }
    return n;
}
__device__ __forceinline__ void tr_item(const float* W, int K, int N, int Nout, bf16_t* WT, float* scr, int item, int lane, int mode) {
    const int nblk = Nout / 32, kb = item / nblk, nb = item % nblk, k0 = 64 * kb, n0 = 32 * nb;
    const int sc = src_col(mode, n0 + (lane & 31));
#pragma unroll 8
    for (int i = 0; i < 32; ++i) { const int kk = 2 * i + (lane >> 5); scr[kk * 33 + (lane & 31)] = W[(size_t)(k0 + kk) * N + sc]; }
    LDS_WAIT(); asm volatile("" ::: "memory");
    const int c = lane & 7;
#pragma unroll
    for (int j = 0; j < 4; ++j) {
        const int n = (lane >> 3) + 8 * j; const float* s = scr + (8 * c) * 33 + n;
        u32x4 o; o.x = pk2(s[0 * 33], s[1 * 33]); o.y = pk2(s[2 * 33], s[3 * 33]); o.z = pk2(s[4 * 33], s[5 * 33]); o.w = pk2(s[6 * 33], s[7 * 33]);
        *(u32x4*)(WT + (size_t)(n0 + n) * K + k0 + 8 * c) = o;
    }
    LDS_WAIT(); asm volatile("" ::: "memory");
}
constexpr int WA_ITEMS = 2688 + 3 * 256 + 512 + 32 + 32 + 32;
constexpr int WB_ITEMS = 2816 + 1408;
__device__ __forceinline__ void convert_WA(const P& p, int l, unsigned char* lds, int NGW) {
    const int tid_ = opaque_tid(), lane = tid_ & 63, gw = blockIdx.x * NWAVES + (tid_ >> 6);
    float* scr = (float*)(lds + (tid_ >> 6) * 16384);
    unsigned char* wa = p.ws + OFF_WA;
    for (int it = gw; it < WA_ITEMS; it += NGW) {
        int r = it;
        if (r < 2688) { tr_item(p.in[I_WIN] + (size_t)l * DM * INW, DM, INW, INW, (bf16_t*)(wa + WA_IN), scr, r, lane, 1); continue; } r -= 2688;
        if (r < 256) { tr_item(p.in[I_WAO] + (size_t)l * 512 * DM, 512, DM, DM, (bf16_t*)(wa + WA_AO), scr, r, lane, 0); continue; } r -= 256;
        if (r < 256) { tr_item(p.in[I_WPO] + (size_t)l * 512 * DM, 512, DM, DM, (bf16_t*)(wa + WA_PO), scr, r, lane, 0); continue; } r -= 256;
        if (r < 256) { tr_item(p.in[I_WRO] + (size_t)l * 512 * DM, 512, DM, DM, (bf16_t*)(wa + WA_RO), scr, r, lane, 0); continue; } r -= 256;
        if (r < 512) { tr_item(p.in[I_WOUT] + (size_t)l * DM * DM, DM, DM, DM, (bf16_t*)(wa + WA_OUT), scr, r, lane, 0); continue; } r -= 512;
        if (r < 32) { const int g = r >> 3; tr_item(p.in[I_PMIX] + (size_t)(l * 4 + g) * 16384, 128, 128, 128, (bf16_t*)(wa + WA_PM) + g * 16384, scr, r & 7, lane, 0); continue; } r -= 32;
        if (r < 32) { const int m = r >> 1; tr_item(p.in[I_LWA] + (size_t)(l * 16 + m) * 4096, 64, 64, 64, (bf16_t*)(wa + WA_LA) + m * 4096, scr, r & 1, lane, 0); continue; } r -= 32;
        { const int m = r >> 1; tr_item(p.in[I_LWX] + (size_t)(l * 16 + m) * 4096, 64, 64, 64, (bf16_t*)(wa + WA_LX) + m * 4096, scr, r & 1, lane, 0); }
    }
}
__device__ __forceinline__ void convert_WB(const P& p, int l, unsigned char* lds, int NGW) {
    const int tid_ = opaque_tid(), lane = tid_ & 63, gw = blockIdx.x * NWAVES + (tid_ >> 6);
    float* scr = (float*)(lds + (tid_ >> 6) * 16384);
    unsigned char* wb = p.ws + OFF_WB;
    for (int it = gw; it < WB_ITEMS; it += NGW) {
        int r = it;
        if (r < 2816) { tr_item(p.in[I_WGU] + (size_t)l * DM * NGU, DM, NGU, NGU, (bf16_t*)(wb + WB_GU), scr, r, lane, 2); continue; } r -= 2816;
        tr_item(p.in[I_WDOWN] + (size_t)l * DFF * DM, DFF, DM, DM, (bf16_t*)(wb + WB_DOWN), scr, r, lane, 0);
    }
}

__device__ __forceinline__ void mod_item(const P& p, unsigned char* lds, int item) {
    const int tid = opaque_tid(), lane = tid & 63, wave = tid >> 6;
    const int l = item / 96, cgp = item % 96;
    float* sc = (float*)lds;
    float* red = (float*)(lds + 36864);
    for (int idx = tid; idx < 9 * 1024; idx += NTHREADS) {
        const int r = idx >> 10, k = idx & 1023;
        const float v = (r < 8) ? p.in[I_C][r * 1024 + k] : p.in[I_CCTX][k];
        sc[idx] = v / (1.f + __expf(-v));
    }
    __syncthreads();
    float acc[9];
#pragma unroll
    for (int r = 0; r < 9; ++r) acc[r] = 0.f;
    const float* wp = p.in[I_WADA] + (size_t)l * 1024 * 6144 + cgp * 64 + lane;
    const int kbeg = wave * 128;
#pragma unroll 4
    for (int k = kbeg; k < kbeg + 128; ++k) {
        const float w = wp[(size_t)k * 6144];
#pragma unroll
        for (int r = 0; r < 9; ++r) acc[r] += sc[r * 1024 + k] * w;
    }
#pragma unroll
    for (int r = 0; r < 9; ++r) red[(wave * 9 + r) * 64 + lane] = acc[r];
    __syncthreads();
    float* mod = (float*)(p.ws + OFF_MOD);
    for (int idx = tid; idx < 9 * 64; idx += NTHREADS) {
        const int r = idx >> 6, ln = idx & 63;
        float s = 0.f;
#pragma unroll
        for (int w = 0; w < 8; ++w) s += red[(w * 9 + r) * 64 + ln];
        const int j = cgp * 64 + ln;
        mod[(size_t)(l * 9 + r) * 6144 + j] = s + p.in[I_BADA][l * 6144 + j];
    }
    __syncthreads();
}
__device__ __forceinline__ void table_item(const P& p) {
    float* tc = (float*)(p.ws + OFF_TAB); float* ts = tc + 1024;
    for (int idx = opaque_tid(); idx < 1024; idx += NTHREADS) {
        const int pos = idx >> 4, i = idx & 15;
        const float ang = (float)pos * ROPE_INV[i];
        const double x = (double)ang;
        const double n = rint(x * 0.6366197723675814);
        const double r = x - n * 1.5707963267948966;
        const double r2 = r * r;
        const double sr = r * (1.0 - r2 / 6.0 * (1.0 - r2 / 20.0 * (1.0 - r2 / 42.0 * (1.0 - r2 / 72.0 * (1.0 - r2 / 110.0 * (1.0 - r2 / 156.0))))));
        const double cr = 1.0 - r2 / 2.0 * (1.0 - r2 / 12.0 * (1.0 - r2 / 30.0 * (1.0 - r2 / 56.0 * (1.0 - r2 / 90.0 * (1.0 - r2 / 132.0 * (1.0 - r2 / 182.0))))));
        const int q = ((int)n) & 3;
        double s, c;
        if (q == 0) { s = sr; c = cr; } else if (q == 1) { s = cr; c = -sr; } else if (q == 2) { s = -sr; c = -cr; } else { s = -cr; c = sr; }
        tc[idx] = (float)c; ts[idx] = (float)s;
    }
}

struct NormArgs {
    const float* xl; const float* xc;
    float* ol; float* oc;
    const bf16_t* y;
    const float* gpost; const float* modg; int gate_idx;
    bf16_t* h; const float* gpre; const float* modh; int shift_idx;
    int nrows;
};
__device__ __forceinline__ void norm_rows(const NormArgs& a, int NGW) {
    const int tid_ = opaque_tid(), lane = tid_ & 63, gw = blockIdx.x * NWAVES + (tid_ >> 6);
    for (int r = gw; r < a.nrows; r += NGW) {
        const bool isl = r < ML;
        const int mrow = isl ? (r >> 11) : 8;
        const float* xin = isl ? a.xl + (size_t)r * DM : a.xc + (size_t)(r - ML) * DM;
        f32x4 v[4];
#pragma unroll
        for (int j = 0; j < 4; ++j) v[j] = *(const f32x4*)(xin + 4 * lane + 256 * j);
        if (a.y) {
            f32x4 yv[4]; float ss = 0.f;
#pragma unroll
            for (int j = 0; j < 4; ++j) { yv[j] = unpack4(*(const u32x2*)(a.y + (size_t)r * DM + 4 * lane + 256 * j)); ss += (yv[j][0] * yv[j][0] + yv[j][1] * yv[j][1]) + (yv[j][2] * yv[j][2] + yv[j][3] * yv[j][3]); }
            const float rstd = rsqrtf(wave_sum(ss) * (1.f / DM) + EPS);
#pragma unroll
            for (int j = 0; j < 4; ++j) {
                const int col = 4 * lane + 256 * j;
                const f32x4 gt = *(const f32x4*)(a.modg + (size_t)mrow * 6144 + a.gate_idx * 1024 + col);
                const f32x4 gp = *(const f32x4*)(a.gpost + col);
                v[j] = v[j] + gt * ((yv[j] * rstd) * gp);
            }
            float* xo = isl ? (a.ol ? a.ol + (size_t)r * DM : nullptr) : (a.oc ? a.oc + (size_t)(r - ML) * DM : nullptr);
            if (xo) {
#pragma unroll
                for (int j = 0; j < 4; ++j) *(f32x4*)(xo + 4 * lane + 256 * j) = v[j];
            }
        }
        if (a.h) {
            float ss = 0.f;
#pragma unroll
            for (int j = 0; j < 4; ++j) ss += (v[j][0] * v[j][0] + v[j][1] * v[j][1]) + (v[j][2] * v[j][2] + v[j][3] * v[j][3]);
            const float rstd = rsqrtf(wave_sum(ss) * (1.f / DM) + EPS);
#pragma unroll
            for (int j = 0; j < 4; ++j) {
                const int col = 4 * lane + 256 * j;
                const f32x4 gp = *(const f32x4*)(a.gpre + col);
                const f32x4 sh = *(const f32x4*)(a.modh + (size_t)mrow * 6144 + a.shift_idx * 1024 + col);
                const f32x4 scl = *(const f32x4*)(a.modh + (size_t)mrow * 6144 + (a.shift_idx + 1) * 1024 + col);
                const f32x4 hv = ((v[j] * rstd) * gp) * (1.f + scl) + sh;
                u32x2 w; w.x = pk2(hv[0], hv[1]); w.y = pk2(hv[2], hv[3]);
                *(u32x2*)(a.h + (size_t)r * DM + col) = w;
            }
        }
    }
}

namespace pg8 {
#define PG8_LAS __attribute__((address_space(3)))
typedef unsigned short bf16_t;
typedef short bf16x8 __attribute__((ext_vector_type(8)));
typedef float f32x4 __attribute__((ext_vector_type(4)));
typedef unsigned u32x4 __attribute__((ext_vector_type(4)));
constexpr int BM = 256, BK = 64, HALF = 128, HTB = HALF * BK * 2  , STAGE_BYTES = 8 * HTB, NXCD = 8, WGM = 8;

__host__ __device__ __forceinline__ int lds_byte(int r, int c) { const int st = (r >> 4) * 2 + (c >> 5), rr = r & 15, cc = c & 31, ob = rr * 64 + cc * 2; return st * 1024 + (ob ^ (((ob >> 9) & 1) << 5)); }
__host__ __device__ __forceinline__ void stage_rc(int b, int& R, int& C) { const int st = b / 1024, sb = b % 1024, swz = sb ^ (((sb >> 9) & 1) << 5); R = (st >> 1) * 16 + swz / 64; C = (st & 1) * 32 + (swz % 64) / 2; }
__host__ __device__ __forceinline__ int perm32(int rho) { const int n = rho >> 4, i = rho & 15; return 8 * (i >> 2) + 4 * n + (i & 3); }

struct Unit { int pm, pn, s; };
struct Gemm { const bf16_t* A; const bf16_t* Bt; int M, N, K;
    __device__ __forceinline__ const char* a(int s_) const { return (const char*)A + (long long)s_ * ((long long)OFF_A - (long long)OFF_Q) + (long long)((s_ * (s_ - 1)) >> 1) * ((long long)OFF_RY + (long long)OFF_Q - 2 * (long long)OFF_A); }
    __device__ __forceinline__ const char* b(int s_) const { return (const char*)Bt + (long long)s_ * 1048576ll; } };

struct StaticOrder {
    int nM, nN, nwg, G, c;
    __host__ __device__ void init(int M, int N, int G_, int c_) { nM = M / BM; nN = N / BM; nwg = nM * nN; G = G_; c = c_; }
    __host__ __device__ bool next(int i, Unit& u) const {
        const long L = (long)i * G + c; if (L >= nwg) return false;
        int wgid = (int)L; { const int q = nwg / NXCD, r = nwg % NXCD, xcd = wgid % NXCD, off = wgid / NXCD; wgid = (xcd < r ? xcd * (q + 1) : r * (q + 1) + (xcd - r) * q) + off; }
        const int nig = WGM * nN, gid = wgid / nig, fm = gid * WGM, gsz = (nM - fm) < WGM ? (nM - fm) : WGM;
        u.pm = fm + ((wgid % nig) % gsz); u.pn = (wgid % nig) / gsz; u.s = 0; return true;
    }
    __device__ __forceinline__ void a_ready(const Unit&) const {}
    __device__ __forceinline__ void done(const Unit&) const {}
};


template <class Epi, class Sched, bool ALIGN_EPI = false, bool SP2 = false>
__device__ __forceinline__ void gemm_phase(PG8_LAS unsigned char* lds, const Gemm g, const Sched& S, const Epi& E) {
    const int tid = opaque_tid(), wid = __builtin_amdgcn_readfirstlane(tid >> 6), lane = tid & 63, wr = wid >> 2, wc = wid & 3, fr = lane & 15, fq = lane >> 4;
    const int K = g.K, nt = K / BK;
    unsigned voffA[2], voffB[2];
#pragma unroll
    for (int i = 0; i < 2; ++i) { int R, C; stage_rc(tid * 16 + i * 8192, R, C); const int Rb = Epi::PERM ? ((R & ~31) + perm32(R & 31)) : R;
        voffA[i] = (unsigned)(R * K + C) * 2u; voffB[i] = (unsigned)(Rb * K + C) * 2u; }
    const size_t kstep = (size_t)(BK * 2);
    const size_t hstep = (size_t)HALF * K * 2;
    const size_t tstep = 2 * hstep;
    const unsigned ldsw = (unsigned)wid * 1024u;
    const int aoff = lds_byte(wr * 64 + fr, fq * 8), boff = lds_byte(wc * 32 + fr, fq * 8);
#define PG8_SA(b, h) (((b) * 2 + (h)) * HTB)
#define PG8_SB(b, h) ((4 + (b) * 2 + (h)) * HTB)
#define PG8_STAGE(bufoff, gbase, voff) do { _Pragma("unroll") for (int _i = 0; _i < 2; ++_i) \
        __builtin_amdgcn_global_load_lds((const unsigned*)((const char*)(gbase) + (voff)[_i]), (PG8_LAS unsigned*)(lds + (bufoff) + ldsw + _i * 8192), 16, 0, 0); } while (0)
#define PG8_LDA(dst, b, h) do { _Pragma("unroll") for (int m = 0; m < 4; ++m) _Pragma("unroll") for (int k = 0; k < 2; ++k) dst[m][k] = *(const PG8_LAS bf16x8*)(lds + PG8_SA(b, h) + aoff + m * 2048 + k * 1024); } while (0)
#define PG8_LDB(dst, b, h) do { _Pragma("unroll") for (int n = 0; n < 2; ++n) _Pragma("unroll") for (int k = 0; k < 2; ++k) dst[n][k] = *(const PG8_LAS bf16x8*)(lds + PG8_SB(b, h) + boff + n * 2048 + k * 1024); } while (0)
#define PG8_MMA(ai, bj, At, Bt) do { __builtin_amdgcn_s_setprio(1); _Pragma("unroll") for (int m = 0; m < 4; ++m) _Pragma("unroll") for (int n = 0; n < 2; ++n) _Pragma("unroll") for (int k = 0; k < 2; ++k) \
        acc[ai][bj][m][n] = __builtin_amdgcn_mfma_f32_16x16x32_bf16(Bt[n][k], At[m][k], acc[ai][bj][m][n], 0, 0, 0); __builtin_amdgcn_s_setprio(0); } while (0)
#define PG8_WAIT_V(n) asm volatile("s_waitcnt vmcnt(" #n ")" ::: "memory")
#define PG8_WAIT_L(n) asm volatile("s_waitcnt lgkmcnt(" #n ")" ::: "memory")
#define PG8_BAR __builtin_amdgcn_s_barrier()
#define PG8_SCHED __builtin_amdgcn_sched_barrier(0)
    Unit cur, nxt; int ui = 0;
    if (!S.next(0, cur)) return;
    f32x4 acc[2][2][4][2];
#pragma unroll
    for (int a = 0; a < 2; ++a)
#pragma unroll
        for (int b = 0; b < 2; ++b)
#pragma unroll
            for (int m = 0; m < 4; ++m)
#pragma unroll
                for (int n = 0; n < 2; ++n) acc[a][b][m][n] = (f32x4){0.f, 0.f, 0.f, 0.f};
    bf16x8 At[4][2], B0[2][2], B1[2][2];
    const char* cA = g.a(cur.s) + (size_t)cur.pm * tstep; const char* cB = g.b(cur.s) + (size_t)cur.pn * tstep;
    S.a_ready(cur);
    if constexpr (SP2) {
        PG8_STAGE(PG8_SB(0, 0), cB, voffB); PG8_STAGE(PG8_SB(0, 1), cB + hstep, voffB); PG8_STAGE(PG8_SA(0, 0), cA, voffA); PG8_STAGE(PG8_SA(0, 1), cA + hstep, voffA);
        if (wr == 1) PG8_BAR;
        PG8_WAIT_V(2); PG8_BAR;
        PG8_STAGE(PG8_SB(1, 0), cB + kstep, voffB); PG8_STAGE(PG8_SA(1, 0), cA + kstep, voffA); PG8_STAGE(PG8_SB(1, 1), cB + hstep + kstep, voffB);
        PG8_WAIT_V(6); PG8_BAR;
    } else {
        PG8_STAGE(PG8_SB(0, 0), cB, voffB); PG8_STAGE(PG8_SA(0, 0), cA, voffA); PG8_STAGE(PG8_SB(0, 1), cB + hstep, voffB); PG8_STAGE(PG8_SA(0, 1), cA + hstep, voffA);
        if (wr == 1) PG8_BAR;
        PG8_WAIT_V(4); PG8_BAR;
        PG8_STAGE(PG8_SB(1, 0), cB + kstep, voffB); PG8_STAGE(PG8_SA(1, 0), cA + kstep, voffA); PG8_STAGE(PG8_SB(1, 1), cB + hstep + kstep, voffB);
        PG8_WAIT_V(6); PG8_BAR;
    }
    for (;;) {
        const bool has_next = S.next(ui + 1, nxt);
        const char* nA = has_next ? g.a(nxt.s) + (size_t)nxt.pm * tstep : cA; const char* nB = has_next ? g.b(nxt.s) + (size_t)nxt.pn * tstep : cB;
        for (int t = 0; t < nt; t += 2) {
            const bool last = (t == nt - 2);
            const char* a1 = cA + (size_t)(t + 1) * kstep;
            const char* a2 = last ? nA : cA + (size_t)(t + 2) * kstep; const char* b2 = last ? nB : cB + (size_t)(t + 2) * kstep;
            const char* a3 = a2 + kstep; const char* b3 = b2 + kstep;
            if (last && has_next) S.a_ready(nxt);
            if constexpr (SP2) {
            PG8_LDB(B0, 0, 0); PG8_LDB(B1, 0, 1); PG8_SCHED; PG8_LDA(At, 0, 0); PG8_STAGE(PG8_SA(1, 1), a1 + hstep, voffA);
            PG8_WAIT_V(8); PG8_WAIT_L(0); PG8_BAR; PG8_MMA(0, 0, At, B0); PG8_MMA(0, 1, At, B1); PG8_BAR; PG8_SCHED;
            PG8_LDA(At, 0, 1); PG8_STAGE(PG8_SB(0, 0), b2, voffB); PG8_STAGE(PG8_SB(0, 1), b2 + hstep, voffB); PG8_STAGE(PG8_SA(0, 0), a2, voffA);
            PG8_WAIT_V(8); PG8_WAIT_L(0); PG8_BAR; PG8_MMA(1, 0, At, B0); PG8_MMA(1, 1, At, B1); PG8_BAR; PG8_SCHED;
            PG8_LDB(B0, 1, 0); PG8_LDB(B1, 1, 1); PG8_SCHED; PG8_LDA(At, 1, 0); PG8_STAGE(PG8_SA(0, 1), a2 + hstep, voffA);
            PG8_WAIT_V(8); PG8_WAIT_L(0); PG8_BAR; PG8_MMA(0, 0, At, B0); PG8_MMA(0, 1, At, B1); PG8_BAR; PG8_SCHED;
            PG8_LDA(At, 1, 1); PG8_STAGE(PG8_SB(1, 0), b3, voffB); PG8_STAGE(PG8_SB(1, 1), b3 + hstep, voffB); PG8_STAGE(PG8_SA(1, 0), a3, voffA);
            PG8_WAIT_V(8); PG8_WAIT_L(0); PG8_BAR; PG8_MMA(1, 0, At, B0); PG8_MMA(1, 1, At, B1); PG8_BAR; PG8_SCHED;
            } else {
            PG8_LDB(B0, 0, 0); PG8_SCHED; PG8_LDA(At, 0, 0); PG8_STAGE(PG8_SA(1, 1), a1 + hstep, voffA);
            PG8_WAIT_L(8); PG8_BAR; PG8_WAIT_L(0); PG8_MMA(0, 0, At, B0); PG8_BAR; PG8_SCHED;
            PG8_LDB(B1, 0, 1); PG8_STAGE(PG8_SB(0, 0), b2, voffB);
            PG8_BAR; PG8_WAIT_L(0); PG8_MMA(0, 1, At, B1); PG8_BAR;
            PG8_LDA(At, 0, 1); PG8_STAGE(PG8_SA(0, 0), a2, voffA);
            PG8_BAR; PG8_WAIT_L(0); PG8_MMA(1, 0, At, B0); PG8_BAR; PG8_SCHED;
            PG8_STAGE(PG8_SB(0, 1), b2 + hstep, voffB);
            PG8_WAIT_V(6); PG8_BAR; PG8_MMA(1, 1, At, B1); PG8_BAR;
            PG8_LDB(B0, 1, 0); PG8_SCHED; PG8_LDA(At, 1, 0); PG8_STAGE(PG8_SA(0, 1), a2 + hstep, voffA);
            PG8_WAIT_L(8); PG8_BAR; PG8_WAIT_L(0); PG8_MMA(0, 0, At, B0); PG8_BAR; PG8_SCHED;
            PG8_LDB(B1, 1, 1); PG8_STAGE(PG8_SB(1, 0), b3, voffB);
            PG8_BAR; PG8_WAIT_L(0); PG8_MMA(0, 1, At, B1); PG8_BAR;
            PG8_LDA(At, 1, 1); PG8_STAGE(PG8_SA(1, 0), a3, voffA);
            PG8_BAR; PG8_WAIT_L(0); PG8_MMA(1, 0, At, B0); PG8_BAR; PG8_SCHED;
            PG8_STAGE(PG8_SB(1, 1), b3 + hstep, voffB);
            PG8_WAIT_V(6); PG8_BAR; PG8_MMA(1, 1, At, B1); PG8_BAR;
            }
        }
        if constexpr (ALIGN_EPI) { if (wr == 0) PG8_BAR; }
        if constexpr (!Epi::AFTER_DRAIN) { E(acc, cur, wr, wc, fr, fq); S.done(cur); }
        if (!has_next) break;
        if (S.last_sub(cur)) {
#pragma unroll
        for (int a = 0; a < 2; ++a)
#pragma unroll
            for (int b = 0; b < 2; ++b)
#pragma unroll
                for (int m = 0; m < 4; ++m)
#pragma unroll
                    for (int n = 0; n < 2; ++n) acc[a][b][m][n] = (f32x4){0.f, 0.f, 0.f, 0.f};
        }
        cur = nxt; cA = nA; cB = nB; ++ui;
        if constexpr (ALIGN_EPI) { if (wr == 1) PG8_BAR; }
    }
    PG8_WAIT_V(0);
    if constexpr (!ALIGN_EPI) { if (wr == 0) PG8_BAR; }
    PG8_BAR;
    if constexpr (Epi::AFTER_DRAIN) { E.fused(acc, cur, wr, wc, fr, fq, lds, wid, lane); S.done(cur); }
#undef PG8_SA
#undef PG8_SB
#undef PG8_STAGE
#undef PG8_LDA
#undef PG8_LDB
#undef PG8_MMA
#undef PG8_WAIT_V
#undef PG8_WAIT_L
#undef PG8_BAR
#undef PG8_SCHED
}
}

struct EpiIn {
    bf16_t *Q, *KV, *RX, *PU, *RY, *G; const float* tcos; const float* tsin;
    __device__ __forceinline__ void operator()(int row, int c8, f32x4 v0, f32x4 v1) const {
        if (c8 < 640) {
            if (row < ML) {
                const int s = row & 2047, pp = c8 & 63, Gq = pp >> 3;
                const int pos = (Gq & 4) ? (s & 63) : (s >> 6);
                const int i0 = (Gq & 3) * 4;
                const f32x4 cs = *(const f32x4*)(tcos + pos * 16 + i0), sn = *(const f32x4*)(tsin + pos * 16 + i0);
                const f32x4 a = v0 * cs - v1 * sn, b = v1 * cs + v0 * sn; v0 = a; v1 = b;
            }
            if (c8 < 512) { v0 = v0 * QSCALE; v1 = v1 * QSCALE; *(u32x4*)(Q + (size_t)row * 512 + c8) = pack8(v0, v1); }
            else *(u32x4*)(KV + (size_t)row * 256 + (c8 - 512)) = pack8(v0, v1);
        } else if (c8 < 768) *(u32x4*)(KV + (size_t)row * 256 + 128 + (c8 - 640)) = pack8(v0, v1);
        else if (c8 < 1280) *(u32x4*)(RX + (size_t)row * 512 + (c8 - 768)) = pack8(v0, v1);
        else if (c8 < 1792) *(u32x4*)(RY + (size_t)row * 512 + (c8 - 1280)) = pack8(v0, v1);
        else if (c8 < 2304) *(u32x4*)(PU + (size_t)row * 512 + (c8 - 1792)) = pack8(v0, v1);
        else {
#pragma unroll
            for (int j = 0; j < 4; ++j) { v0[j] = sigm(v0[j]); v1[j] = sigm(v1[j]); }
            *(u32x4*)(G + (size_t)row * 3072 + (c8 - 2304)) = pack8(v0, v1);
        }
    }
};
struct EpiStore {
    bf16_t* O; int ldc;
    __device__ __forceinline__ void operator()(int row, int c8, f32x4 v0, f32x4 v1) const { *(u32x4*)(O + (size_t)row * ldc + c8) = pack8(v0, v1); }
};
struct EpiSwiglu {
    bf16_t* O;
    __device__ __forceinline__ void operator()(int row, int c8, f32x4 v0, f32x4 v1) const {
        f32x4 o;
#pragma unroll
        for (int j = 0; j < 4; ++j) o[j] = v0[j] * sigm(v0[j]) * v1[j];
        u32x2 w; w.x = pk2(o[0], o[1]); w.y = pk2(o[2], o[3]);
        *(u32x2*)(O + (size_t)row * DFF + (c8 >> 1)) = w;
    }
};

template <class F> struct EpiW {
    static constexpr bool PERM = true, AFTER_DRAIN = false;
    F f;
    __device__ __forceinline__ void operator()(pg8::f32x4 (&acc)[2][2][4][2], const pg8::Unit& u, int wr, int wc, int fr, int fq) const {
        const int row0 = u.pm * 256 + wr * 64 + fr, col0 = u.pn * 256 + wc * 32 + 8 * fq;
#pragma unroll
        for (int ai = 0; ai < 2; ++ai)
#pragma unroll
            for (int m = 0; m < 4; ++m)
#pragma unroll
                for (int bj = 0; bj < 2; ++bj) f(row0 + ai * 128 + m * 16, col0 + bj * 128, acc[ai][bj][m][0], acc[ai][bj][m][1], u.s);
    }
};
struct EpiAll {
    int kind; unsigned char* ws; size_t ooff;
    __device__ __forceinline__ void operator()(int row, int c8, f32x4& v0, f32x4& v1, int sub) const {
        if (kind == 0) {
            EpiIn e{(bf16_t*)(ws + OFF_Q), (bf16_t*)(ws + OFF_KV), (bf16_t*)(ws + OFF_RX), (bf16_t*)(ws + OFF_PU), (bf16_t*)(ws + OFF_RY), (bf16_t*)(ws + OFF_G),
                    (const float*)(ws + OFF_TAB), (const float*)(ws + OFF_TAB) + 1024};
            e(row, c8, v0, v1);
        } else if (kind == 1) {
            *(u32x4*)((bf16_t*)(ws + ooff) + (size_t)row * DM + c8) = pack8(v0, v1);
        } else if (kind == 2) {
            EpiSwiglu e{(bf16_t*)(ws + OFF_G)};
            e(row, c8, v0, v1);
        } else {
            const bf16_t* gp = (const bf16_t*)(ws + OFF_G) + (size_t)row * 3072 + sub * 1024 + c8;
            f32x4 a0, a1; unpack8(*(const u32x4*)gp, a0, a1);
            if (sub < 2) {
                f32x4 b0, b1; unpack8(*(const u32x4*)(gp + 1024), b0, b1);
#pragma unroll
                for (int j = 0; j < 4; ++j) { v0[j] *= a0[j] * __builtin_amdgcn_rcpf(fmaxf(b0[j], 1e-30f)); v1[j] *= a1[j] * __builtin_amdgcn_rcpf(fmaxf(b1[j], 1e-30f)); }
            } else {
                *(u32x4*)((bf16_t*)(ws + OFF_MERGED) + (size_t)row * DM + c8) = pack8(v0 * a0, v1 * a1);
            }
        }
    }
};
struct UOrder {
    pg8::StaticOrder so; int extra, subs;
    __device__ void init(int M, int N, int G, int c, int extra_, int subs_) { so.init(M, N, G, c); extra = extra_; subs = subs_; }
    __device__ bool next(int i, pg8::Unit& u) const {
        int ti = i, sub = 0;
        if (subs == 3) { ti = i / 3; sub = i - 3 * ti; }
        const long L = (long)ti * so.G + so.c;
        if (L < so.nwg) { const bool ok = so.next(ti, u); u.s = sub; return ok; }
        const int r = (int)(L - so.nwg); if (r >= extra) return false;
        u.pm = 64 + (r & 7); u.pn = 2 + (r >> 3); u.s = 0; return true;
    }
    __device__ __forceinline__ bool last_sub(const pg8::Unit& u) const { return u.s + 1 == subs; }
    __device__ __forceinline__ void a_ready(const pg8::Unit&) const {}
    __device__ __forceinline__ void done(const pg8::Unit&) const {}
};
__device__ __forceinline__ void gemm_wave_acc(const bf16_t* A, const bf16_t* Bt, int K, int rw, int cw, int fr, int fq, f32x4 (&acc)[4][4]) {
    const bf16_t* ap[4]; const bf16_t* bp[4];
#pragma unroll
    for (int i = 0; i < 4; ++i) ap[i] = A + (size_t)(rw + 16 * i + fr) * K + 8 * fq;
#pragma unroll
    for (int q = 0; q < 4; ++q) bp[q] = Bt + (size_t)(cw + 32 * (q >> 1) + perm32(16 * (q & 1) + fr)) * K + 8 * fq;
#pragma unroll 2
    for (int k = 0; k < K; k += 32) {
        bf16x8 af[4], bfr[4];
#pragma unroll
        for (int i = 0; i < 4; ++i) af[i] = *(const bf16x8*)(ap[i] + k);
#pragma unroll
        for (int q = 0; q < 4; ++q) bfr[q] = *(const bf16x8*)(bp[q] + k);
#pragma unroll
        for (int i = 0; i < 4; ++i)
#pragma unroll
            for (int q = 0; q < 4; ++q) acc[i][q] = __builtin_amdgcn_mfma_f32_16x16x32_bf16(bfr[q], af[i], acc[i][q], 0, 0, 0);
    }
}
template <class Epi>
__device__ __forceinline__ void gemm_simple(const bf16_t* A, const bf16_t* Bt, int K, int row_off, int M, int col_off, int N, const Epi& epi, int bid, int G) {
    const int tid = opaque_tid(), lane = tid & 63, wave = tid >> 6, wr = wave >> 2, wc = wave & 3, fr = lane & 15, fq = lane >> 4;
    const int nM = M / 128, nN = N / 256;
    for (int u = bid; u < nM * nN; u += G) {
        const int pm = u % nM, pn = u / nM;
        const int rw = row_off + pm * 128 + wr * 64, cw = col_off + pn * 256 + wc * 64;
        f32x4 acc[4][4];
#pragma unroll
        for (int i = 0; i < 4; ++i)
#pragma unroll
            for (int q = 0; q < 4; ++q) acc[i][q] = (f32x4){0.f, 0.f, 0.f, 0.f};
        gemm_wave_acc(A, Bt, K, rw, cw, fr, fq, acc);
#pragma unroll
        for (int i = 0; i < 4; ++i)
#pragma unroll
            for (int g = 0; g < 2; ++g) epi(rw + 16 * i + fr, cw + 32 * g + 8 * fq, acc[i][2 * g], acc[i][2 * g + 1]);
    }
}
__device__ __forceinline__ void gemm_merge(const P& p, int M, int bid, int G) {
    const int tid = opaque_tid(), lane = tid & 63, wave = tid >> 6, wr = wave >> 2, wc = wave & 3, fr = lane & 15, fq = lane >> 4;
    const bf16_t* Gt = (const bf16_t*)(p.ws + OFF_G);
    bf16_t* O = (bf16_t*)(p.ws + OFF_MERGED);
    const int nM = M / 128, nN = 8;
    for (int u = bid; u < nM * nN; u += G) {
        const int pm = u % nM, pn = u / nM;
        const int rw = pm * 128 + wr * 64, cw = pn * 128 + wc * 32;
        f32x4 tot[4][2];
#pragma unroll
        for (int i = 0; i < 4; ++i) { tot[i][0] = (f32x4){0.f, 0.f, 0.f, 0.f}; tot[i][1] = (f32x4){0.f, 0.f, 0.f, 0.f}; }
#pragma unroll 1
        for (int s = 0; s < 3; ++s) {
            const bf16_t* A = (const bf16_t*)(p.ws + (s == 0 ? OFF_Q : (s == 1 ? OFF_A : OFF_RY)));
            const bf16_t* Bt = (const bf16_t*)(p.ws + OFF_WA + (s == 0 ? WA_AO : (s == 1 ? WA_PO : WA_RO)));
            f32x4 acc[4][2];
#pragma unroll
            for (int i = 0; i < 4; ++i) { acc[i][0] = (f32x4){0.f, 0.f, 0.f, 0.f}; acc[i][1] = (f32x4){0.f, 0.f, 0.f, 0.f}; }
            const bf16_t* ap = A + (size_t)(rw + fr) * 512 + 8 * fq;
            const bf16_t* bp0 = Bt + (size_t)(cw + perm32(fr)) * 512 + 8 * fq;
            const bf16_t* bp1 = Bt + (size_t)(cw + perm32(16 + fr)) * 512 + 8 * fq;
#pragma unroll 2
            for (int k = 0; k < 512; k += 32) {
                const bf16x8 b0 = *(const bf16x8*)(bp0 + k), b1 = *(const bf16x8*)(bp1 + k);
#pragma unroll
                for (int i = 0; i < 4; ++i) {
                    const bf16x8 af = *(const bf16x8*)(ap + (size_t)(16 * i) * 512 + k);
                    acc[i][0] = __builtin_amdgcn_mfma_f32_16x16x32_bf16(b0, af, acc[i][0], 0, 0, 0);
                    acc[i][1] = __builtin_amdgcn_mfma_f32_16x16x32_bf16(b1, af, acc[i][1], 0, 0, 0);
                }
            }
#pragma unroll
            for (int i = 0; i < 4; ++i) {
                f32x4 g0, g1; unpack8(*(const u32x4*)(Gt + (size_t)(rw + 16 * i + fr) * 3072 + s * 1024 + cw + 8 * fq), g0, g1);
                tot[i][0] += g0 * acc[i][0]; tot[i][1] += g1 * acc[i][1];
            }
        }
#pragma unroll
        for (int i = 0; i < 4; ++i) *(u32x4*)(O + (size_t)(rw + 16 * i + fr) * DM + cw + 8 * fq) = pack8(tot[i][0], tot[i][1]);
    }
}

__device__ __forceinline__ void attn_item(unsigned char* lds, bf16_t* Qb, const bf16_t* KVb, const float* sink, int qrow0, int kvh, int npos0, int b) {
    const int tid = opaque_tid(), lane = tid & 63, wave = tid >> 6, r32 = lane & 31, hi = lane >> 5;
    bf16_t* Ks = (bf16_t*)lds;
    bf16_t* Vs = (bf16_t*)(lds + 9216);
    const int hq = kvh * 4 + (wave >> 1);
    const int qoff = (wave & 1) * 32;
    bf16x8 qf[4];
#pragma unroll
    for (int ks = 0; ks < 4; ++ks) qf[ks] = *(const bf16x8*)(Qb + (size_t)(qrow0 + qoff + r32) * 512 + hq * 64 + 16 * ks + 8 * hi);
    f32x16 o[2];
#pragma unroll
    for (int dt = 0; dt < 2; ++dt)
#pragma unroll
        for (int r = 0; r < 16; ++r) o[dt][r] = 0.f;
    float m = sink[hq] * LOG2E, l = (hi == 0) ? 1.f : 0.f;
    const int ntl = (npos0 >= 0) ? 5 : 0;
    const int qp0 = npos0 + qoff;
    const int skey = tid >> 3, sch = tid & 7;
    int ti = 0;
    while (ti < ntl) { const int k0 = npos0 - 128 + 64 * ti; if (k0 >= 0 && k0 < SEQ) break; ++ti; }
    u32x4 pkv, pvv;
    {
        const int krow = (ti < ntl) ? (b * SEQ + npos0 - 128 + 64 * ti) : (ML + b * CTX + 64 * (ti - ntl));
        const bf16_t* src = KVb + (size_t)(krow + skey) * 256 + kvh * 64 + sch * 8;
        pkv = *(const u32x4*)src; pvv = *(const u32x4*)(src + 128);
    }
#pragma unroll 1
    while (ti < ntl + 4) {
        const bool masked = ti < ntl;
        const int kp0 = masked ? (npos0 - 128 + 64 * ti) : 0;
        __syncthreads();
        {
            *(u32x4*)(Ks + skey * 72 + sch * 8) = pkv;
            *(u32x4*)(Vs + skey * 72 + sch * 8) = pvv;
        }
        __syncthreads();
        int tn = ti + 1;
        while (tn < ntl) { const int k0 = npos0 - 128 + 64 * tn; if (k0 >= 0 && k0 < SEQ) break; ++tn; }
        if (tn < ntl + 4) {
            const int krow = (tn < ntl) ? (b * SEQ + npos0 - 128 + 64 * tn) : (ML + b * CTX + 64 * (tn - ntl));
            const bf16_t* src = KVb + (size_t)(krow + skey) * 256 + kvh * 64 + sch * 8;
            pkv = *(const u32x4*)src; pvv = *(const u32x4*)(src + 128);
        }
        const int tcur = ti; ti = tn; (void)tcur;
        if (masked && (kp0 - (qp0 + 31) > 128 || qp0 - (kp0 + 63) > 128)) continue;
        f32x16 p0, p1;
#pragma unroll
        for (int r = 0; r < 16; ++r) { p0[r] = 0.f; p1[r] = 0.f; }
#pragma unroll
        for (int ks = 0; ks < 4; ++ks) {
            const bf16x8 k0 = *(const bf16x8*)(Ks + r32 * 72 + 16 * ks + 8 * hi);
            const bf16x8 k1 = *(const bf16x8*)(Ks + (32 + r32) * 72 + 16 * ks + 8 * hi);
            p0 = __builtin_amdgcn_mfma_f32_32x32x16_bf16(k0, qf[ks], p0, 0, 0, 0);
            p1 = __builtin_amdgcn_mfma_f32_32x32x16_bf16(k1, qf[ks], p1, 0, 0, 0);
        }
        if (masked && ((qp0 + 31) - kp0 > 128 || (kp0 + 63) - qp0 > 128)) {
            const int qp = qp0 + r32;
#pragma unroll
            for (int r = 0; r < 16; ++r) {
                const int d0 = qp - (kp0 + crow(r, hi)), d1 = d0 - 32;
                if (d0 > 128 || d0 < -128) p0[r] = -1e30f;
                if (d1 > 128 || d1 < -128) p1[r] = -1e30f;
            }
        }
        float mx = fmaxf(p0[0], p1[0]);
#pragma unroll
        for (int r = 1; r < 16; ++r) mx = fmaxf(mx, fmaxf(p0[r], p1[r]));
        mx = fmaxf(mx, __shfl_xor(mx, 32));
        const float mn = fmaxf(m, mx);
        const float alpha = __builtin_amdgcn_exp2f(m - mn);
        m = mn;
        float rs = 0.f;
#pragma unroll
        for (int r = 0; r < 16; ++r) { p0[r] = __builtin_amdgcn_exp2f(p0[r] - mn); p1[r] = __builtin_amdgcn_exp2f(p1[r] - mn); rs += p0[r] + p1[r]; }
        l = l * alpha + rs;
#pragma unroll
        for (int dt = 0; dt < 2; ++dt)
#pragma unroll
            for (int r = 0; r < 16; ++r) o[dt][r] *= alpha;
#pragma unroll
        for (int s4 = 0; s4 < 4; ++s4) {
            u32x4 pw;
            if (s4 < 2) { const int o8 = 8 * s4; pw.x = pk2(p0[o8], p0[o8 + 1]); pw.y = pk2(p0[o8 + 2], p0[o8 + 3]); pw.z = pk2(p0[o8 + 4], p0[o8 + 5]); pw.w = pk2(p0[o8 + 6], p0[o8 + 7]); }
            else { const int o8 = 8 * (s4 - 2); pw.x = pk2(p1[o8], p1[o8 + 1]); pw.y = pk2(p1[o8 + 2], p1[o8 + 3]); pw.z = pk2(p1[o8 + 4], p1[o8 + 5]); pw.w = pk2(p1[o8 + 6], p1[o8 + 7]); }
            const bf16x8 pf = __builtin_bit_cast(bf16x8, pw);
            const int keybase = 32 * (s4 >> 1) + 16 * (s4 & 1) + 4 * hi;
#pragma unroll
            for (int dt = 0; dt < 2; ++dt) {
                const bf16_t* vp = Vs + (keybase + ((lane & 15) >> 2)) * 72 + 32 * dt + 16 * ((lane >> 4) & 1) + 4 * (lane & 3);
                const s16x4 lo = __builtin_bit_cast(s16x4, __builtin_amdgcn_ds_read_tr16_b64_v4i16((__attribute__((address_space(3))) s16x4*)vp));
                const s16x4 hh = __builtin_bit_cast(s16x4, __builtin_amdgcn_ds_read_tr16_b64_v4i16((__attribute__((address_space(3))) s16x4*)(vp + 8 * 72)));
                const bf16x8 vf = (bf16x8){lo[0], lo[1], lo[2], lo[3], hh[0], hh[1], hh[2], hh[3]};
                o[dt] = __builtin_amdgcn_mfma_f32_32x32x16_bf16(vf, pf, o[dt], 0, 0, 0);
            }
        }
    }
    {
        const float lt = l + __shfl_xor(l, 32);
        const float inv = 1.f / lt;
        bf16_t* orow = Qb + (size_t)(qrow0 + qoff + r32) * 512 + hq * 64;
#pragma unroll
        for (int dt = 0; dt < 2; ++dt)
#pragma unroll
            for (int rg = 0; rg < 4; ++rg) {
                u32x2 w; w.x = pk2(o[dt][4 * rg] * inv, o[dt][4 * rg + 1] * inv); w.y = pk2(o[dt][4 * rg + 2] * inv, o[dt][4 * rg + 3] * inv);
                *(u32x2*)(orow + 32 * dt + 8 * rg + 4 * hi) = w;
            }
    }
    __syncthreads();
}

__device__ __forceinline__ void pool_item(const P& p, int l, unsigned char* lds, int rb, int L, int t0, int g) {
    const int tid = opaque_tid(), lane = tid & 63, wave = tid >> 6, fr = lane & 15, fq = lane >> 4;
    bf16_t* U = (bf16_t*)lds;
    bf16_t* Dt = (bf16_t*)(lds + 20480);
    const bf16_t* PUb = (const bf16_t*)(p.ws + OFF_PU);
    bf16_t* PO = (bf16_t*)(p.ws + OFF_A);
    const bf16_t* PMt = (const bf16_t*)(p.ws + OFF_WA + WA_PM);
    const int mt = wave & 3, nh = wave >> 2;
    bf16x8 wf[4][4];
#pragma unroll
    for (int nt = 0; nt < 4; ++nt)
#pragma unroll
        for (int ks = 0; ks < 4; ++ks) wf[nt][ks] = *(const bf16x8*)(PMt + (size_t)(g * 128 + nh * 64 + 16 * nt + fr) * 128 + 32 * ks + 8 * fq);
    for (int idx = tid; idx < 80 * 16; idx += NTHREADS) {
        const int rr = idx >> 4, ch = idx & 15, t = t0 - 7 + rr;
        u32x4 v = (u32x4){0u, 0u, 0u, 0u};
        if (t >= 0 && t < L) v = *(const u32x4*)(PUb + (size_t)(rb + t) * 512 + g * 128 + ch * 8);
        *(u32x4*)(U + rr * 128 + ch * 8) = v;
    }
    __syncthreads();
    {
        const int w = 2 << g, offL = (w - 1) / 2, offR = w / 2;
        const int cp = tid & 63, t8 = (tid >> 6) * 8;
        const unsigned* U32 = (const unsigned*)U;
        float s0 = 0.f, s1 = 0.f;
        for (int u = t8 - offL; u <= t8 + offR; ++u) { const unsigned x = U32[(u + 7) * 64 + cp]; s0 += bf2f(x & 0xffffu); s1 += bf2f(x >> 16); }
#pragma unroll
        for (int i = 0; i < 8; ++i) {
            const int tt = t8 + i, t = t0 + tt;
            const int lo = max(t - offL, 0), hi = min(t + offR + 1, L);
            const float rc = __builtin_amdgcn_rcpf((float)(hi - lo));
            const unsigned xc = U32[(tt + 7) * 64 + cp];
            const float d0 = s0 * rc - bf2f(xc & 0xffffu), d1 = s1 * rc - bf2f(xc >> 16);
            *(unsigned*)(Dt + tt * 136 + 2 * cp) = pk2(d0, d1);
            if (i < 7) {
                const unsigned xo = U32[(tt - offL + 7) * 64 + cp], xn = U32[(tt + offR + 1 + 7) * 64 + cp];
                s0 += bf2f(xn & 0xffffu) - bf2f(xo & 0xffffu); s1 += bf2f(xn >> 16) - bf2f(xo >> 16);
            }
        }
    }
    __syncthreads();
    f32x4 acc[4];
#pragma unroll
    for (int nt = 0; nt < 4; ++nt) acc[nt] = (f32x4){0.f, 0.f, 0.f, 0.f};
#pragma unroll
    for (int ks = 0; ks < 4; ++ks) {
        const bf16x8 af = *(const bf16x8*)(Dt + (16 * mt + fr) * 136 + 32 * ks + 8 * fq);
#pragma unroll
        for (int nt = 0; nt < 4; ++nt) acc[nt] = __builtin_amdgcn_mfma_f32_16x16x32_bf16(wf[nt][ks], af, acc[nt], 0, 0, 0);
    }
#pragma unroll
    for (int nt = 0; nt < 4; ++nt) {
        const int col = g * 128 + nh * 64 + 16 * nt + 4 * fq;
        const f32x4 sc = *(const f32x4*)(p.in[I_PSCALE] + l * 512 + col);
        const f32x4 v = acc[nt] * sc;
        u32x2 wv; wv.x = pk2(v[0], v[1]); wv.y = pk2(v[2], v[3]);
        *(u32x2*)(PO + (size_t)(rb + t0 + 16 * mt + fr) * 512 + col) = wv;
    }
    __syncthreads();
}

constexpr size_t OFF_CT = 251 * MiB;
__device__ __forceinline__ void rnn_phase(const P& p, int l, unsigned char* lds, int pass, bool skip_ctx, int g_first, int g_step) {
    const int tid = opaque_tid(), half = tid >> 8, lane = tid & 63, hw = (tid >> 6) & 3, fr = lane & 15, fq = lane >> 4;
    const int d = half;
    float* XL = (float*)lds;
    bf16_t* XA = (bf16_t*)(lds + 16384);
    float2* TT = (float2*)(lds + 25600);
    float* HO = (float*)(lds + 31744);
    float2* CTL = (float2*)(lds + 64512);
    bf16_t* WL = (bf16_t*)(lds + 101376);
    const bf16_t* RXb = (const bf16_t*)(p.ws + OFF_RX);
    bf16_t* RYb = (bf16_t*)(p.ws + OFF_RY);
    float2* CT = (float2*)(p.ws + OFF_CT);
    const int cc = tid & 63, tb = (tid >> 6) * 8;
    const int ot = tid >> 3, oc8 = (tid & 7) * 8;
#pragma unroll 1
    for (int g = g_first; g < 256; g += g_step) {
        const int b = g >> 5, hb = (g >> 2) & 7, q4 = g & 3;
        const size_t ctbase = (size_t)((b * 8 + hb) * 2) * 36 * 64;
        __syncthreads();
#pragma unroll
        for (int i = 0; i < 4; ++i) {
            const int pc = tid + 512 * i, dm = pc >> 9, row = (pc >> 3) & 63, ch = pc & 7;
            const bf16_t* src = (const bf16_t*)(p.ws + OFF_WA + ((dm & 1) ? WA_LX : WA_LA)) + (size_t)((dm >> 1) * 8 + hb) * 4096 + row * 64 + ch * 8;
            *(u32x4*)(WL + (dm * 64 + row) * 72 + ch * 8) = *(const u32x4*)src;
        }
        float gba[4], gbx[4], ls2[4], cw[4];
#pragma unroll
        for (int nt = 0; nt < 4; ++nt) {
            const int cg_ = (l * 2 + d) * 512 + hb * 64 + 16 * nt + fr;
            gba[nt] = p.in[I_LBA][cg_]; gbx[nt] = p.in[I_LBX][cg_];
            ls2[nt] = (-8.f * LOG2E) * log1pf(__expf(-p.in[I_LAM][cg_]));
        }
#pragma unroll
        for (int k = 0; k < 4; ++k) cw[k] = p.in[I_CONVW][(l * 4 + k) * 512 + hb * 64 + cc];
        const float cbias = p.in[I_CONVB][l * 512 + hb * 64 + cc];
        if (pass == 2) {
#pragma unroll
            for (int i = 0; i < 9; ++i) CTL[tid + 512 * i] = CT[ctbase + tid + 512 * i];
            __syncthreads();
            if (tid < 128) {
                const int dd = tid >> 6, c = tid & 63;
                float2* ct = CTL + (dd * 36) * 64 + c;
                float h = 0.f;
#pragma unroll 12
                for (int j = 0; j < 36; ++j) {
                    const int k = (dd == 0) ? j : (j < 4 ? 3 - j : 39 - j);
                    const float2 t = ct[k * 64];
                    ct[k * 64].x = h;
                    h = t.x * h + t.y;
                }
            }
        }
        const int k0 = (pass == 2 && skip_ctx) ? 1 : 0;
        unsigned short xraw[11]; u32x4 yraw = (u32x4){0u, 0u, 0u, 0u};
#define RNN_ROWBASE(cj_) (((cj_) < 4) ? (ML + b * CTX + (cj_) * 64) : (b * SEQ + (cj_) * 64 - 256))
#define RNN_ISSUE(cj_) do { const int sp0_ = ((cj_) < 4) ? (cj_) * 64 : (cj_) * 64 - 256; const int L_ = ((cj_) < 4) ? CTX : SEQ; \
            const bf16_t* rxp_ = RXb + (size_t)RNN_ROWBASE(cj_) * 512 + hb * 64 + cc; \
            _Pragma("unroll") for (int i = 0; i < 11; ++i) { const int sp = sp0_ + tb - 1 + i; xraw[i] = (sp >= 0 && sp < L_) ? rxp_[(ptrdiff_t)(tb - 1 + i) * 512] : (unsigned short)0; } } while (0)
        RNN_ISSUE(q4 + 4 * k0);
        if (pass == 2) yraw = *(const u32x4*)(RYb + (size_t)(RNN_ROWBASE(q4 + 4 * k0) + ot) * 512 + hb * 64 + oc8);
#pragma unroll 1
        for (int k = k0; k < 9; ++k) {
            const int cj = q4 + 4 * k;
            const int rowbase = RNN_ROWBASE(cj);
            {
                float xv[11];
#pragma unroll
                for (int i = 0; i < 11; ++i) xv[i] = bf2f(xraw[i]);
#pragma unroll
                for (int i = 0; i < 8; ++i) {
                    const float v = cbias + cw[0] * xv[i] + cw[1] * xv[i + 1] + cw[2] * xv[i + 2] + cw[3] * xv[i + 3];
                    XL[(tb + i) * 64 + cc] = v; XA[(tb + i) * 72 + cc] = (bf16_t)f2bf(v);
                }
            }
            __syncthreads();
            u32x4 yraw_n = (u32x4){0u, 0u, 0u, 0u};
            if (k + 1 < 9) {
                RNN_ISSUE(cj + 4);
                if (pass == 2) yraw_n = *(const u32x4*)(RYb + (size_t)(RNN_ROWBASE(cj + 4) + ot) * 512 + hb * 64 + oc8);
            }
            float av[4][4], bv[4][4];
            {
                f32x4 ga[4], gx[4];
#pragma unroll
                for (int nt = 0; nt < 4; ++nt) { ga[nt] = (f32x4){0.f, 0.f, 0.f, 0.f}; gx[nt] = (f32x4){0.f, 0.f, 0.f, 0.f}; }
#pragma unroll
                for (int ks = 0; ks < 2; ++ks) {
                    const bf16x8 af = *(const bf16x8*)(XA + (16 * hw + fr) * 72 + 32 * ks + 8 * fq);
#pragma unroll
                    for (int nt = 0; nt < 4; ++nt) {
                        const bf16x8 wa = *(const bf16x8*)(WL + ((d * 2 + 0) * 64 + 16 * nt + fr) * 72 + 32 * ks + 8 * fq);
                        const bf16x8 wx = *(const bf16x8*)(WL + ((d * 2 + 1) * 64 + 16 * nt + fr) * 72 + 32 * ks + 8 * fq);
                        ga[nt] = __builtin_amdgcn_mfma_f32_16x16x32_bf16(af, wa, ga[nt], 0, 0, 0);
                        gx[nt] = __builtin_amdgcn_mfma_f32_16x16x32_bf16(af, wx, gx[nt], 0, 0, 0);
                    }
                }
#pragma unroll
                for (int nt = 0; nt < 4; ++nt)
#pragma unroll
                    for (int rg = 0; rg < 4; ++rg) {
                        const int tk = 16 * hw + 4 * fq + rg, c = 16 * nt + fr;
                        const float r = sigm(ga[nt][rg] + gba[nt]);
                        const float ig = sigm(gx[nt][rg] + gbx[nt]);
                        const float a = __builtin_amdgcn_exp2f(ls2[nt] * r);
                        av[nt][rg] = a;
                        bv[nt][rg] = __builtin_amdgcn_sqrtf(fmaxf(1.f - a * a, 0.f)) * ig * XL[tk * 64 + c];
                    }
            }
            float exP[4], exQ[4];
#pragma unroll
            for (int nt = 0; nt < 4; ++nt) {
                float Pc = 1.f, Qc = 0.f;
#pragma unroll
                for (int i = 0; i < 4; ++i) {
                    const int rg = (d == 0) ? i : 3 - i;
                    Qc = av[nt][rg] * Qc + bv[nt][rg]; Pc = Pc * av[nt][rg];
                    av[nt][rg] = Pc; bv[nt][rg] = Qc;
                }
                float eP = 1.f, eQ = 0.f, tP = 1.f, tQ = 0.f;
#pragma unroll
                for (int i = 0; i < 4; ++i) {
                    const int kk = (d == 0) ? i : 3 - i;
                    const float kP = __shfl(Pc, fr + 16 * kk), kQ = __shfl(Qc, fr + 16 * kk);
                    const bool before = (d == 0) ? (kk < fq) : (kk > fq);
                    if (before) { eQ = kP * eQ + kQ; eP = eP * kP; }
                    tQ = kP * tQ + kQ; tP = tP * kP;
                }
                exP[nt] = eP; exQ[nt] = eQ;
                if (fq == 0) TT[(half * 4 + hw) * 64 + 16 * nt + fr] = make_float2(tP, tQ);
            }
            __syncthreads();
            if (pass == 1) {
                if (tid < 128) {
                    const int dd = tid >> 6, c = tid & 63;
                    float tP = 1.f, tQ = 0.f;
#pragma unroll
                    for (int i = 0; i < 4; ++i) { const int w = (dd == 0) ? i : 3 - i; const float2 t = TT[(dd * 4 + w) * 64 + c]; tQ = t.x * tQ + t.y; tP = tP * t.x; }
                    CT[ctbase + (size_t)(dd * 36 + cj) * 64 + c] = make_float2(tP, tQ);
                }
            } else {
#pragma unroll
                for (int nt = 0; nt < 4; ++nt) {
                    const int c = 16 * nt + fr;
                    float h = CTL[(half * 36 + cj) * 64 + c].x;
#pragma unroll
                    for (int i = 0; i < 3; ++i) {
                        const int w = (d == 0) ? i : 3 - i;
                        const float2 t = TT[(half * 4 + w) * 64 + c];
                        const bool before = (d == 0) ? (w < hw) : (w > hw);
                        if (before) h = t.x * h + t.y;
                    }
                    const float hin = exP[nt] * h + exQ[nt];
#pragma unroll
                    for (int rg = 0; rg < 4; ++rg) HO[(half * 64 + 16 * hw + 4 * fq + rg) * 64 + c] = av[nt][rg] * hin + bv[nt][rg];
                }
                __syncthreads();
                {
                    const f32x4 f0 = *(const f32x4*)(HO + ot * 64 + oc8), f1 = *(const f32x4*)(HO + ot * 64 + oc8 + 4);
                    const f32x4 b0 = *(const f32x4*)(HO + (64 + ot) * 64 + oc8), b1 = *(const f32x4*)(HO + (64 + ot) * 64 + oc8 + 4);
                    f32x4 y0, y1; unpack8(yraw, y0, y1);
                    f32x4 o0, o1;
#pragma unroll
                    for (int j = 0; j < 4; ++j) { o0[j] = (f0[j] + b0[j]) * gelu_tanh(y0[j]); o1[j] = (f1[j] + b1[j]) * gelu_tanh(y1[j]); }
                    *(u32x4*)(RYb + (size_t)(rowbase + ot) * 512 + hb * 64 + oc8) = pack8(o0, o1);
                }
            }
            yraw = yraw_n;
        }
#undef RNN_ROWBASE
#undef RNN_ISSUE
    }
    __syncthreads();
}

#define XB_TMO      128
#define XB_XCNT(j)  (256  + 64 * (j))
#define XB_XSUB(j)  (1280 + 64 * (j))
#define XB_XGEN(j)  (2304 + 64 * (j))
#define XB_TOP      3328
#define XB_TOPGEN   3392
#define XCD_BAR_WORDS 3456
#define XB_SPIN_CAP (1u << 18)

__device__ __forceinline__ unsigned xb_ld(unsigned* p)              { return __hip_atomic_load(p, __ATOMIC_RELAXED, __HIP_MEMORY_SCOPE_AGENT); }
__device__ __forceinline__ unsigned xb_add(unsigned* p, unsigned v) { return __hip_atomic_fetch_add(p, v, __ATOMIC_RELAXED, __HIP_MEMORY_SCOPE_AGENT); }
__device__ __forceinline__ unsigned xb_xcc_id() { return (unsigned)__builtin_amdgcn_s_getreg((3 << 11) | 20) & 0xFu; }
#define XB_SPIN(cond, bar) do { unsigned _sp = 0; while (cond) { __builtin_amdgcn_s_sleep(1); \
    if ((++_sp & 255u) == 0u) { if (xb_ld(&(bar)[XB_TMO])) break; if (_sp > XB_SPIN_CAP) { atomicAdd(&(bar)[XB_TMO], 1u); break; } } } } while (0)

struct XcdBarrier {
    unsigned* bar; unsigned x;
    volatile PG8_LAS unsigned* st;
};

__device__ __forceinline__ XcdBarrier xcd_barrier_post(unsigned* bar, volatile PG8_LAS unsigned* st) {
    XcdBarrier b; b.bar = bar; b.x = xb_xcc_id(); b.st = st;
    if (threadIdx.x == 0) (void)xb_add(&bar[XB_XCNT(b.x)], 1u);
    return b;
}
__device__ __forceinline__ void xcd_barrier_complete(unsigned* bar, unsigned x, unsigned& nloc, unsigned& nx) {
    const unsigned G = gridDim.x * gridDim.y * gridDim.z;
    unsigned sum, cnt, mine, sp = 0u;
    for (;;) {
        sum = 0u; cnt = 0u; mine = 0u;
#pragma unroll
        for (unsigned j = 0; j < 16; ++j) { const unsigned c = xb_ld(&bar[XB_XCNT(j)]); sum += c; cnt += (c > 0u) ? 1u : 0u; mine = (j == x) ? c : mine; }
        if (sum == G) break;
        __builtin_amdgcn_s_sleep(1);
        if ((++sp & 255u) == 0u) { if (xb_ld(&bar[XB_TMO])) break; if (sp > XB_SPIN_CAP) { atomicAdd(&bar[XB_TMO], 1u); break; } }
    }
    nloc = mine > 0u ? mine : 1u; nx = cnt > 0u ? cnt : 1u;
}

__device__ __forceinline__ void xcd_barrier(const XcdBarrier& b) {
    asm volatile("s_waitcnt vmcnt(0)" ::: "memory");
    __syncthreads();
    if (threadIdx.x == 0) {
        unsigned* bar = b.bar;
        __builtin_amdgcn_s_waitcnt(0);
        unsigned nloc = b.st[0], nx = b.st[1];
        if (nloc == 0u) { xcd_barrier_complete(bar, b.x, nloc, nx); b.st[0] = nloc; b.st[1] = nx; }
        const unsigned old = xb_add(&bar[XB_XSUB(b.x)], 1u);
        const unsigned gen = old / nloc;
        if (old + 1u == (gen + 1u) * nloc) {
            __builtin_amdgcn_fence(__ATOMIC_RELEASE, "agent");
            asm volatile("s_waitcnt vmcnt(0)" ::: "memory");
            const unsigned og = xb_add(&bar[XB_TOP], 1u);
            const unsigned tg = og / nx;
            if (og + 1u == (tg + 1u) * nx) xb_add(&bar[XB_TOPGEN], 1u);
            else XB_SPIN(xb_ld(&bar[XB_TOPGEN]) == tg, bar);
            __builtin_amdgcn_fence(__ATOMIC_ACQUIRE, "agent");
            xb_add(&bar[XB_XGEN(b.x)], 1u);
            asm volatile("s_waitcnt vmcnt(0)" ::: "memory");
        } else {
            XB_SPIN(xb_ld(&bar[XB_XGEN(b.x)]) == gen, bar);
            __builtin_amdgcn_fence(__ATOMIC_ACQUIRE, "agent");
            asm volatile("s_waitcnt vmcnt(0)" ::: "memory");
        }
    }
    __syncthreads();
}

__device__ __forceinline__ void run_phase(int ph, unsigned char* lds) {
#if defined(__HIP_DEVICE_COMPILE__)
    const __attribute__((address_space(4))) P* pp = (const __attribute__((address_space(4))) P*)__builtin_amdgcn_kernarg_segment_ptr();
    asm volatile("" : "+s"(pp));
    const P p = *pp;
#else
    const P p{};
#endif
    const int bid = blockIdx.x, G = gridDim.x;
    const int NGW = G * NWAVES;
    PG8_LAS unsigned char* ldsl = (PG8_LAS unsigned char*)lds;
    const float* mod = (const float*)(p.ws + OFF_MOD);
    bf16_t* Hb = (bf16_t*)(p.ws + OFF_A);
    float* XC = (float*)(p.ws + OFF_XC);
    if (ph == 0) {
        for (int it = bid; it < 192; it += G) mod_item(p, lds, it);
        if (bid == (192 % G)) table_item(p);
        __syncthreads();
        convert_WA(p, 0, lds, NGW);
        return;
    }
    if (ph == 1) {
        NormArgs a{}; a.xl = p.in[I_X]; a.xc = p.in[I_CTX]; a.y = nullptr; a.h = Hb; a.gpre = p.in[I_GPREMIX]; a.modh = mod; a.shift_idx = 0; a.nrows = MA;
        norm_rows(a, NGW);
        return;
    }
    const int l = (ph - 2) / 9; int sp = (ph - 2) % 9;
    const bool last = (l == 1);
    const int Mrows = last ? ML : MA;
    const float* modl = mod + (size_t)l * 9 * 6144;
    if (sp == 1) {
        const bool need_ctx = !last;
        const int nR = 256, nAL = 512, nAC = need_ctx ? 64 : 0, nPL = 1024, nPC = need_ctx ? 128 : 0;
        const int total = nR + nAL + nAC + nPL + nPC;
        bf16_t* Qb = (bf16_t*)(p.ws + OFF_Q); const bf16_t* KVb = (const bf16_t*)(p.ws + OFF_KV);
        const float* sink = p.in[I_SINK] + l * 8;
        unsigned* ctr = (unsigned*)(p.ws + OFF_CTL + 4096 + 256 * l);
        volatile int* slot = (volatile int*)(lds + LDS_BYTES - 32);
        for (;;) {
            if (threadIdx.x == 0) *slot = (int)atomicAdd(ctr, 1u);
            __syncthreads();
            int r = *slot;
            __syncthreads();
            if (r >= total) break;
            if (r < nR) { rnn_phase(p, l, lds, 1, false, r, 256); continue; }
            r -= nR;
            if (r < nAL + nAC) {
                int b, qrow0, npos0; const int kvh = r & 1;
                if (r < nAL) { b = r >> 6; const int qb = (r >> 1) & 31; qrow0 = b * SEQ + 64 * qb; npos0 = 64 * qb; }
                else { const int rc = r - nAL; b = rc >> 3; const int qb = (rc >> 1) & 3; qrow0 = ML + b * CTX + 64 * qb; npos0 = -1; }
                attn_item(lds, Qb, KVb, sink, qrow0, kvh, npos0, b);
                continue;
            }
            r -= nAL + nAC;
            int b, tile, rb, L; const int g = r & 3;
            if (r < nPL) { b = r >> 7; tile = (r >> 2) & 31; rb = b * SEQ; L = SEQ; }
            else { const int rc = r - nPL; b = rc >> 4; tile = (rc >> 2) & 3; rb = ML + b * CTX; L = CTX; }
            pool_item(p, l, lds, rb, L, tile * 64, g);
        }
        return;
    }
    if (sp == 2) { rnn_phase(p, l, lds, 2, last, bid, G); return; }
    if (sp > 2) sp -= 1;
    if (sp == 0 || sp == 2 || sp == 3 || sp == 5 || sp == 6) {
        pg8::Gemm g; EpiW<EpiAll> E; UOrder S;
        E.f.ws = p.ws; E.f.ooff = 0;
        if (sp == 0) {
            g.A = Hb; g.Bt = (const bf16_t*)(p.ws + OFF_WA + WA_IN); g.M = MA; g.N = INW; g.K = DM; E.f.kind = 0;
            if (!last) S.init(MA, INW, G, bid, 0, 1); else S.init(ML, INW, G, bid, 24, 1);
        } else if (sp == 2) {
            g.A = (const bf16_t*)(p.ws + OFF_Q); g.Bt = (const bf16_t*)(p.ws + OFF_WA + WA_AO);
            g.M = Mrows; g.N = DM; g.K = 512; E.f.kind = 3;
            S.init(Mrows, DM, G, bid, 0, 3);
        } else if (sp == 3) {
            g.A = (const bf16_t*)(p.ws + OFF_MERGED); g.Bt = (const bf16_t*)(p.ws + OFF_WA + WA_OUT); g.M = Mrows; g.N = DM; g.K = DM; E.f.kind = 1; E.f.ooff = OFF_G;
            S.init(Mrows, DM, G, bid, 0, 1);
        } else if (sp == 5) {
            g.A = Hb; g.Bt = (const bf16_t*)(p.ws + OFF_WB + WB_GU); g.M = Mrows; g.N = NGU; g.K = DM; E.f.kind = 2;
            S.init(Mrows, NGU, G, bid, 0, 1);
        } else {
            g.A = (const bf16_t*)(p.ws + OFF_G); g.Bt = (const bf16_t*)(p.ws + OFF_WB + WB_DOWN); g.M = Mrows; g.N = DM; g.K = DFF; E.f.kind = 1; E.f.ooff = OFF_F;
            S.init(Mrows, DM, G, bid, 0, 1);
        }
        pg8::gemm_phase<EpiW<EpiAll>, UOrder, true, true>(ldsl, g, S, E);
        return;
    }
    if (sp == 4) {
        NormArgs a{};
        a.xl = (l == 0) ? p.in[I_X] : p.out; a.xc = (l == 0) ? p.in[I_CTX] : XC; a.ol = p.out; a.oc = XC;
        a.y = (const bf16_t*)(p.ws + OFF_G); a.gpost = p.in[I_GPOSTMIX] + l * DM; a.modg = modl; a.gate_idx = 2;
        a.h = Hb; a.gpre = p.in[I_GPREFFN] + l * DM; a.modh = modl; a.shift_idx = 3; a.nrows = Mrows;
        norm_rows(a, NGW);
        convert_WB(p, l, lds, NGW);
        return;
    }
    {
        NormArgs a{};
        a.xl = p.out; a.xc = XC; a.ol = p.out; a.oc = XC;
        a.y = (const bf16_t*)(p.ws + OFF_F); a.gpost = p.in[I_GPOSTFFN] + l * DM; a.modg = modl; a.gate_idx = 5;
        if (!last) { a.h = Hb; a.gpre = p.in[I_GPREMIX] + (l + 1) * DM; a.modh = mod + (size_t)(l + 1) * 9 * 6144; a.shift_idx = 0; }
        a.nrows = Mrows;
        norm_rows(a, NGW);
        if (!last) convert_WA(p, l + 1, lds, NGW);
    }
}

#ifndef PROBE
#define PROBE 0
#endif
#ifndef PROBE_MASK_A
#define PROBE_MASK_A 0u
#endif
#ifndef PROBE_K
#define PROBE_K 2
#endif
#ifndef PROBE_MASK_B
#define PROBE_MASK_B 0u
#endif
constexpr int LDS_MISC = LDS_BYTES - 64;
constexpr size_t CTL_BAR = 262144;
__global__ void __launch_bounds__(NTHREADS) mega(P p) {
    extern __shared__ __attribute__((aligned(16))) unsigned char lds[];
    volatile PG8_LAS unsigned* misc = (volatile PG8_LAS unsigned*)((PG8_LAS unsigned char*)lds + LDS_MISC);
    if (threadIdx.x < 16) misc[threadIdx.x] = 0u;
    __syncthreads();
    XcdBarrier bar = xcd_barrier_post((unsigned*)(p.ws + OFF_CTL + CTL_BAR), misc);
#if PROBE
    unsigned long long* ts = (unsigned long long*)(p.ws + OFF_CTL + 65536);
    if (blockIdx.x == 0 && threadIdx.x == 0) ts[0] = __builtin_amdgcn_s_memrealtime();
#endif
    for (int ph = p.ph_lo; ph < p.ph_hi; ++ph) {
        run_phase(ph, lds);
#if PROBE
        if (ph == p.ph_lo) cg::this_grid().sync(); else xcd_barrier(bar);
        if (blockIdx.x == 0 && threadIdx.x == 0) ts[ph + 1] = __builtin_amdgcn_s_memrealtime();
#else
        if (ph + 1 < p.ph_hi) { if (ph == p.ph_lo) cg::this_grid().sync(); else xcd_barrier(bar); }
#endif
    }
#if PROBE
    if (blockIdx.x == 0 && threadIdx.x == 0) {
        unsigned long long extra = 0;
        for (int ph = 0; ph < NPHASES; ++ph) if ((PROBE_MASK_A >> ph) & 1u) extra += ts[ph + 1] - ts[ph];
        extra *= PROBE_K;
        const unsigned long long t0 = __builtin_amdgcn_s_memrealtime();
        while (__builtin_amdgcn_s_memrealtime() - t0 < extra) __builtin_amdgcn_s_sleep(8);
    }
#endif
}

extern "C" void kernel_launch(void* const* d_in, const int* in_sizes, int n_in, void* d_out, int out_size, void* d_ws, size_t ws_size, hipStream_t stream) {
    static int grid = 0;
    if (grid == 0) {
        if (n_in != 27 || ws_size < WS_NEED) { fprintf(stderr, "kernel_launch: unexpected n_in %d or ws_size %zu\n", n_in, ws_size); grid = -1; return; }
        int dev = 0, cus = 0, per_cu = 0;
        hipGetDevice(&dev);
        hipDeviceGetAttribute(&cus, hipDeviceAttributeMultiprocessorCount, dev);
        hipFuncSetAttribute((const void*)mega, hipFuncAttributeMaxDynamicSharedMemorySize, LDS_BYTES);
        hipOccupancyMaxActiveBlocksPerMultiprocessor(&per_cu, (const void*)mega, NTHREADS, LDS_BYTES);
        if (per_cu < 1) { fprintf(stderr, "kernel_launch: occupancy query says %d blocks per CU\n", per_cu); per_cu = 1; }
        grid = cus;
    }
    if (grid < 0) return;
    hipMemsetAsync((char*)d_ws + OFF_CTL, 0, 1 * MiB, stream);
    P p{};
    for (int i = 0; i < 27; ++i) p.in[i] = (const float*)d_in[i];
    p.out = (float*)d_out; p.ws = (unsigned char*)d_ws;
#if PER_PHASE_LAUNCH
    for (int ph = 0; ph < NPHASES; ++ph) {
        p.ph_lo = ph; p.ph_hi = ph + 1;
        hipLaunchKernelGGL(mega, dim3(grid), dim3(NTHREADS), LDS_BYTES, stream, p);
    }
#else
    p.ph_lo = 0; p.ph_hi = NPHASES;
    void* args[] = {&p};
    hipError_t e = hipLaunchCooperativeKernel((const void*)mega, dim3(grid), dim3(NTHREADS), args, LDS_BYTES, stream);
    if (e != hipSuccess) fprintf(stderr, "cooperative launch failed: %s (grid %d)\n", hipGetErrorString(e), grid);
#endif
}
```

```cpp
#include <hip/hip_runtime.h>
#include <hip/hip_cooperative_groups.h>
#include <cstdio>
#include <cstdint>
namespace cg = cooperative_groups;

#ifndef PER_PHASE_LAUNCH
#define PER_PHASE_LAUNCH 0
#endif

typedef unsigned short bf16_t;
typedef short bf16x8 __attribute__((ext_vector_type(8)));
typedef short s16x4 __attribute__((ext_vector_type(4)));
typedef float f32x4 __attribute__((ext_vector_type(4)));
typedef float f32x16 __attribute__((ext_vector_type(16)));
typedef unsigned u32x4 __attribute__((ext_vector_type(4)));
typedef unsigned u32x2 __attribute__((ext_vector_type(2)));

constexpr int DM = 1024, NBATCH = 8, SEQ = 2048, CTX = 256;
constexpr int ML = NBATCH * SEQ;
constexpr int MC = NBATCH * CTX;
constexpr int MA = ML + MC;
constexpr int INW = 5376, DFF = 2816, NGU = 5632;
constexpr float EPS = 1e-6f;
constexpr float LOG2E = 1.4426950408889634f;
constexpr float QSCALE = 0.125f * LOG2E;
constexpr int NTHREADS = 512, NWAVES = 8;
constexpr int LDS_BYTES = 147456;
constexpr int NPHASES = 20;

constexpr size_t MiB = 1u << 20;
constexpr size_t OFF_CTL = 0;
constexpr size_t OFF_TAB = 1 * MiB;
constexpr size_t OFF_MOD = 1 * MiB + 65536;
constexpr size_t OFF_WA = 2 * MiB;
constexpr size_t WA_IN = 0, WA_AO = 11010048, WA_PO = WA_AO + 1048576, WA_RO = WA_PO + 1048576, WA_OUT = WA_RO + 1048576,
                 WA_PM = WA_OUT + 2097152, WA_LA = WA_PM + 131072, WA_LX = WA_LA + 131072;
constexpr size_t OFF_A = 18 * MiB;
constexpr size_t OFF_Q = 54 * MiB;
constexpr size_t OFF_KV = 72 * MiB;
constexpr size_t OFF_RX = 81 * MiB;
constexpr size_t OFF_PU = 99 * MiB;
constexpr size_t OFF_RY = 117 * MiB;
constexpr size_t OFF_MERGED = OFF_RX;
constexpr size_t OFF_F = OFF_Q;
constexpr size_t OFF_WB = 94 * MiB;
constexpr size_t WB_GU = 0, WB_DOWN = 11534336;
constexpr size_t OFF_G = 135 * MiB;
constexpr size_t OFF_XC = 243 * MiB;
constexpr size_t WS_NEED = 254 * MiB;

struct P {
    const float* in[27];
    float* out;
    unsigned char* ws;
    int ph_lo, ph_hi;
};
enum { I_X = 0, I_C, I_CTX, I_CCTX, I_WADA, I_BADA, I_GPREMIX, I_GPOSTMIX, I_GPREFFN, I_GPOSTFFN, I_WIN, I_SINK, I_WAO, I_PMIX, I_PSCALE, I_WPO,
       I_CONVW, I_CONVB, I_LWA, I_LBA, I_LWX, I_LBX, I_LAM, I_WRO, I_WOUT, I_WGU, I_WDOWN };

__device__ __forceinline__ float bf2f(unsigned v) { return __uint_as_float(v << 16); }
__device__ __forceinline__ unsigned f2bf(float f) { unsigned u = __float_as_uint(f); return (u + 0x7fffu + ((u >> 16) & 1u)) >> 16; }
typedef float f32x2_t __attribute__((ext_vector_type(2)));
typedef __bf16 bf16x2_t __attribute__((ext_vector_type(2)));
__device__ __forceinline__ unsigned pk2(float lo, float hi) { const f32x2_t v = {lo, hi}; const bf16x2_t b = __builtin_convertvector(v, bf16x2_t); return __builtin_bit_cast(unsigned, b); }
__device__ __forceinline__ float wave_sum(float v) {
#pragma unroll
    for (int o = 1; o < 64; o <<= 1) v += __shfl_xor(v, o);
    return v;
}
__device__ __forceinline__ float sigm(float x) { return __builtin_amdgcn_rcpf(1.f + __builtin_amdgcn_exp2f(-LOG2E * x)); }
__device__ __forceinline__ float gelu_tanh(float y) {
    const float z = 0.7978845608028654f * (y + 0.044715f * y * y * y);
    const float t = 1.f - 2.f * __builtin_amdgcn_rcpf(1.f + __builtin_amdgcn_exp2f((2.f * LOG2E) * z));
    return 0.5f * y * (1.f + t);
}
__device__ __forceinline__ int crow(int r, int hi) { return (r & 3) + 8 * (r >> 2) + 4 * hi; }
__device__ __forceinline__ int perm32(int rho) { const int n = rho >> 4, i = rho & 15; return 8 * (i >> 2) + 4 * n + (i & 3); }
#define LDS_WAIT() asm volatile("s_waitcnt lgkmcnt(0)" ::: "memory")
__device__ __forceinline__ int opaque_tid() { int t = threadIdx.x; asm volatile("" : "+v"(t)); return t; }
__device__ __forceinline__ f32x4 unpack4(u32x2 w) { return (f32x4){bf2f(w.x & 0xffffu), bf2f(w.x >> 16), bf2f(w.y & 0xffffu), bf2f(w.y >> 16)}; }
__device__ __forceinline__ void unpack8(u32x4 w, f32x4& a, f32x4& b) {
    a = (f32x4){bf2f(w.x & 0xffffu), bf2f(w.x >> 16), bf2f(w.y & 0xffffu), bf2f(w.y >> 16)};
    b = (f32x4){bf2f(w.z & 0xffffu), bf2f(w.z >> 16), bf2f(w.w & 0xffffu), bf2f(w.w >> 16)};
}
__device__ __forceinline__ u32x4 pack8(f32x4 a, f32x4 b) { u32x4 w; w.x = pk2(a[0], a[1]); w.y = pk2(a[2], a[3]); w.z = pk2(b[0], b[1]); w.w = pk2(b[2], b[3]); return w; }

__constant__ float ROPE_INV[16] = {1.0f, 0.5623413251903491f, 0.31622776601683794f, 0.1778279410038923f, 0.1f, 0.05623413251903491f, 0.03162277660168379f,
                                   0.01778279410038923f, 0.01f, 0.005623413251903491f, 0.003162277660168379f, 0.001778279410038923f, 0.001f,
                                   0.0005623413251903491f, 0.0003162277660168379f, 0.0001778279410038923f};

__device__ __forceinline__ int src_col(int mode, int n) {
    if (mode == 1) {
        if (n >= 640) return n;
        const int p = n & 63, hb = n - p, G = p >> 3, j = p & 7, half = G >> 2, g = G & 3;
        const int dim = half * 32 + ((j < 4) ? (4 * g + j) : (16 + 4 * g + (j - 4)));
        return hb + dim;
    }
    if (mode == 2) {
        const int q = n >> 3, t = n & 7;
        return (t < 4) ? (4 * q + t) : (DFF + 4 * q + (t - 4));
    }
    return n;
}
__device__ __forceinline__ void tr_item(const float* W, int K, int N, int Nout, bf16_t* WT, float* scr, int item, int lane, int mode) {
    const int nblk = Nout / 32, kb = item / nblk, nb = item % nblk, k0 = 64 * kb, n0 = 32 * nb;
    const int sc = src_col(mode, n0 + (lane & 31));
#pragma unroll 8
    for (int i = 0; i < 32; ++i) { const int kk = 2 * i + (lane >> 5); scr[kk * 33 + (lane & 31)] = W[(size_t)(k0 + kk) * N + sc]; }
    LDS_WAIT(); asm volatile("" ::: "memory");
    const int c = lane & 7;
#pragma unroll
    for (int j = 0; j < 4; ++j) {
        const int n = (lane >> 3) + 8 * j; const float* s = scr + (8 * c) * 33 + n;
        u32x4 o; o.x = pk2(s[0 * 33], s[1 * 33]); o.y = pk2(s[2 * 33], s[3 * 33]); o.z = pk2(s[4 * 33], s[5 * 33]); o.w = pk2(s[6 * 33], s[7 * 33]);
        *(u32x4*)(WT + (size_t)(n0 + n) * K + k0 + 8 * c) = o;
    }
    LDS_WAIT(); asm volatile("" ::: "memory");
}
constexpr int WA_ITEMS = 2688 + 3 * 256 + 512 + 32 + 32 + 32;
constexpr int WB_ITEMS = 2816 + 1408;
__device__ __forceinline__ void convert_WA(const P& p, int l, unsigned char* lds, int NGW) {
    const int tid_ = opaque_tid(), lane = tid_ & 63, gw = blockIdx.x * NWAVES + (tid_ >> 6);
    float* scr = (float*)(lds + (tid_ >> 6) * 16384);
    unsigned char* wa = p.ws + OFF_WA;
    for (int it = gw; it < WA_ITEMS; it += NGW) {
        int r = it;
        if (r < 2688) { tr_item(p.in[I_WIN] + (size_t)l * DM * INW, DM, INW, INW, (bf16_t*)(wa + WA_IN), scr, r, lane, 1); continue; } r -= 2688;
        if (r < 256) { tr_item(p.in[I_WAO] + (size_t)l * 512 * DM, 512, DM, DM, (bf16_t*)(wa + WA_AO), scr, r, lane, 0); continue; } r -= 256;
        if (r < 256) { tr_item(p.in[I_WPO] + (size_t)l * 512 * DM, 512, DM, DM, (bf16_t*)(wa + WA_PO), scr, r, lane, 0); continue; } r -= 256;
        if (r < 256) { tr_item(p.in[I_WRO] + (size_t)l * 512 * DM, 512, DM, DM, (bf16_t*)(wa + WA_RO), scr, r, lane, 0); continue; } r -= 256;
        if (r < 512) { tr_item(p.in[I_WOUT] + (size_t)l * DM * DM, DM, DM, DM, (bf16_t*)(wa + WA_OUT), scr, r, lane, 0); continue; } r -= 512;
        if (r < 32) { const int g = r >> 3; tr_item(p.in[I_PMIX] + (size_t)(l * 4 + g) * 16384, 128, 128, 128, (bf16_t*)(wa + WA_PM) + g * 16384, scr, r & 7, lane, 0); continue; } r -= 32;
        if (r < 32) { const int m = r >> 1; tr_item(p.in[I_LWA] + (size_t)(l * 16 + m) * 4096, 64, 64, 64, (bf16_t*)(wa + WA_LA) + m * 4096, scr, r & 1, lane, 0); continue; } r -= 32;
        { const int m = r >> 1; tr_item(p.in[I_LWX] + (size_t)(l * 16 + m) * 4096, 64, 64, 64, (bf16_t*)(wa + WA_LX) + m * 4096, scr, r & 1, lane, 0); }
    }
}
__device__ __forceinline__ void convert_WB(const P& p, int l, unsigned char* lds, int NGW) {
    const int tid_ = opaque_tid(), lane = tid_ & 63, gw = blockIdx.x * NWAVES + (tid_ >> 6);
    float* scr = (float*)(lds + (tid_ >> 6) * 16384);
    unsigned char* wb = p.ws + OFF_WB;
    for (int it = gw; it < WB_ITEMS; it += NGW) {
        int r = it;
        if (r < 2816) { tr_item(p.in[I_WGU] + (size_t)l * DM * NGU, DM, NGU, NGU, (bf16_t*)(wb + WB_GU), scr, r, lane, 2); continue; } r -= 2816;
        tr_item(p.in[I_WDOWN] + (size_t)l * DFF * DM, DFF, DM, DM, (bf16_t*)(wb + WB_DOWN), scr, r, lane, 0);
    }
}

__device__ __forceinline__ void mod_item(const P& p, unsigned char* lds, int item) {
    const int tid = opaque_tid(), lane = tid & 63, wave = tid >> 6;
    const int l = item / 96, cgp = item % 96;
    float* sc = (float*)lds;
    float* red = (float*)(lds + 36864);
    for (int idx = tid; idx < 9 * 1024; idx += NTHREADS) {
        const int r = idx >> 10, k = idx & 1023;
        const float v = (r < 8) ? p.in[I_C][r * 1024 + k] : p.in[I_CCTX][k];
        sc[idx] = v / (1.f + __expf(-v));
    }
    __syncthreads();
    float acc[9];
#pragma unroll
    for (int r = 0; r < 9; ++r) acc[r] = 0.f;
    const float* wp = p.in[I_WADA] + (size_t)l * 1024 * 6144 + cgp * 64 + lane;
    const int kbeg = wave * 128;
#pragma unroll 1
    for (int k0 = kbeg; k0 < kbeg + 128; k0 += 32) {
        float w[32];
#pragma unroll
        for (int i = 0; i < 32; ++i) w[i] = wp[(size_t)(k0 + i) * 6144];
#pragma unroll
        for (int i = 0; i < 32; ++i)
#pragma unroll
            for (int r = 0; r < 9; ++r) acc[r] += sc[r * 1024 + k0 + i] * w[i];
    }
#pragma unroll
    for (int r = 0; r < 9; ++r) red[(wave * 9 + r) * 64 + lane] = acc[r];
    __syncthreads();
    float* mod = (float*)(p.ws + OFF_MOD);
    for (int idx = tid; idx < 9 * 64; idx += NTHREADS) {
        const int r = idx >> 6, ln = idx & 63;
        float s = 0.f;
#pragma unroll
        for (int w = 0; w < 8; ++w) s += red[(w * 9 + r) * 64 + ln];
        const int j = cgp * 64 + ln;
        mod[(size_t)(l * 9 + r) * 6144 + j] = s + p.in[I_BADA][l * 6144 + j];
    }
    __syncthreads();
}
__device__ __forceinline__ void table_item(const P& p) {
    float* tc = (float*)(p.ws + OFF_TAB); float* ts = tc + 1024;
    for (int idx = opaque_tid(); idx < 1024; idx += NTHREADS) {
        const int pos = idx >> 4, i = idx & 15;
        const float ang = (float)pos * ROPE_INV[i];
        const double x = (double)ang;
        const double n = rint(x * 0.6366197723675814);
        const double r = x - n * 1.5707963267948966;
        const double r2 = r * r;
        const double sr = r * (1.0 - r2 / 6.0 * (1.0 - r2 / 20.0 * (1.0 - r2 / 42.0 * (1.0 - r2 / 72.0 * (1.0 - r2 / 110.0 * (1.0 - r2 / 156.0))))));
        const double cr = 1.0 - r2 / 2.0 * (1.0 - r2 / 12.0 * (1.0 - r2 / 30.0 * (1.0 - r2 / 56.0 * (1.0 - r2 / 90.0 * (1.0 - r2 / 132.0 * (1.0 - r2 / 182.0))))));
        const int q = ((int)n) & 3;
        double s, c;
        if (q == 0) { s = sr; c = cr; } else if (q == 1) { s = cr; c = -sr; } else if (q == 2) { s = -sr; c = -cr; } else { s = -cr; c = sr; }
        tc[idx] = (float)c; ts[idx] = (float)s;
    }
}

struct NormArgs {
    const float* xl; const float* xc;
    float* ol; float* oc;
    const bf16_t* y;
    const float* gpost; const float* modg; int gate_idx;
    bf16_t* h; const float* gpre; const float* modh; int shift_idx;
    int nrows;
};
__device__ __forceinline__ void norm_rows(const NormArgs& a, int NGW) {
    const int tid_ = opaque_tid(), lane = tid_ & 63, gw = blockIdx.x * NWAVES + (tid_ >> 6);
    const int per = (a.nrows + NGW - 1) / NGW, r_beg = gw * per, r_end = min(r_beg + per, a.nrows);
    if (r_beg >= r_end) return;
    f32x4 gpo[4], gpr[4], gt[4], sh[4], scl[4];
#pragma unroll
    for (int j = 0; j < 4; ++j) {
        const int col = 4 * lane + 256 * j;
        gpo[j] = a.y ? *(const f32x4*)(a.gpost + col) : (f32x4){0.f, 0.f, 0.f, 0.f};
        gpr[j] = a.h ? *(const f32x4*)(a.gpre + col) : (f32x4){0.f, 0.f, 0.f, 0.f};
        gt[j] = (f32x4){0.f, 0.f, 0.f, 0.f}; sh[j] = gt[j]; scl[j] = gt[j];
    }
    int cur_m = -1;
    f32x4 xv[4]; u32x2 yv[4];
    {
        const int r = r_beg; const float* xin = (r < ML) ? a.xl + (size_t)r * DM : a.xc + (size_t)(r - ML) * DM;
#pragma unroll
        for (int j = 0; j < 4; ++j) { xv[j] = *(const f32x4*)(xin + 4 * lane + 256 * j); yv[j] = a.y ? *(const u32x2*)(a.y + (size_t)r * DM + 4 * lane + 256 * j) : (u32x2){0u, 0u}; }
    }
#pragma unroll 1
    for (int r = r_beg; r < r_end; ++r) {
        const bool isl = r < ML;
        const int mrow = isl ? (r >> 11) : 8;
        f32x4 xn[4]; u32x2 yn[4];
        if (r + 1 < r_end) {
            const int rn = r + 1; const float* xin = (rn < ML) ? a.xl + (size_t)rn * DM : a.xc + (size_t)(rn - ML) * DM;
#pragma unroll
            for (int j = 0; j < 4; ++j) { xn[j] = *(const f32x4*)(xin + 4 * lane + 256 * j); yn[j] = a.y ? *(const u32x2*)(a.y + (size_t)rn * DM + 4 * lane + 256 * j) : (u32x2){0u, 0u}; }
        } else {
#pragma unroll
            for (int j = 0; j < 4; ++j) { xn[j] = (f32x4){0.f, 0.f, 0.f, 0.f}; yn[j] = (u32x2){0u, 0u}; }
        }
        if (mrow != cur_m) {
            cur_m = mrow;
#pragma unroll
            for (int j = 0; j < 4; ++j) {
                const int col = 4 * lane + 256 * j;
                if (a.y) gt[j] = *(const f32x4*)(a.modg + (size_t)mrow * 6144 + a.gate_idx * 1024 + col);
                if (a.h) { sh[j] = *(const f32x4*)(a.modh + (size_t)mrow * 6144 + a.shift_idx * 1024 + col); scl[j] = *(const f32x4*)(a.modh + (size_t)mrow * 6144 + (a.shift_idx + 1) * 1024 + col) + 1.f; }
            }
        }
        f32x4 v[4];
#pragma unroll
        for (int j = 0; j < 4; ++j) v[j] = xv[j];
        if (a.y) {
            f32x4 yf[4]; float ss = 0.f;
#pragma unroll
            for (int j = 0; j < 4; ++j) { yf[j] = unpack4(yv[j]); ss += (yf[j][0] * yf[j][0] + yf[j][1] * yf[j][1]) + (yf[j][2] * yf[j][2] + yf[j][3] * yf[j][3]); }
            const float rstd = rsqrtf(wave_sum(ss) * (1.f / DM) + EPS);
#pragma unroll
            for (int j = 0; j < 4; ++j) v[j] = v[j] + gt[j] * ((yf[j] * rstd) * gpo[j]);
            float* xo = isl ? (a.ol ? a.ol + (size_t)r * DM : nullptr) : (a.oc ? a.oc + (size_t)(r - ML) * DM : nullptr);
            if (xo) {
#pragma unroll
                for (int j = 0; j < 4; ++j) *(f32x4*)(xo + 4 * lane + 256 * j) = v[j];
            }
        }
        if (a.h) {
            float ss = 0.f;
#pragma unroll
            for (int j = 0; j < 4; ++j) ss += (v[j][0] * v[j][0] + v[j][1] * v[j][1]) + (v[j][2] * v[j][2] + v[j][3] * v[j][3]);
            const float rstd = rsqrtf(wave_sum(ss) * (1.f / DM) + EPS);
#pragma unroll
            for (int j = 0; j < 4; ++j) {
                const f32x4 hv = ((v[j] * rstd) * gpr[j]) * scl[j] + sh[j];
                u32x2 w; w.x = pk2(hv[0], hv[1]); w.y = pk2(hv[2], hv[3]);
                *(u32x2*)(a.h + (size_t)r * DM + 4 * lane + 256 * j) = w;
            }
        }
#pragma unroll
        for (int j = 0; j < 4; ++j) { xv[j] = xn[j]; yv[j] = yn[j]; }
    }
}

namespace pg8 {
#define PG8_LAS __attribute__((address_space(3)))
typedef unsigned short bf16_t;
typedef short bf16x8 __attribute__((ext_vector_type(8)));
typedef float f32x4 __attribute__((ext_vector_type(4)));
typedef unsigned u32x4 __attribute__((ext_vector_type(4)));
constexpr int BM = 256, BK = 64, HALF = 128, HTB = HALF * BK * 2  , STAGE_BYTES = 8 * HTB, NXCD = 8, WGM = 8;

__host__ __device__ __forceinline__ int lds_byte(int r, int c) { const int st = (r >> 4) * 2 + (c >> 5), rr = r & 15, cc = c & 31, ob = rr * 64 + cc * 2; return st * 1024 + (ob ^ (((ob >> 9) & 1) << 5)); }
__host__ __device__ __forceinline__ void stage_rc(int b, int& R, int& C) { const int st = b / 1024, sb = b % 1024, swz = sb ^ (((sb >> 9) & 1) << 5); R = (st >> 1) * 16 + swz / 64; C = (st & 1) * 32 + (swz % 64) / 2; }
__host__ __device__ __forceinline__ int perm32(int rho) { const int n = rho >> 4, i = rho & 15; return 8 * (i >> 2) + 4 * n + (i & 3); }

struct Unit { int pm, pn, s; };
struct Gemm { const bf16_t* A; const bf16_t* Bt; int M, N, K;
    __device__ __forceinline__ const char* a(int s_) const { return (const char*)A + (long long)s_ * ((long long)OFF_A - (long long)OFF_Q) + (long long)((s_ * (s_ - 1)) >> 1) * ((long long)OFF_RY + (long long)OFF_Q - 2 * (long long)OFF_A); }
    __device__ __forceinline__ const char* b(int s_) const { return (const char*)Bt + (long long)s_ * 1048576ll; } };

struct StaticOrder {
    int nM, nN, nwg, G, c;
    __host__ __device__ void init(int M, int N, int G_, int c_) { nM = M / BM; nN = N / BM; nwg = nM * nN; G = G_; c = c_; }
    __host__ __device__ bool next(int i, Unit& u) const {
        const long L = (long)i * G + c; if (L >= nwg) return false;
        int wgid = (int)L; { const int q = nwg / NXCD, r = nwg % NXCD, xcd = wgid % NXCD, off = wgid / NXCD; wgid = (xcd < r ? xcd * (q + 1) : r * (q + 1) + (xcd - r) * q) + off; }
        const int nig = WGM * nN, gid = wgid / nig, fm = gid * WGM, gsz = (nM - fm) < WGM ? (nM - fm) : WGM;
        u.pm = fm + ((wgid % nig) % gsz); u.pn = (wgid % nig) / gsz; u.s = 0; return true;
    }
    __device__ __forceinline__ void a_ready(const Unit&) const {}
    __device__ __forceinline__ void done(const Unit&) const {}
};


template <class Epi, class Sched, bool ALIGN_EPI = false, bool SP2 = false>
__device__ __forceinline__ void gemm_phase(PG8_LAS unsigned char* lds, const Gemm g, const Sched& S, const Epi& E) {
    const int tid = opaque_tid(), wid = __builtin_amdgcn_readfirstlane(tid >> 6), lane = tid & 63, wr = wid >> 2, wc = wid & 3, fr = lane & 15, fq = lane >> 4;
    const int K = g.K, nt = K / BK;
    unsigned voffA[2], voffB[2];
#pragma unroll
    for (int i = 0; i < 2; ++i) { int R, C; stage_rc(tid * 16 + i * 8192, R, C); const int Rb = Epi::PERM ? ((R & ~31) + perm32(R & 31)) : R;
        voffA[i] = (unsigned)(R * K + C) * 2u; voffB[i] = (unsigned)(Rb * K + C) * 2u; }
    const size_t kstep = (size_t)(BK * 2);
    const size_t hstep = (size_t)HALF * K * 2;
    const size_t tstep = 2 * hstep;
    const unsigned ldsw = (unsigned)wid * 1024u;
    const int aoff = lds_byte(wr * 64 + fr, fq * 8), boff = lds_byte(wc * 32 + fr, fq * 8);
#define PG8_SA(b, h) (((b) * 2 + (h)) * HTB)
#define PG8_SB(b, h) ((4 + (b) * 2 + (h)) * HTB)
#define PG8_STAGE(bufoff, gbase, voff) do { _Pragma("unroll") for (int _i = 0; _i < 2; ++_i) \
        __builtin_amdgcn_global_load_lds((const unsigned*)((const char*)(gbase) + (voff)[_i]), (PG8_LAS unsigned*)(lds + (bufoff) + ldsw + _i * 8192), 16, 0, 0); } while (0)
#define PG8_LDA(dst, b, h) do { _Pragma("unroll") for (int m = 0; m < 4; ++m) _Pragma("unroll") for (int k = 0; k < 2; ++k) dst[m][k] = *(const PG8_LAS bf16x8*)(lds + PG8_SA(b, h) + aoff + m * 2048 + k * 1024); } while (0)
#define PG8_LDB(dst, b, h) do { _Pragma("unroll") for (int n = 0; n < 2; ++n) _Pragma("unroll") for (int k = 0; k < 2; ++k) dst[n][k] = *(const PG8_LAS bf16x8*)(lds + PG8_SB(b, h) + boff + n * 2048 + k * 1024); } while (0)
#define PG8_MMA(ai, bj, At, Bt) do { __builtin_amdgcn_s_setprio(1); _Pragma("unroll") for (int m = 0; m < 4; ++m) _Pragma("unroll") for (int n = 0; n < 2; ++n) _Pragma("unroll") for (int k = 0; k < 2; ++k) \
        acc[ai][bj][m][n] = __builtin_amdgcn_mfma_f32_16x16x32_bf16(Bt[n][k], At[m][k], acc[ai][bj][m][n], 0, 0, 0); __builtin_amdgcn_s_setprio(0); } while (0)
#define PG8_WAIT_V(n) asm volatile("s_waitcnt vmcnt(" #n ")" ::: "memory")
#define PG8_WAIT_L(n) asm volatile("s_waitcnt lgkmcnt(" #n ")" ::: "memory")
#define PG8_BAR __builtin_amdgcn_s_barrier()
#define PG8_SCHED __builtin_amdgcn_sched_barrier(0)
    Unit cur, nxt; int ui = 0;
    if (!S.next(0, cur)) return;
    f32x4 acc[2][2][4][2];
#pragma unroll
    for (int a = 0; a < 2; ++a)
#pragma unroll
        for (int b = 0; b < 2; ++b)
#pragma unroll
            for (int m = 0; m < 4; ++m)
#pragma unroll
                for (int n = 0; n < 2; ++n) acc[a][b][m][n] = (f32x4){0.f, 0.f, 0.f, 0.f};
    bf16x8 At[4][2], B0[2][2], B1[2][2];
    const char* cA = g.a(cur.s) + (size_t)cur.pm * tstep; const char* cB = g.b(cur.s) + (size_t)cur.pn * tstep;
    S.a_ready(cur);
    if constexpr (SP2) {
        PG8_STAGE(PG8_SB(0, 0), cB, voffB); PG8_STAGE(PG8_SB(0, 1), cB + hstep, voffB); PG8_STAGE(PG8_SA(0, 0), cA, voffA); PG8_STAGE(PG8_SA(0, 1), cA + hstep, voffA);
        if (wr == 1) PG8_BAR;
        PG8_WAIT_V(2); PG8_BAR;
        PG8_STAGE(PG8_SB(1, 0), cB + kstep, voffB); PG8_STAGE(PG8_SA(1, 0), cA + kstep, voffA); PG8_STAGE(PG8_SB(1, 1), cB + hstep + kstep, voffB);
        PG8_WAIT_V(6); PG8_BAR;
    } else {
        PG8_STAGE(PG8_SB(0, 0), cB, voffB); PG8_STAGE(PG8_SA(0, 0), cA, voffA); PG8_STAGE(PG8_SB(0, 1), cB + hstep, voffB); PG8_STAGE(PG8_SA(0, 1), cA + hstep, voffA);
        if (wr == 1) PG8_BAR;
        PG8_WAIT_V(4); PG8_BAR;
        PG8_STAGE(PG8_SB(1, 0), cB + kstep, voffB); PG8_STAGE(PG8_SA(1, 0), cA + kstep, voffA); PG8_STAGE(PG8_SB(1, 1), cB + hstep + kstep, voffB);
        PG8_WAIT_V(6); PG8_BAR;
    }
    for (;;) {
        const bool has_next = S.next(ui + 1, nxt);
        const char* nA = has_next ? g.a(nxt.s) + (size_t)nxt.pm * tstep : cA; const char* nB = has_next ? g.b(nxt.s) + (size_t)nxt.pn * tstep : cB;
        for (int t = 0; t < nt; t += 2) {
            const bool last = (t == nt - 2);
            const char* a1 = cA + (size_t)(t + 1) * kstep;
            const char* a2 = last ? nA : cA + (size_t)(t + 2) * kstep; const char* b2 = last ? nB : cB + (size_t)(t + 2) * kstep;
            const char* a3 = a2 + kstep; const char* b3 = b2 + kstep;
            if (last && has_next) S.a_ready(nxt);
            if constexpr (SP2) {
            PG8_LDB(B0, 0, 0); PG8_LDB(B1, 0, 1); PG8_SCHED; PG8_LDA(At, 0, 0); PG8_STAGE(PG8_SA(1, 1), a1 + hstep, voffA);
            PG8_WAIT_V(8); PG8_WAIT_L(0); PG8_BAR; PG8_MMA(0, 0, At, B0); PG8_MMA(0, 1, At, B1); PG8_BAR; PG8_SCHED;
            PG8_LDA(At, 0, 1); PG8_STAGE(PG8_SB(0, 0), b2, voffB); PG8_STAGE(PG8_SB(0, 1), b2 + hstep, voffB); PG8_STAGE(PG8_SA(0, 0), a2, voffA);
            PG8_WAIT_V(8); PG8_WAIT_L(0); PG8_BAR; PG8_MMA(1, 0, At, B0); PG8_MMA(1, 1, At, B1); PG8_BAR; PG8_SCHED;
            PG8_LDB(B0, 1, 0); PG8_LDB(B1, 1, 1); PG8_SCHED; PG8_LDA(At, 1, 0); PG8_STAGE(PG8_SA(0, 1), a2 + hstep, voffA);
            PG8_WAIT_V(8); PG8_WAIT_L(0); PG8_BAR; PG8_MMA(0, 0, At, B0); PG8_MMA(0, 1, At, B1); PG8_BAR; PG8_SCHED;
            PG8_LDA(At, 1, 1); PG8_STAGE(PG8_SB(1, 0), b3, voffB); PG8_STAGE(PG8_SB(1, 1), b3 + hstep, voffB); PG8_STAGE(PG8_SA(1, 0), a3, voffA);
            PG8_WAIT_V(8); PG8_WAIT_L(0); PG8_BAR; PG8_MMA(1, 0, At, B0); PG8_MMA(1, 1, At, B1); PG8_BAR; PG8_SCHED;
            } else {
            PG8_LDB(B0, 0, 0); PG8_SCHED; PG8_LDA(At, 0, 0); PG8_STAGE(PG8_SA(1, 1), a1 + hstep, voffA);
            PG8_WAIT_L(8); PG8_BAR; PG8_WAIT_L(0); PG8_MMA(0, 0, At, B0); PG8_BAR; PG8_SCHED;
            PG8_LDB(B1, 0, 1); PG8_STAGE(PG8_SB(0, 0), b2, voffB);
            PG8_BAR; PG8_WAIT_L(0); PG8_MMA(0, 1, At, B1); PG8_BAR;
            PG8_LDA(At, 0, 1); PG8_STAGE(PG8_SA(0, 0), a2, voffA);
            PG8_BAR; PG8_WAIT_L(0); PG8_MMA(1, 0, At, B0); PG8_BAR; PG8_SCHED;
            PG8_STAGE(PG8_SB(0, 1), b2 + hstep, voffB);
            PG8_WAIT_V(6); PG8_BAR; PG8_MMA(1, 1, At, B1); PG8_BAR;
            PG8_LDB(B0, 1, 0); PG8_SCHED; PG8_LDA(At, 1, 0); PG8_STAGE(PG8_SA(0, 1), a2 + hstep, voffA);
            PG8_WAIT_L(8); PG8_BAR; PG8_WAIT_L(0); PG8_MMA(0, 0, At, B0); PG8_BAR; PG8_SCHED;
            PG8_LDB(B1, 1, 1); PG8_STAGE(PG8_SB(1, 0), b3, voffB);
            PG8_BAR; PG8_WAIT_L(0); PG8_MMA(0, 1, At, B1); PG8_BAR;
            PG8_LDA(At, 1, 1); PG8_STAGE(PG8_SA(1, 0), a3, voffA);
            PG8_BAR; PG8_WAIT_L(0); PG8_MMA(1, 0, At, B0); PG8_BAR; PG8_SCHED;
            PG8_STAGE(PG8_SB(1, 1), b3 + hstep, voffB);
            PG8_WAIT_V(6); PG8_BAR; PG8_MMA(1, 1, At, B1); PG8_BAR;
            }
        }
        if constexpr (ALIGN_EPI) { if (wr == 0) PG8_BAR; }
        if constexpr (!Epi::AFTER_DRAIN) { E(acc, cur, wr, wc, fr, fq); S.done(cur); }
        if (!has_next) break;
        if (S.last_sub(cur)) {
#pragma unroll
        for (int a = 0; a < 2; ++a)
#pragma unroll
            for (int b = 0; b < 2; ++b)
#pragma unroll
                for (int m = 0; m < 4; ++m)
#pragma unroll
                    for (int n = 0; n < 2; ++n) acc[a][b][m][n] = (f32x4){0.f, 0.f, 0.f, 0.f};
        }
        cur = nxt; cA = nA; cB = nB; ++ui;
        if constexpr (ALIGN_EPI) { if (wr == 1) PG8_BAR; }
    }
    PG8_WAIT_V(0);
    if constexpr (!ALIGN_EPI) { if (wr == 0) PG8_BAR; }
    PG8_BAR;
    if constexpr (Epi::AFTER_DRAIN) { E.fused(acc, cur, wr, wc, fr, fq, lds, wid, lane); S.done(cur); }
#undef PG8_SA
#undef PG8_SB
#undef PG8_STAGE
#undef PG8_LDA
#undef PG8_LDB
#undef PG8_MMA
#undef PG8_WAIT_V
#undef PG8_WAIT_L
#undef PG8_BAR
#undef PG8_SCHED
}
}

struct EpiIn {
    bf16_t *Q, *KV, *RX, *PU, *RY, *G; const float* tcos; const float* tsin;
    __device__ __forceinline__ void operator()(int row, int c8, f32x4 v0, f32x4 v1) const {
        if (c8 < 640) {
            if (row < ML) {
                const int s = row & 2047, pp = c8 & 63, Gq = pp >> 3;
                const int pos = (Gq & 4) ? (s & 63) : (s >> 6);
                const int i0 = (Gq & 3) * 4;
                const f32x4 cs = *(const f32x4*)(tcos + pos * 16 + i0), sn = *(const f32x4*)(tsin + pos * 16 + i0);
                const f32x4 a = v0 * cs - v1 * sn, b = v1 * cs + v0 * sn; v0 = a; v1 = b;
            }
            if (c8 < 512) { v0 = v0 * QSCALE; v1 = v1 * QSCALE; *(u32x4*)(Q + (size_t)row * 512 + c8) = pack8(v0, v1); }
            else *(u32x4*)(KV + (size_t)row * 256 + (c8 - 512)) = pack8(v0, v1);
        } else if (c8 < 768) *(u32x4*)(KV + (size_t)row * 256 + 128 + (c8 - 640)) = pack8(v0, v1);
        else if (c8 < 1280) *(u32x4*)(RX + (size_t)row * 512 + (c8 - 768)) = pack8(v0, v1);
        else if (c8 < 1792) *(u32x4*)(RY + (size_t)row * 512 + (c8 - 1280)) = pack8(v0, v1);
        else if (c8 < 2304) *(u32x4*)(PU + (size_t)row * 512 + (c8 - 1792)) = pack8(v0, v1);
        else {
#pragma unroll
            for (int j = 0; j < 4; ++j) { v0[j] = sigm(v0[j]); v1[j] = sigm(v1[j]); }
            *(u32x4*)(G + (size_t)row * 3072 + (c8 - 2304)) = pack8(v0, v1);
        }
    }
};
struct EpiStore {
    bf16_t* O; int ldc;
    __device__ __forceinline__ void operator()(int row, int c8, f32x4 v0, f32x4 v1) const { *(u32x4*)(O + (size_t)row * ldc + c8) = pack8(v0, v1); }
};
struct EpiSwiglu {
    bf16_t* O;
    __device__ __forceinline__ void operator()(int row, int c8, f32x4 v0, f32x4 v1) const {
        f32x4 o;
#pragma unroll
        for (int j = 0; j < 4; ++j) o[j] = v0[j] * sigm(v0[j]) * v1[j];
        u32x2 w; w.x = pk2(o[0], o[1]); w.y = pk2(o[2], o[3]);
        *(u32x2*)(O + (size_t)row * DFF + (c8 >> 1)) = w;
    }
};

template <class F> struct EpiW {
    static constexpr bool PERM = true, AFTER_DRAIN = false;
    F f;
    __device__ __forceinline__ void operator()(pg8::f32x4 (&acc)[2][2][4][2], const pg8::Unit& u, int wr, int wc, int fr, int fq) const {
        const int row0 = u.pm * 256 + wr * 64 + fr, col0 = u.pn * 256 + wc * 32 + 8 * fq;
#pragma unroll
        for (int ai = 0; ai < 2; ++ai)
#pragma unroll
            for (int m = 0; m < 4; ++m)
#pragma unroll
                for (int bj = 0; bj < 2; ++bj) f(row0 + ai * 128 + m * 16, col0 + bj * 128, acc[ai][bj][m][0], acc[ai][bj][m][1], u.s);
    }
};
struct EpiAll {
    int kind; unsigned char* ws; size_t ooff;
    __device__ __forceinline__ void operator()(int row, int c8, f32x4& v0, f32x4& v1, int sub) const {
        if (kind == 0) {
            EpiIn e{(bf16_t*)(ws + OFF_Q), (bf16_t*)(ws + OFF_KV), (bf16_t*)(ws + OFF_RX), (bf16_t*)(ws + OFF_PU), (bf16_t*)(ws + OFF_RY), (bf16_t*)(ws + OFF_G),
                    (const float*)(ws + OFF_TAB), (const float*)(ws + OFF_TAB) + 1024};
            e(row, c8, v0, v1);
        } else if (kind == 1) {
            *(u32x4*)((bf16_t*)(ws + ooff) + (size_t)row * DM + c8) = pack8(v0, v1);
        } else if (kind == 2) {
            EpiSwiglu e{(bf16_t*)(ws + OFF_G)};
            e(row, c8, v0, v1);
        } else {
            const bf16_t* gp = (const bf16_t*)(ws + OFF_G) + (size_t)row * 3072 + sub * 1024 + c8;
            f32x4 a0, a1; unpack8(*(const u32x4*)gp, a0, a1);
            if (sub < 2) {
                f32x4 b0, b1; unpack8(*(const u32x4*)(gp + 1024), b0, b1);
#pragma unroll
                for (int j = 0; j < 4; ++j) { v0[j] *= a0[j] * __builtin_amdgcn_rcpf(fmaxf(b0[j], 1e-30f)); v1[j] *= a1[j] * __builtin_amdgcn_rcpf(fmaxf(b1[j], 1e-30f)); }
            } else {
                *(u32x4*)((bf16_t*)(ws + OFF_MERGED) + (size_t)row * DM + c8) = pack8(v0 * a0, v1 * a1);
            }
        }
    }
};
struct UOrder {
    pg8::StaticOrder so; int extra, subs;
    __device__ void init(int M, int N, int G, int c, int extra_, int subs_) { so.init(M, N, G, c); extra = extra_; subs = subs_; }
    __device__ bool next(int i, pg8::Unit& u) const {
        int ti = i, sub = 0;
        if (subs == 3) { ti = i / 3; sub = i - 3 * ti; }
        const long L = (long)ti * so.G + so.c;
        if (L < so.nwg) { const bool ok = so.next(ti, u); u.s = sub; return ok; }
        const int r = (int)(L - so.nwg); if (r >= extra) return false;
        u.pm = 64 + (r & 7); u.pn = 2 + (r >> 3); u.s = 0; return true;
    }
    __device__ __forceinline__ bool last_sub(const pg8::Unit& u) const { return u.s + 1 == subs; }
    __device__ __forceinline__ void a_ready(const pg8::Unit&) const {}
    __device__ __forceinline__ void done(const pg8::Unit&) const {}
};
__device__ __forceinline__ void gemm_wave_acc(const bf16_t* A, const bf16_t* Bt, int K, int rw, int cw, int fr, int fq, f32x4 (&acc)[4][4]) {
    const bf16_t* ap[4]; const bf16_t* bp[4];
#pragma unroll
    for (int i = 0; i < 4; ++i) ap[i] = A + (size_t)(rw + 16 * i + fr) * K + 8 * fq;
#pragma unroll
    for (int q = 0; q < 4; ++q) bp[q] = Bt + (size_t)(cw + 32 * (q >> 1) + perm32(16 * (q & 1) + fr)) * K + 8 * fq;
#pragma unroll 2
    for (int k = 0; k < K; k += 32) {
        bf16x8 af[4], bfr[4];
#pragma unroll
        for (int i = 0; i < 4; ++i) af[i] = *(const bf16x8*)(ap[i] + k);
#pragma unroll
        for (int q = 0; q < 4; ++q) bfr[q] = *(const bf16x8*)(bp[q] + k);
#pragma unroll
        for (int i = 0; i < 4; ++i)
#pragma unroll
            for (int q = 0; q < 4; ++q) acc[i][q] = __builtin_amdgcn_mfma_f32_16x16x32_bf16(bfr[q], af[i], acc[i][q], 0, 0, 0);
    }
}
template <class Epi>
__device__ __forceinline__ void gemm_simple(const bf16_t* A, const bf16_t* Bt, int K, int row_off, int M, int col_off, int N, const Epi& epi, int bid, int G) {
    const int tid = opaque_tid(), lane = tid & 63, wave = tid >> 6, wr = wave >> 2, wc = wave & 3, fr = lane & 15, fq = lane >> 4;
    const int nM = M / 128, nN = N / 256;
    for (int u = bid; u < nM * nN; u += G) {
        const int pm = u % nM, pn = u / nM;
        const int rw = row_off + pm * 128 + wr * 64, cw = col_off + pn * 256 + wc * 64;
        f32x4 acc[4][4];
#pragma unroll
        for (int i = 0; i < 4; ++i)
#pragma unroll
            for (int q = 0; q < 4; ++q) acc[i][q] = (f32x4){0.f, 0.f, 0.f, 0.f};
        gemm_wave_acc(A, Bt, K, rw, cw, fr, fq, acc);
#pragma unroll
        for (int i = 0; i < 4; ++i)
#pragma unroll
            for (int g = 0; g < 2; ++g) epi(rw + 16 * i + fr, cw + 32 * g + 8 * fq, acc[i][2 * g], acc[i][2 * g + 1]);
    }
}
__device__ __forceinline__ void gemm_merge(const P& p, int M, int bid, int G) {
    const int tid = opaque_tid(), lane = tid & 63, wave = tid >> 6, wr = wave >> 2, wc = wave & 3, fr = lane & 15, fq = lane >> 4;
    const bf16_t* Gt = (const bf16_t*)(p.ws + OFF_G);
    bf16_t* O = (bf16_t*)(p.ws + OFF_MERGED);
    const int nM = M / 128, nN = 8;
    for (int u = bid; u < nM * nN; u += G) {
        const int pm = u % nM, pn = u / nM;
        const int rw = pm * 128 + wr * 64, cw = pn * 128 + wc * 32;
        f32x4 tot[4][2];
#pragma unroll
        for (int i = 0; i < 4; ++i) { tot[i][0] = (f32x4){0.f, 0.f, 0.f, 0.f}; tot[i][1] = (f32x4){0.f, 0.f, 0.f, 0.f}; }
#pragma unroll 1
        for (int s = 0; s < 3; ++s) {
            const bf16_t* A = (const bf16_t*)(p.ws + (s == 0 ? OFF_Q : (s == 1 ? OFF_A : OFF_RY)));
            const bf16_t* Bt = (const bf16_t*)(p.ws + OFF_WA + (s == 0 ? WA_AO : (s == 1 ? WA_PO : WA_RO)));
            f32x4 acc[4][2];
#pragma unroll
            for (int i = 0; i < 4; ++i) { acc[i][0] = (f32x4){0.f, 0.f, 0.f, 0.f}; acc[i][1] = (f32x4){0.f, 0.f, 0.f, 0.f}; }
            const bf16_t* ap = A + (size_t)(rw + fr) * 512 + 8 * fq;
            const bf16_t* bp0 = Bt + (size_t)(cw + perm32(fr)) * 512 + 8 * fq;
            const bf16_t* bp1 = Bt + (size_t)(cw + perm32(16 + fr)) * 512 + 8 * fq;
#pragma unroll 2
            for (int k = 0; k < 512; k += 32) {
                const bf16x8 b0 = *(const bf16x8*)(bp0 + k), b1 = *(const bf16x8*)(bp1 + k);
#pragma unroll
                for (int i = 0; i < 4; ++i) {
                    const bf16x8 af = *(const bf16x8*)(ap + (size_t)(16 * i) * 512 + k);
                    acc[i][0] = __builtin_amdgcn_mfma_f32_16x16x32_bf16(b0, af, acc[i][0], 0, 0, 0);
                    acc[i][1] = __builtin_amdgcn_mfma_f32_16x16x32_bf16(b1, af, acc[i][1], 0, 0, 0);
                }
            }
#pragma unroll
            for (int i = 0; i < 4; ++i) {
                f32x4 g0, g1; unpack8(*(const u32x4*)(Gt + (size_t)(rw + 16 * i + fr) * 3072 + s * 1024 + cw + 8 * fq), g0, g1);
                tot[i][0] += g0 * acc[i][0]; tot[i][1] += g1 * acc[i][1];
            }
        }
#pragma unroll
        for (int i = 0; i < 4; ++i) *(u32x4*)(O + (size_t)(rw + 16 * i + fr) * DM + cw + 8 * fq) = pack8(tot[i][0], tot[i][1]);
    }
}

__device__ __forceinline__ void attn_item(unsigned char* lds, bf16_t* Qb, const bf16_t* KVb, const float* sink, int qrow0, int kvh, int npos0, int b) {
    const int tid = opaque_tid(), lane = tid & 63, wave = tid >> 6, r32 = lane & 31, hi = lane >> 5;
    bf16_t* Ks = (bf16_t*)lds;
    bf16_t* Vs = (bf16_t*)(lds + 9216);
    const int hq = kvh * 4 + (wave >> 1);
    const int qoff = (wave & 1) * 32;
    bf16x8 qf[4];
#pragma unroll
    for (int ks = 0; ks < 4; ++ks) qf[ks] = *(const bf16x8*)(Qb + (size_t)(qrow0 + qoff + r32) * 512 + hq * 64 + 16 * ks + 8 * hi);
    f32x16 o[2];
#pragma unroll
    for (int dt = 0; dt < 2; ++dt)
#pragma unroll
        for (int r = 0; r < 16; ++r) o[dt][r] = 0.f;
    float m = sink[hq] * LOG2E, l = (hi == 0) ? 1.f : 0.f;
    const int ntl = (npos0 >= 0) ? 5 : 0;
    const int qp0 = npos0 + qoff;
    const int skey = tid >> 3, sch = tid & 7;
    int ti = 0;
    while (ti < ntl) { const int k0 = npos0 - 128 + 64 * ti; if (k0 >= 0 && k0 < SEQ) break; ++ti; }
    u32x4 pkv, pvv;
    {
        const int krow = (ti < ntl) ? (b * SEQ + npos0 - 128 + 64 * ti) : (ML + b * CTX + 64 * (ti - ntl));
        const bf16_t* src = KVb + (size_t)(krow + skey) * 256 + kvh * 64 + sch * 8;
        pkv = *(const u32x4*)src; pvv = *(const u32x4*)(src + 128);
    }
#pragma unroll 1
    while (ti < ntl + 4) {
        const bool masked = ti < ntl;
        const int kp0 = masked ? (npos0 - 128 + 64 * ti) : 0;
        __syncthreads();
        {
            *(u32x4*)(Ks + skey * 72 + sch * 8) = pkv;
            *(u32x4*)(Vs + skey * 72 + sch * 8) = pvv;
        }
        __syncthreads();
        int tn = ti + 1;
        while (tn < ntl) { const int k0 = npos0 - 128 + 64 * tn; if (k0 >= 0 && k0 < SEQ) break; ++tn; }
        if (tn < ntl + 4) {
            const int krow = (tn < ntl) ? (b * SEQ + npos0 - 128 + 64 * tn) : (ML + b * CTX + 64 * (tn - ntl));
            const bf16_t* src = KVb + (size_t)(krow + skey) * 256 + kvh * 64 + sch * 8;
            pkv = *(const u32x4*)src; pvv = *(const u32x4*)(src + 128);
        }
        const int tcur = ti; ti = tn; (void)tcur;
        if (masked && (kp0 - (qp0 + 31) > 128 || qp0 - (kp0 + 63) > 128)) continue;
        f32x16 p0, p1;
#pragma unroll
        for (int r = 0; r < 16; ++r) { p0[r] = 0.f; p1[r] = 0.f; }
#pragma unroll
        for (int ks = 0; ks < 4; ++ks) {
            const bf16x8 k0 = *(const bf16x8*)(Ks + r32 * 72 + 16 * ks + 8 * hi);
            const bf16x8 k1 = *(const bf16x8*)(Ks + (32 + r32) * 72 + 16 * ks + 8 * hi);
            p0 = __builtin_amdgcn_mfma_f32_32x32x16_bf16(k0, qf[ks], p0, 0, 0, 0);
            p1 = __builtin_amdgcn_mfma_f32_32x32x16_bf16(k1, qf[ks], p1, 0, 0, 0);
        }
        if (masked && ((qp0 + 31) - kp0 > 128 || (kp0 + 63) - qp0 > 128)) {
            const int qp = qp0 + r32;
#pragma unroll
            for (int r = 0; r < 16; ++r) {
                const int d0 = qp - (kp0 + crow(r, hi)), d1 = d0 - 32;
                if (d0 > 128 || d0 < -128) p0[r] = -1e30f;
                if (d1 > 128 || d1 < -128) p1[r] = -1e30f;
            }
        }
        float mx = fmaxf(p0[0], p1[0]);
#pragma unroll
        for (int r = 1; r < 16; ++r) mx = fmaxf(mx, fmaxf(p0[r], p1[r]));
        mx = fmaxf(mx, __shfl_xor(mx, 32));
        const float mn = fmaxf(m, mx);
        const float alpha = __builtin_amdgcn_exp2f(m - mn);
        m = mn;
        float rs = 0.f;
#pragma unroll
        for (int r = 0; r < 16; ++r) { p0[r] = __builtin_amdgcn_exp2f(p0[r] - mn); p1[r] = __builtin_amdgcn_exp2f(p1[r] - mn); rs += p0[r] + p1[r]; }
        l = l * alpha + rs;
#pragma unroll
        for (int dt = 0; dt < 2; ++dt)
#pragma unroll
            for (int r = 0; r < 16; ++r) o[dt][r] *= alpha;
#pragma unroll
        for (int s4 = 0; s4 < 4; ++s4) {
            u32x4 pw;
            if (s4 < 2) { const int o8 = 8 * s4; pw.x = pk2(p0[o8], p0[o8 + 1]); pw.y = pk2(p0[o8 + 2], p0[o8 + 3]); pw.z = pk2(p0[o8 + 4], p0[o8 + 5]); pw.w = pk2(p0[o8 + 6], p0[o8 + 7]); }
            else { const int o8 = 8 * (s4 - 2); pw.x = pk2(p1[o8], p1[o8 + 1]); pw.y = pk2(p1[o8 + 2], p1[o8 + 3]); pw.z = pk2(p1[o8 + 4], p1[o8 + 5]); pw.w = pk2(p1[o8 + 6], p1[o8 + 7]); }
            const bf16x8 pf = __builtin_bit_cast(bf16x8, pw);
            const int keybase = 32 * (s4 >> 1) + 16 * (s4 & 1) + 4 * hi;
#pragma unroll
            for (int dt = 0; dt < 2; ++dt) {
                const bf16_t* vp = Vs + (keybase + ((lane & 15) >> 2)) * 72 + 32 * dt + 16 * ((lane >> 4) & 1) + 4 * (lane & 3);
                const s16x4 lo = __builtin_bit_cast(s16x4, __builtin_amdgcn_ds_read_tr16_b64_v4i16((__attribute__((address_space(3))) s16x4*)vp));
                const s16x4 hh = __builtin_bit_cast(s16x4, __builtin_amdgcn_ds_read_tr16_b64_v4i16((__attribute__((address_space(3))) s16x4*)(vp + 8 * 72)));
                const bf16x8 vf = (bf16x8){lo[0], lo[1], lo[2], lo[3], hh[0], hh[1], hh[2], hh[3]};
                o[dt] = __builtin_amdgcn_mfma_f32_32x32x16_bf16(vf, pf, o[dt], 0, 0, 0);
            }
        }
    }
    {
        const float lt = l + __shfl_xor(l, 32);
        const float inv = 1.f / lt;
        bf16_t* orow = Qb + (size_t)(qrow0 + qoff + r32) * 512 + hq * 64;
#pragma unroll
        for (int dt = 0; dt < 2; ++dt)
#pragma unroll
            for (int rg = 0; rg < 4; ++rg) {
                u32x2 w; w.x = pk2(o[dt][4 * rg] * inv, o[dt][4 * rg + 1] * inv); w.y = pk2(o[dt][4 * rg + 2] * inv, o[dt][4 * rg + 3] * inv);
                *(u32x2*)(orow + 32 * dt + 8 * rg + 4 * hi) = w;
            }
    }
    __syncthreads();
}

__device__ __forceinline__ void pool_item(const P& p, int l, unsigned char* lds, int rb, int L, int t0, int g) {
    const int tid = opaque_tid(), lane = tid & 63, wave = tid >> 6, fr = lane & 15, fq = lane >> 4;
    bf16_t* U = (bf16_t*)lds;
    bf16_t* Dt = (bf16_t*)(lds + 20480);
    const bf16_t* PUb = (const bf16_t*)(p.ws + OFF_PU);
    bf16_t* PO = (bf16_t*)(p.ws + OFF_A);
    const bf16_t* PMt = (const bf16_t*)(p.ws + OFF_WA + WA_PM);
    const int mt = wave & 3, nh = wave >> 2;
    bf16x8 wf[4][4];
#pragma unroll
    for (int nt = 0; nt < 4; ++nt)
#pragma unroll
        for (int ks = 0; ks < 4; ++ks) wf[nt][ks] = *(const bf16x8*)(PMt + (size_t)(g * 128 + nh * 64 + 16 * nt + fr) * 128 + 32 * ks + 8 * fq);
    for (int idx = tid; idx < 80 * 16; idx += NTHREADS) {
        const int rr = idx >> 4, ch = idx & 15, t = t0 - 7 + rr;
        u32x4 v = (u32x4){0u, 0u, 0u, 0u};
        if (t >= 0 && t < L) v = *(const u32x4*)(PUb + (size_t)(rb + t) * 512 + g * 128 + ch * 8);
        *(u32x4*)(U + rr * 128 + ch * 8) = v;
    }
    __syncthreads();
    {
        const int w = 2 << g, offL = (w - 1) / 2, offR = w / 2;
        const int cp = tid & 63, t8 = (tid >> 6) * 8;
        const unsigned* U32 = (const unsigned*)U;
        float s0 = 0.f, s1 = 0.f;
        for (int u = t8 - offL; u <= t8 + offR; ++u) { const unsigned x = U32[(u + 7) * 64 + cp]; s0 += bf2f(x & 0xffffu); s1 += bf2f(x >> 16); }
#pragma unroll
        for (int i = 0; i < 8; ++i) {
            const int tt = t8 + i, t = t0 + tt;
            const int lo = max(t - offL, 0), hi = min(t + offR + 1, L);
            const float rc = __builtin_amdgcn_rcpf((float)(hi - lo));
            const unsigned xc = U32[(tt + 7) * 64 + cp];
            const float d0 = s0 * rc - bf2f(xc & 0xffffu), d1 = s1 * rc - bf2f(xc >> 16);
            *(unsigned*)(Dt + tt * 136 + 2 * cp) = pk2(d0, d1);
            if (i < 7) {
                const unsigned xo = U32[(tt - offL + 7) * 64 + cp], xn = U32[(tt + offR + 1 + 7) * 64 + cp];
                s0 += bf2f(xn & 0xffffu) - bf2f(xo & 0xffffu); s1 += bf2f(xn >> 16) - bf2f(xo >> 16);
            }
        }
    }
    __syncthreads();
    f32x4 acc[4];
#pragma unroll
    for (int nt = 0; nt < 4; ++nt) acc[nt] = (f32x4){0.f, 0.f, 0.f, 0.f};
#pragma unroll
    for (int ks = 0; ks < 4; ++ks) {
        const bf16x8 af = *(const bf16x8*)(Dt + (16 * mt + fr) * 136 + 32 * ks + 8 * fq);
#pragma unroll
        for (int nt = 0; nt < 4; ++nt) acc[nt] = __builtin_amdgcn_mfma_f32_16x16x32_bf16(wf[nt][ks], af, acc[nt], 0, 0, 0);
    }
#pragma unroll
    for (int nt = 0; nt < 4; ++nt) {
        const int col = g * 128 + nh * 64 + 16 * nt + 4 * fq;
        const f32x4 sc = *(const f32x4*)(p.in[I_PSCALE] + l * 512 + col);
        const f32x4 v = acc[nt] * sc;
        u32x2 wv; wv.x = pk2(v[0], v[1]); wv.y = pk2(v[2], v[3]);
        *(u32x2*)(PO + (size_t)(rb + t0 + 16 * mt + fr) * 512 + col) = wv;
    }
    __syncthreads();
}

constexpr size_t OFF_CT = 251 * MiB;
__device__ __forceinline__ void rnn_phase(const P& p, int l, unsigned char* lds, int pass, bool skip_ctx, int g_first, int g_step) {
    const int tid = opaque_tid(), half = tid >> 8, lane = tid & 63, hw = (tid >> 6) & 3, fr = lane & 15, fq = lane >> 4;
    const int d = half;
    float* XL = (float*)lds;
    bf16_t* XA = (bf16_t*)(lds + 16384);
    float2* TT = (float2*)(lds + 25600);
    float* HO = (float*)(lds + 31744);
    float2* CTL = (float2*)(lds + 64512);
    bf16_t* WL = (bf16_t*)(lds + 101376);
    const bf16_t* RXb = (const bf16_t*)(p.ws + OFF_RX);
    bf16_t* RYb = (bf16_t*)(p.ws + OFF_RY);
    float2* CT = (float2*)(p.ws + OFF_CT);
    const int cc = tid & 63, tb = (tid >> 6) * 8;
    const int ot = tid >> 3, oc8 = (tid & 7) * 8;
#pragma unroll 1
    for (int g = g_first; g < 256; g += g_step) {
        const int b = g >> 5, hb = (g >> 2) & 7, q4 = g & 3;
        const size_t ctbase = (size_t)((b * 8 + hb) * 2) * 36 * 64;
        __syncthreads();
#pragma unroll
        for (int i = 0; i < 4; ++i) {
            const int pc = tid + 512 * i, dm = pc >> 9, row = (pc >> 3) & 63, ch = pc & 7;
            const bf16_t* src = (const bf16_t*)(p.ws + OFF_WA + ((dm & 1) ? WA_LX : WA_LA)) + (size_t)((dm >> 1) * 8 + hb) * 4096 + row * 64 + ch * 8;
            *(u32x4*)(WL + (dm * 64 + row) * 72 + ch * 8) = *(const u32x4*)src;
        }
        float gba[4], gbx[4], ls2[4], cw[4];
#pragma unroll
        for (int nt = 0; nt < 4; ++nt) {
            const int cg_ = (l * 2 + d) * 512 + hb * 64 + 16 * nt + fr;
            gba[nt] = p.in[I_LBA][cg_]; gbx[nt] = p.in[I_LBX][cg_];
            ls2[nt] = (-8.f * LOG2E) * log1pf(__expf(-p.in[I_LAM][cg_]));
        }
#pragma unroll
        for (int k = 0; k < 4; ++k) cw[k] = p.in[I_CONVW][(l * 4 + k) * 512 + hb * 64 + cc];
        const float cbias = p.in[I_CONVB][l * 512 + hb * 64 + cc];
        if (pass == 2) {
#pragma unroll
            for (int i = 0; i < 9; ++i) CTL[tid + 512 * i] = CT[ctbase + tid + 512 * i];
            __syncthreads();
            if (tid < 128) {
                const int dd = tid >> 6, c = tid & 63;
                float2* ct = CTL + (dd * 36) * 64 + c;
                float h = 0.f;
#pragma unroll 12
                for (int j = 0; j < 36; ++j) {
                    const int k = (dd == 0) ? j : (j < 4 ? 3 - j : 39 - j);
                    const float2 t = ct[k * 64];
                    ct[k * 64].x = h;
                    h = t.x * h + t.y;
                }
            }
        }
        const int k0 = (pass == 2 && skip_ctx) ? 1 : 0;
        unsigned short xraw[11]; u32x4 yraw = (u32x4){0u, 0u, 0u, 0u};
#define RNN_ROWBASE(cj_) (((cj_) < 4) ? (ML + b * CTX + (cj_) * 64) : (b * SEQ + (cj_) * 64 - 256))
#define RNN_ISSUE(cj_) do { const int sp0_ = ((cj_) < 4) ? (cj_) * 64 : (cj_) * 64 - 256; const int L_ = ((cj_) < 4) ? CTX : SEQ; \
            const bf16_t* rxp_ = RXb + (size_t)RNN_ROWBASE(cj_) * 512 + hb * 64 + cc; \
            _Pragma("unroll") for (int i = 0; i < 11; ++i) { const int sp = sp0_ + tb - 1 + i; xraw[i] = (sp >= 0 && sp < L_) ? rxp_[(ptrdiff_t)(tb - 1 + i) * 512] : (unsigned short)0; } } while (0)
        RNN_ISSUE(q4 + 4 * k0);
        if (pass == 2) yraw = *(const u32x4*)(RYb + (size_t)(RNN_ROWBASE(q4 + 4 * k0) + ot) * 512 + hb * 64 + oc8);
#pragma unroll 1
        for (int k = k0; k < 9; ++k) {
            const int cj = q4 + 4 * k;
            const int rowbase = RNN_ROWBASE(cj);
            {
                float xv[11];
#pragma unroll
                for (int i = 0; i < 11; ++i) xv[i] = bf2f(xraw[i]);
#pragma unroll
                for (int i = 0; i < 8; ++i) {
                    const float v = cbias + cw[0] * xv[i] + cw[1] * xv[i + 1] + cw[2] * xv[i + 2] + cw[3] * xv[i + 3];
                    XL[(tb + i) * 64 + cc] = v; XA[(tb + i) * 72 + cc] = (bf16_t)f2bf(v);
                }
            }
            __syncthreads();
            u32x4 yraw_n = (u32x4){0u, 0u, 0u, 0u};
            if (k + 1 < 9) {
                RNN_ISSUE(cj + 4);
                if (pass == 2) yraw_n = *(const u32x4*)(RYb + (size_t)(RNN_ROWBASE(cj + 4) + ot) * 512 + hb * 64 + oc8);
            }
            float av[4][4], bv[4][4];
            {
                f32x4 ga[4], gx[4];
#pragma unroll
                for (int nt = 0; nt < 4; ++nt) { ga[nt] = (f32x4){0.f, 0.f, 0.f, 0.f}; gx[nt] = (f32x4){0.f, 0.f, 0.f, 0.f}; }
#pragma unroll
                for (int ks = 0; ks < 2; ++ks) {
                    const bf16x8 af = *(const bf16x8*)(XA + (16 * hw + fr) * 72 + 32 * ks + 8 * fq);
#pragma unroll
                    for (int nt = 0; nt < 4; ++nt) {
                        const bf16x8 wa = *(const bf16x8*)(WL + ((d * 2 + 0) * 64 + 16 * nt + fr) * 72 + 32 * ks + 8 * fq);
                        const bf16x8 wx = *(const bf16x8*)(WL + ((d * 2 + 1) * 64 + 16 * nt + fr) * 72 + 32 * ks + 8 * fq);
                        ga[nt] = __builtin_amdgcn_mfma_f32_16x16x32_bf16(af, wa, ga[nt], 0, 0, 0);
                        gx[nt] = __builtin_amdgcn_mfma_f32_16x16x32_bf16(af, wx, gx[nt], 0, 0, 0);
                    }
                }
#pragma unroll
                for (int nt = 0; nt < 4; ++nt)
#pragma unroll
                    for (int rg = 0; rg < 4; ++rg) {
                        const int tk = 16 * hw + 4 * fq + rg, c = 16 * nt + fr;
                        const float r = sigm(ga[nt][rg] + gba[nt]);
                        const float ig = sigm(gx[nt][rg] + gbx[nt]);
                        const float a = __builtin_amdgcn_exp2f(ls2[nt] * r);
                        av[nt][rg] = a;
                        bv[nt][rg] = __builtin_amdgcn_sqrtf(fmaxf(1.f - a * a, 0.f)) * ig * XL[tk * 64 + c];
                    }
            }
            float exP[4], exQ[4];
#pragma unroll
            for (int nt = 0; nt < 4; ++nt) {
                float Pc = 1.f, Qc = 0.f;
#pragma unroll
                for (int i = 0; i < 4; ++i) {
                    const int rg = (d == 0) ? i : 3 - i;
                    Qc = av[nt][rg] * Qc + bv[nt][rg]; Pc = Pc * av[nt][rg];
                    av[nt][rg] = Pc; bv[nt][rg] = Qc;
                }
                float eP = 1.f, eQ = 0.f, tP = 1.f, tQ = 0.f;
#pragma unroll
                for (int i = 0; i < 4; ++i) {
                    const int kk = (d == 0) ? i : 3 - i;
                    const float kP = __shfl(Pc, fr + 16 * kk), kQ = __shfl(Qc, fr + 16 * kk);
                    const bool before = (d == 0) ? (kk < fq) : (kk > fq);
                    if (before) { eQ = kP * eQ + kQ; eP = eP * kP; }
                    tQ = kP * tQ + kQ; tP = tP * kP;
                }
                exP[nt] = eP; exQ[nt] = eQ;
                if (fq == 0) TT[(half * 4 + hw) * 64 + 16 * nt + fr] = make_float2(tP, tQ);
            }
            __syncthreads();
            if (pass == 1) {
                if (tid < 128) {
                    const int dd = tid >> 6, c = tid & 63;
                    float tP = 1.f, tQ = 0.f;
#pragma unroll
                    for (int i = 0; i < 4; ++i) { const int w = (dd == 0) ? i : 3 - i; const float2 t = TT[(dd * 4 + w) * 64 + c]; tQ = t.x * tQ + t.y; tP = tP * t.x; }
                    CT[ctbase + (size_t)(dd * 36 + cj) * 64 + c] = make_float2(tP, tQ);
                }
            } else {
#pragma unroll
                for (int nt = 0; nt < 4; ++nt) {
                    const int c = 16 * nt + fr;
                    float h = CTL[(half * 36 + cj) * 64 + c].x;
#pragma unroll
                    for (int i = 0; i < 3; ++i) {
                        const int w = (d == 0) ? i : 3 - i;
                        const float2 t = TT[(half * 4 + w) * 64 + c];
                        const bool before = (d == 0) ? (w < hw) : (w > hw);
                        if (before) h = t.x * h + t.y;
                    }
                    const float hin = exP[nt] * h + exQ[nt];
#pragma unroll
                    for (int rg = 0; rg < 4; ++rg) HO[(half * 64 + 16 * hw + 4 * fq + rg) * 64 + c] = av[nt][rg] * hin + bv[nt][rg];
                }
                __syncthreads();
                {
                    const f32x4 f0 = *(const f32x4*)(HO + ot * 64 + oc8), f1 = *(const f32x4*)(HO + ot * 64 + oc8 + 4);
                    const f32x4 b0 = *(const f32x4*)(HO + (64 + ot) * 64 + oc8), b1 = *(const f32x4*)(HO + (64 + ot) * 64 + oc8 + 4);
                    f32x4 y0, y1; unpack8(yraw, y0, y1);
                    f32x4 o0, o1;
#pragma unroll
                    for (int j = 0; j < 4; ++j) { o0[j] = (f0[j] + b0[j]) * gelu_tanh(y0[j]); o1[j] = (f1[j] + b1[j]) * gelu_tanh(y1[j]); }
                    *(u32x4*)(RYb + (size_t)(rowbase + ot) * 512 + hb * 64 + oc8) = pack8(o0, o1);
                }
            }
            yraw = yraw_n;
        }
#undef RNN_ROWBASE
#undef RNN_ISSUE
    }
    __syncthreads();
}

#define XB_TMO      128
#define XB_XCNT(j)  (256  + 64 * (j))
#define XB_XSUB(j)  (1280 + 64 * (j))
#define XB_XGEN(j)  (2304 + 64 * (j))
#define XB_TOP      3328
#define XB_TOPGEN   3392
#define XCD_BAR_WORDS 3456
#define XB_SPIN_CAP (1u << 18)

__device__ __forceinline__ unsigned xb_ld(unsigned* p)              { return __hip_atomic_load(p, __ATOMIC_RELAXED, __HIP_MEMORY_SCOPE_AGENT); }
__device__ __forceinline__ unsigned xb_add(unsigned* p, unsigned v) { return __hip_atomic_fetch_add(p, v, __ATOMIC_RELAXED, __HIP_MEMORY_SCOPE_AGENT); }
__device__ __forceinline__ unsigned xb_xcc_id() { return (unsigned)__builtin_amdgcn_s_getreg((3 << 11) | 20) & 0xFu; }
#define XB_SPIN(cond, bar) do { unsigned _sp = 0; while (cond) { __builtin_amdgcn_s_sleep(1); \
    if ((++_sp & 255u) == 0u) { if (xb_ld(&(bar)[XB_TMO])) break; if (_sp > XB_SPIN_CAP) { atomicAdd(&(bar)[XB_TMO], 1u); break; } } } } while (0)

struct XcdBarrier {
    unsigned* bar; unsigned x;
    volatile PG8_LAS unsigned* st;
};

__device__ __forceinline__ XcdBarrier xcd_barrier_post(unsigned* bar, volatile PG8_LAS unsigned* st) {
    XcdBarrier b; b.bar = bar; b.x = xb_xcc_id(); b.st = st;
    if (threadIdx.x == 0) (void)xb_add(&bar[XB_XCNT(b.x)], 1u);
    return b;
}
__device__ __forceinline__ void xcd_barrier_complete(unsigned* bar, unsigned x, unsigned& nloc, unsigned& nx) {
    const unsigned G = gridDim.x * gridDim.y * gridDim.z;
    unsigned sum, cnt, mine, sp = 0u;
    for (;;) {
        sum = 0u; cnt = 0u; mine = 0u;
#pragma unroll
        for (unsigned j = 0; j < 16; ++j) { const unsigned c = xb_ld(&bar[XB_XCNT(j)]); sum += c; cnt += (c > 0u) ? 1u : 0u; mine = (j == x) ? c : mine; }
        if (sum == G) break;
        __builtin_amdgcn_s_sleep(1);
        if ((++sp & 255u) == 0u) { if (xb_ld(&bar[XB_TMO])) break; if (sp > XB_SPIN_CAP) { atomicAdd(&bar[XB_TMO], 1u); break; } }
    }
    nloc = mine > 0u ? mine : 1u; nx = cnt > 0u ? cnt : 1u;
}

__device__ __forceinline__ void xcd_barrier(const XcdBarrier& b) {
    asm volatile("s_waitcnt vmcnt(0)" ::: "memory");
    __syncthreads();
    if (threadIdx.x == 0) {
        unsigned* bar = b.bar;
        __builtin_amdgcn_s_waitcnt(0);
        unsigned nloc = b.st[0], nx = b.st[1];
        if (nloc == 0u) { xcd_barrier_complete(bar, b.x, nloc, nx); b.st[0] = nloc; b.st[1] = nx; }
        const unsigned old = xb_add(&bar[XB_XSUB(b.x)], 1u);
        const unsigned gen = old / nloc;
        if (old + 1u == (gen + 1u) * nloc) {
            __builtin_amdgcn_fence(__ATOMIC_RELEASE, "agent");
            asm volatile("s_waitcnt vmcnt(0)" ::: "memory");
            const unsigned og = xb_add(&bar[XB_TOP], 1u);
            const unsigned tg = og / nx;
            if (og + 1u == (tg + 1u) * nx) xb_add(&bar[XB_TOPGEN], 1u);
            else XB_SPIN(xb_ld(&bar[XB_TOPGEN]) == tg, bar);
            __builtin_amdgcn_fence(__ATOMIC_ACQUIRE, "agent");
            xb_add(&bar[XB_XGEN(b.x)], 1u);
            asm volatile("s_waitcnt vmcnt(0)" ::: "memory");
        } else {
            XB_SPIN(xb_ld(&bar[XB_XGEN(b.x)]) == gen, bar);
            __builtin_amdgcn_fence(__ATOMIC_ACQUIRE, "agent");
            asm volatile("s_waitcnt vmcnt(0)" ::: "memory");
        }
    }
    __syncthreads();
}

__device__ __forceinline__ void run_phase(int ph, unsigned char* lds) {
#if defined(__HIP_DEVICE_COMPILE__)
    const __attribute__((address_space(4))) P* pp = (const __attribute__((address_space(4))) P*)__builtin_amdgcn_kernarg_segment_ptr();
    asm volatile("" : "+s"(pp));
    const P p = *pp;
#else
    const P p{};
#endif
    const int bid = blockIdx.x, G = gridDim.x;
    const int NGW = G * NWAVES;
    PG8_LAS unsigned char* ldsl = (PG8_LAS unsigned char*)lds;
    const float* mod = (const float*)(p.ws + OFF_MOD);
    bf16_t* Hb = (bf16_t*)(p.ws + OFF_A);
    float* XC = (float*)(p.ws + OFF_XC);
    if (ph == 0) {
        for (int it = bid; it < 192; it += G) mod_item(p, lds, it);
        if (bid == (192 % G)) table_item(p);
        __syncthreads();
        convert_WA(p, 0, lds, NGW);
        return;
    }
    if (ph == 1) {
        NormArgs a{}; a.xl = p.in[I_X]; a.xc = p.in[I_CTX]; a.y = nullptr; a.h = Hb; a.gpre = p.in[I_GPREMIX]; a.modh = mod; a.shift_idx = 0; a.nrows = MA;
        norm_rows(a, NGW);
        return;
    }
    const int l = (ph - 2) / 9; int sp = (ph - 2) % 9;
    const bool last = (l == 1);
    const int Mrows = last ? ML : MA;
    const float* modl = mod + (size_t)l * 9 * 6144;
    if (sp == 1) {
        const bool need_ctx = !last;
        const int nR = 256, nAL = 512, nAC = need_ctx ? 64 : 0, nPL = 1024, nPC = need_ctx ? 128 : 0;
        const int total = nR + nAL + nAC + nPL + nPC;
        bf16_t* Qb = (bf16_t*)(p.ws + OFF_Q); const bf16_t* KVb = (const bf16_t*)(p.ws + OFF_KV);
        const float* sink = p.in[I_SINK] + l * 8;
        unsigned* ctr = (unsigned*)(p.ws + OFF_CTL + 4096 + 256 * l);
        volatile int* slot = (volatile int*)(lds + LDS_BYTES - 32);
        for (;;) {
            if (threadIdx.x == 0) *slot = (int)atomicAdd(ctr, 1u);
            __syncthreads();
            int r = *slot;
            __syncthreads();
            if (r >= total) break;
            if (r < nR) { rnn_phase(p, l, lds, 1, false, r, 256); continue; }
            r -= nR;
            if (r < nAL + nAC) {
                int b, qrow0, npos0; const int kvh = r & 1;
                if (r < nAL) { b = r >> 6; const int qb = (r >> 1) & 31; qrow0 = b * SEQ + 64 * qb; npos0 = 64 * qb; }
                else { const int rc = r - nAL; b = rc >> 3; const int qb = (rc >> 1) & 3; qrow0 = ML + b * CTX + 64 * qb; npos0 = -1; }
                attn_item(lds, Qb, KVb, sink, qrow0, kvh, npos0, b);
                continue;
            }
            r -= nAL + nAC;
            int b, tile, rb, L; const int g = r & 3;
            if (r < nPL) { b = r >> 7; tile = (r >> 2) & 31; rb = b * SEQ; L = SEQ; }
            else { const int rc = r - nPL; b = rc >> 4; tile = (rc >> 2) & 3; rb = ML + b * CTX; L = CTX; }
            pool_item(p, l, lds, rb, L, tile * 64, g);
        }
        return;
    }
    if (sp == 2) { rnn_phase(p, l, lds, 2, last, bid, G); return; }
    if (sp > 2) sp -= 1;
    if (sp == 0 || sp == 2 || sp == 3 || sp == 5 || sp == 6) {
        pg8::Gemm g; EpiW<EpiAll> E; UOrder S;
        E.f.ws = p.ws; E.f.ooff = 0;
        if (sp == 0) {
            g.A = Hb; g.Bt = (const bf16_t*)(p.ws + OFF_WA + WA_IN); g.M = MA; g.N = INW; g.K = DM; E.f.kind = 0;
            if (!last) S.init(MA, INW, G, bid, 0, 1); else S.init(ML, INW, G, bid, 24, 1);
        } else if (sp == 2) {
            g.A = (const bf16_t*)(p.ws + OFF_Q); g.Bt = (const bf16_t*)(p.ws + OFF_WA + WA_AO);
            g.M = Mrows; g.N = DM; g.K = 512; E.f.kind = 3;
            S.init(Mrows, DM, G, bid, 0, 3);
        } else if (sp == 3) {
            g.A = (const bf16_t*)(p.ws + OFF_MERGED); g.Bt = (const bf16_t*)(p.ws + OFF_WA + WA_OUT); g.M = Mrows; g.N = DM; g.K = DM; E.f.kind = 1; E.f.ooff = OFF_G;
            S.init(Mrows, DM, G, bid, 0, 1);
        } else if (sp == 5) {
            g.A = Hb; g.Bt = (const bf16_t*)(p.ws + OFF_WB + WB_GU); g.M = Mrows; g.N = NGU; g.K = DM; E.f.kind = 2;
            S.init(Mrows, NGU, G, bid, 0, 1);
        } else {
            g.A = (const bf16_t*)(p.ws + OFF_G); g.Bt = (const bf16_t*)(p.ws + OFF_WB + WB_DOWN); g.M = Mrows; g.N = DM; g.K = DFF; E.f.kind = 1; E.f.ooff = OFF_F;
            S.init(Mrows, DM, G, bid, 0, 1);
        }
        pg8::gemm_phase<EpiW<EpiAll>, UOrder, true, true>(ldsl, g, S, E);
        return;
    }
    if (sp == 4) {
        NormArgs a{};
        a.xl = (l == 0) ? p.in[I_X] : p.out; a.xc = (l == 0) ? p.in[I_CTX] : XC; a.ol = p.out; a.oc = XC;
        a.y = (const bf16_t*)(p.ws + OFF_G); a.gpost = p.in[I_GPOSTMIX] + l * DM; a.modg = modl; a.gate_idx = 2;
        a.h = Hb; a.gpre = p.in[I_GPREFFN] + l * DM; a.modh = modl; a.shift_idx = 3; a.nrows = Mrows;
        norm_rows(a, NGW);
        convert_WB(p, l, lds, NGW);
        return;
    }
    {
        NormArgs a{};
        a.xl = p.out; a.xc = XC; a.ol = p.out; a.oc = XC;
        a.y = (const bf16_t*)(p.ws + OFF_F); a.gpost = p.in[I_GPOSTFFN] + l * DM; a.modg = modl; a.gate_idx = 5;
        if (!last) { a.h = Hb; a.gpre = p.in[I_GPREMIX] + (l + 1) * DM; a.modh = mod + (size_t)(l + 1) * 9 * 6144; a.shift_idx = 0; }
        a.nrows = Mrows;
        norm_rows(a, NGW);
        if (!last) convert_WA(p, l + 1, lds, NGW);
    }
}

#ifndef PROBE
#define PROBE 0
#endif
#ifndef PROBE_MASK_A
#define PROBE_MASK_A 0u
#endif
#ifndef PROBE_K
#define PROBE_K 2
#endif
#ifndef PROBE_MASK_B
#define PROBE_MASK_B 0u
#endif
constexpr int LDS_MISC = LDS_BYTES - 64;
constexpr size_t CTL_BAR = 262144;
__global__ void __launch_bounds__(NTHREADS) mega(P p) {
    extern __shared__ __attribute__((aligned(16))) unsigned char lds[];
    volatile PG8_LAS unsigned* misc = (volatile PG8_LAS unsigned*)((PG8_LAS unsigned char*)lds + LDS_MISC);
    if (threadIdx.x < 16) misc[threadIdx.x] = 0u;
    __syncthreads();
    XcdBarrier bar = xcd_barrier_post((unsigned*)(p.ws + OFF_CTL + CTL_BAR), misc);
    if (p.ph_lo < 0) cg::this_grid().sync();
#if PROBE
    unsigned long long* ts = (unsigned long long*)(p.ws + OFF_CTL + 65536);
    if (blockIdx.x == 0 && threadIdx.x == 0) ts[0] = __builtin_amdgcn_s_memrealtime();
#endif
    for (int ph = p.ph_lo; ph < p.ph_hi; ++ph) {
        run_phase(ph, lds);
#if PROBE
        xcd_barrier(bar);
        if (blockIdx.x == 0 && threadIdx.x == 0) ts[ph + 1] = __builtin_amdgcn_s_memrealtime();
#else
        if (ph + 1 < p.ph_hi) xcd_barrier(bar);
#endif
    }
#if PROBE
    if (blockIdx.x == 0 && threadIdx.x == 0) {
        unsigned long long extra = 0;
        for (int ph = 0; ph < NPHASES; ++ph) if ((PROBE_MASK_A >> ph) & 1u) extra += ts[ph + 1] - ts[ph];
        extra *= PROBE_K;
        const unsigned long long t0 = __builtin_amdgcn_s_memrealtime();
        while (__builtin_amdgcn_s_memrealtime() - t0 < extra) __builtin_amdgcn_s_sleep(8);
    }
#endif
}

extern "C" void kernel_launch(void* const* d_in, const int* in_sizes, int n_in, void* d_out, int out_size, void* d_ws, size_t ws_size, hipStream_t stream) {
    static int grid = 0;
    if (grid == 0) {
        if (n_in != 27 || ws_size < WS_NEED) { fprintf(stderr, "kernel_launch: unexpected n_in %d or ws_size %zu\n", n_in, ws_size); grid = -1; return; }
        int dev = 0, cus = 0, per_cu = 0;
        hipGetDevice(&dev);
        hipDeviceGetAttribute(&cus, hipDeviceAttributeMultiprocessorCount, dev);
        hipFuncSetAttribute((const void*)mega, hipFuncAttributeMaxDynamicSharedMemorySize, LDS_BYTES);
        hipOccupancyMaxActiveBlocksPerMultiprocessor(&per_cu, (const void*)mega, NTHREADS, LDS_BYTES);
        if (per_cu < 1) { fprintf(stderr, "kernel_launch: occupancy query says %d blocks per CU\n", per_cu); per_cu = 1; }
        grid = cus;
    }
    if (grid < 0) return;
    hipMemsetAsync((char*)d_ws + OFF_CTL, 0, 1 * MiB, stream);
    P p{};
    for (int i = 0; i < 27; ++i) p.in[i] = (const float*)d_in[i];
    p.out = (float*)d_out; p.ws = (unsigned char*)d_ws;
#if PER_PHASE_LAUNCH
    for (int ph = 0; ph < NPHASES; ++ph) {
        p.ph_lo = ph; p.ph_hi = ph + 1;
        hipLaunchKernelGGL(mega, dim3(grid), dim3(NTHREADS), LDS_BYTES, stream, p);
    }
#else
    p.ph_lo = 0; p.ph_hi = NPHASES;
    void* args[] = {&p};
    hipError_t e = hipLaunchCooperativeKernel((const void*)mega, dim3(grid), dim3(NTHREADS), args, LDS_BYTES, stream);
    if (e != hipSuccess) fprintf(stderr, "cooperative launch failed: %s (grid %d)\n", hipGetErrorString(e), grid);
#endif
}
```
